# Optimizing an MI355X kernel written in HIP

```python
import jax, jax.numpy as jnp
from jax import lax
import numpy as np

D_MODEL = 1024
BATCH = 16
SEQ = 2048
DEPTH = 2
DEC_BATCH = 8
DEC_SEQ = 32
PAST_LEN = 2048

CHUNK = 64
D_CONV = 1024
CONV_W = 3
N_HEADS = 16
QK_NOPE = 64
QK_ROPE = 32
V_HEAD = 64
Q_LORA = 384
KV_LORA = 256
D_FF = 2816
ROPE_THETA = 10000.0
EPS = 1e-6
Q_BLOCK = 128
ATTN_SCALE = (QK_NOPE + QK_ROPE) ** -0.5
NEG_INF = -1e30
D_IN = 3 * D_CONV + Q_LORA + KV_LORA + QK_ROPE + 2 * D_MODEL

kernel_name = "hybrid_shortconv_mla_stream_step"


def rmsnorm(x, g):
    xf = x.astype(jnp.float32)
    y = xf * lax.rsqrt(jnp.mean(xf * xf, axis=-1, keepdims=True) + EPS)
    return (y * g.astype(jnp.float32)).astype(x.dtype)


def apply_rope(x, pos):
    half = QK_ROPE // 2
    inv = ROPE_THETA ** (-jnp.arange(half, dtype=jnp.float32) / half)
    ang = pos.astype(jnp.float32)[:, None] * inv[None, :]
    cos = jnp.cos(ang)[None, :, None, :]
    sin = jnp.sin(ang)[None, :, None, :]
    xf = x.astype(jnp.float32)
    x1, x2 = xf[..., :half], xf[..., half:]
    return jnp.concatenate([x1 * cos - x2 * sin, x1 * sin + x2 * cos], axis=-1).astype(x.dtype)


def attend_block(q_nope, q_rope, q_pos, k_nope, k_rope, v, k_pos):
    s = (jnp.einsum('bqhn,bkhn->bhqk', q_nope, k_nope)
         + jnp.einsum('bqhr,bkr->bhqk', q_rope, k_rope))
    s = s.astype(jnp.float32) * ATTN_SCALE
    mask = (k_pos // CHUNK)[None, :] <= (q_pos // CHUNK)[:, None]
    s = jnp.where(mask[None, None], s, jnp.float32(NEG_INF))
    p = jax.nn.softmax(s, axis=-1).astype(v.dtype)
    return jnp.einsum('bhqk,bkhv->bqhv', p, v)


def mixer(h, pos, conv_hist, ckv_past, krope_past, k_pos, w_in, norm_q, norm_kv,
          w_uq, w_ukv, conv_w, w_conv_out, w_attn_out, w_merge):
    bsz, s_len, _ = h.shape
    proj = h @ w_in
    o1, o2, o3 = D_CONV, 2 * D_CONV, 3 * D_CONV
    o4 = o3 + Q_LORA
    o5 = o4 + KV_LORA
    o6 = o5 + QK_ROPE
    o7 = o6 + D_MODEL
    b_g, c_g, xin, q_lat, ckv, k_r, g_a, g_b = jnp.split(proj, [o1, o2, o3, o4, o5, o6, o7], axis=-1)

    u = c_g * xin
    u_ext = jnp.concatenate([conv_hist, u], axis=1)
    conv = (conv_w[0] * u_ext[:, 0:s_len] + conv_w[1] * u_ext[:, 1:s_len + 1]
            + conv_w[2] * u_ext[:, 2:s_len + 2])
    y_a = (b_g * conv) @ w_conv_out
    new_conv = u_ext[:, -(CONV_W - 1):]

    q = (rmsnorm(q_lat, norm_q) @ w_uq).reshape(bsz, s_len, N_HEADS, QK_NOPE + QK_ROPE)
    q_nope, q_rope = q[..., :QK_NOPE], apply_rope(q[..., QK_NOPE:], pos)
    c_new = rmsnorm(ckv, norm_kv)
    kr_new = apply_rope(k_r[:, :, None, :], pos)[:, :, 0]
    if ckv_past is None:
        c_all, kr_all = c_new, kr_new
    else:
        c_all = jnp.concatenate([ckv_past, c_new], axis=1)
        kr_all = jnp.concatenate([krope_past, kr_new], axis=1)
    n_keys = c_all.shape[1]
    kv = (c_all @ w_ukv).reshape(bsz, n_keys, N_HEADS, QK_NOPE + V_HEAD)
    k_nope, v = kv[..., :QK_NOPE], kv[..., QK_NOPE:]
    if ckv_past is None:
        n_blk = s_len // Q_BLOCK
        qn_b = jnp.moveaxis(q_nope.reshape(bsz, n_blk, Q_BLOCK, N_HEADS, QK_NOPE), 1, 0)
        qr_b = jnp.moveaxis(q_rope.reshape(bsz, n_blk, Q_BLOCK, N_HEADS, QK_ROPE), 1, 0)
        pos_b = pos.reshape(n_blk, Q_BLOCK)
        out = lax.map(lambda a: attend_block(a[0], a[1], a[2], k_nope, kr_all, v, k_pos),
                      (qn_b, qr_b, pos_b))
        attn = jnp.moveaxis(out, 0, 1).reshape(bsz, s_len, N_HEADS * V_HEAD)
    else:
        attn = attend_block(q_nope, q_rope, pos, k_nope, kr_all, v, k_pos).reshape(bsz, s_len, N_HEADS * V_HEAD)
    y_b = attn @ w_attn_out

    mixed = (jax.nn.sigmoid(g_a) * y_a + jax.nn.sigmoid(g_b) * y_b) @ w_merge
    return mixed, new_conv, c_new, kr_new


def layer(x, pos, k_pos, conv_hist, ckv_past, krope_past, w_in, norm_attn_pre, norm_attn_post,
          norm_q, norm_kv, w_uq, w_ukv, conv_w, w_conv_out, w_attn_out, w_merge,
          norm_ffn_pre, norm_ffn_post, w_gate_up, w_down):
    m, new_conv, c_new, kr_new = mixer(rmsnorm(x, norm_attn_pre), pos, conv_hist, ckv_past, krope_past,
                                       k_pos, w_in, norm_q, norm_kv, w_uq, w_ukv, conv_w,
                                       w_conv_out, w_attn_out, w_merge)
    x = x + rmsnorm(m, norm_attn_post)
    gu = rmsnorm(x, norm_ffn_pre) @ w_gate_up
    f = (jax.nn.silu(gu[..., :D_FF]) * gu[..., D_FF:]) @ w_down
    x = x + rmsnorm(f, norm_ffn_post)
    return x, new_conv, c_new, kr_new


def setup_inputs(seed: int = 0) -> dict:
    key = jax.random.key(seed)
    ks = jax.random.split(key, 24)
    f32 = jnp.float32

    def nrm(k, shape, scale):
        return jax.random.normal(k, shape, f32) * scale

    def gain(k, n):
        return 1.0 + 0.05 * jax.random.normal(k, (DEPTH, n), f32)

    return {
        "x_prompt": nrm(ks[0], (BATCH, SEQ, D_MODEL), 1.0),
        "x_sample": nrm(ks[1], (DEC_BATCH, DEC_SEQ, D_MODEL), 1.0),
        "state_conv": nrm(ks[2], (DEPTH, DEC_BATCH, CONV_W - 1, D_CONV), 1.0),
        "cache_ckv": nrm(ks[3], (DEPTH, DEC_BATCH, PAST_LEN, KV_LORA), 1.0),
        "cache_krope": nrm(ks[4], (DEPTH, DEC_BATCH, PAST_LEN, QK_ROPE), 1.0),
        "w_in": nrm(ks[5], (DEPTH, D_MODEL, D_IN), D_MODEL ** -0.5),
        "norm_attn_pre": gain(ks[6], D_MODEL),
        "norm_attn_post": gain(ks[7], D_MODEL),
        "norm_q": gain(ks[8], Q_LORA),
        "norm_kv": gain(ks[9], KV_LORA),
        "w_uq": nrm(ks[10], (DEPTH, Q_LORA, N_HEADS * (QK_NOPE + QK_ROPE)), Q_LORA ** -0.5),
        "w_ukv": nrm(ks[11], (DEPTH, KV_LORA, N_HEADS * (QK_NOPE + V_HEAD)), KV_LORA ** -0.5),
        "conv_w": nrm(ks[12], (DEPTH, CONV_W, D_CONV), CONV_W ** -0.5),
        "w_conv_out": nrm(ks[13], (DEPTH, D_CONV, D_MODEL), D_CONV ** -0.5),
        "w_attn_out": nrm(ks[14], (DEPTH, N_HEADS * V_HEAD, D_MODEL), (N_HEADS * V_HEAD) ** -0.5),
        "w_merge": nrm(ks[15], (DEPTH, D_MODEL, D_MODEL), D_MODEL ** -0.5),
        "norm_ffn_pre": gain(ks[16], D_MODEL),
        "norm_ffn_post": gain(ks[17], D_MODEL),
        "w_gate_up": nrm(ks[18], (DEPTH, D_MODEL, 2 * D_FF), D_MODEL ** -0.5),
        "w_down": nrm(ks[19], (DEPTH, D_FF, D_MODEL), D_FF ** -0.5),
    }


def reference(x_prompt, x_sample, state_conv, cache_ckv, cache_krope, w_in, norm_attn_pre,
              norm_attn_post, norm_q, norm_kv, w_uq, w_ukv, conv_w, w_conv_out, w_attn_out,
              w_merge, norm_ffn_pre, norm_ffn_post, w_gate_up, w_down):
    s_p = x_prompt.shape[1]
    s_s = x_sample.shape[1]
    past = cache_ckv.shape[2]
    pos_p = jnp.arange(s_p, dtype=jnp.int32)
    pos_s = past + jnp.arange(s_s, dtype=jnp.int32)
    kpos_s = jnp.arange(past + s_s, dtype=jnp.int32)
    hist_p = jnp.zeros((x_prompt.shape[0], CONV_W - 1, D_CONV), x_prompt.dtype)

    xp, xs = x_prompt, x_sample
    conv_p, ckv_p, kr_p, conv_s, ckv_s, kr_s = [], [], [], [], [], []
    for l in range(DEPTH):
        w = (w_in[l], norm_attn_pre[l], norm_attn_post[l], norm_q[l], norm_kv[l], w_uq[l], w_ukv[l],
             conv_w[l], w_conv_out[l], w_attn_out[l], w_merge[l], norm_ffn_pre[l], norm_ffn_post[l],
             w_gate_up[l], w_down[l])
        xp, nc, cn, kn = layer(xp, pos_p, pos_p, hist_p, None, None, *w)
        conv_p.append(nc); ckv_p.append(cn); kr_p.append(kn)
        xs, nc, cn, kn = layer(xs, pos_s, kpos_s, state_conv[l], cache_ckv[l], cache_krope[l], *w)
        conv_s.append(nc); ckv_s.append(cn); kr_s.append(kn)

    return (xp, xs, jnp.stack(conv_p), jnp.stack(ckv_p), jnp.stack(kr_p),
            jnp.stack(conv_s), jnp.stack(ckv_s), jnp.stack(kr_s))
```

```cpp
#include <hip/hip_runtime.h>
#include <hip/hip_cooperative_groups.h>
#include <cstdio>
#include <cstdint>
namespace cg = cooperative_groups;
constexpr int NWAVES = 8;
constexpr int D = 1024, TP = 32768, TS = 256, T = TP + TS, SEQ = 2048, NB = 16, DB = 8, DSEQ = 32, PAST = 2048, SKEYS = PAST + DSEQ, KT = TP + DB * SKEYS;
constexpr int DIN = 5792, DINP = 5888, QL = 384, KVL = 256, RP = 32, DFF = 2816, NH = 16, LATP = 768;
constexpr int G0_ROWS = 16384, G1_ROWS = T - G0_ROWS, G1_KEYS = KT - G0_ROWS, VT_LD = 33024;
constexpr float EPS = 1e-6f;
constexpr float QSCALE = 0.10206207261596577f * 1.4426950408889634f;
static_assert(T % 256 == 0 && G1_ROWS % 256 == 0 && G1_KEYS % 256 == 0 && KT % 256 == 0 && G1_KEYS == VT_LD, "tiles");
constexpr size_t O_Y = 0, O_CONV_P = (size_t)T * D, O_CKV_P = O_CONV_P + 2 * NB * 2 * D, O_KR_P = O_CKV_P + (size_t)2 * TP * KVL, O_CONV_S = O_KR_P + (size_t)2 * TP * RP,
                 O_CKV_S = O_CONV_S + 2 * DB * 2 * D, O_KR_S = O_CKV_S + (size_t)2 * TS * KVL, O_END = O_KR_S + (size_t)2 * TS * RP;
static_assert(O_END == 52936704, "d_out size");
constexpr size_t MiB = 1u << 20, U1 = (size_t)T * D * 2;
constexpr size_t WS_RSA = 256 * 1024, WS_RSB = 512 * 1024;
constexpr size_t WS_ROPE = 1 * MiB, WS_W = 2 * MiB, WS_R0 = 40 * MiB, WS_R1 = WS_R0 + U1, WS_R2 = WS_R1 + U1, WS_R3 = WS_R2 + U1, WS_R6 = WS_R3 + 178 * MiB;
constexpr size_t WS_QLN = WS_R6, WS_CALL = WS_QLN + (size_t)T * QL * 2, WS_KR = WS_CALL + (size_t)KT * KVL * 2, WS_END = WS_KR + (size_t)KT * RP * 2;
constexpr size_t W_IN = 0, W_UQ = W_IN + (size_t)DINP * D, W_UK = W_UQ + (size_t)1536 * QL, W_UV = W_UK + (size_t)1024 * KVL, W_CONV = W_UV + (size_t)1024 * KVL,
                 W_ATTN = W_CONV + (size_t)D * D, W_MERGE = W_ATTN + (size_t)D * D, W_GU = W_MERGE + (size_t)D * D, W_DOWN = W_GU + (size_t)2 * DFF * D, W_END = W_DOWN + (size_t)D * DFF;
static_assert(WS_W + W_END * 2 <= WS_R0, "weights fit");
constexpr size_t WS_BG = WS_R3, WS_U = WS_R3 + U1, WS_LAT = WS_R3 + 2 * U1;
constexpr size_t WS_QN = WS_R3, WS_QR = WS_QN + (size_t)G1_ROWS * 1024 * 2, WS_KN = WS_QR + (size_t)G1_ROWS * 512 * 2, WS_VT = WS_KN + (size_t)G1_KEYS * 1024 * 2, WS_GEND = WS_VT + (size_t)1024 * VT_LD * 2;
static_assert(WS_GEND <= WS_R6 && WS_LAT + (size_t)T * LATP * 2 <= WS_R6 && WS_R3 + (size_t)T * DFF * 2 <= WS_R6, "R3 region");
static_assert(WS_END <= 536870912, "d_ws budget (512 MiB)");
constexpr int LDS_BYTES = 131072 + 1024;


namespace pg8 {
#define PG8_LAS __attribute__((address_space(3)))
typedef unsigned short bf16_t;
typedef short bf16x8 __attribute__((ext_vector_type(8)));
typedef float f32x4 __attribute__((ext_vector_type(4)));
typedef unsigned u32x4 __attribute__((ext_vector_type(4)));
constexpr int BM = 256, BK = 64, HALF = 128, HTB = HALF * BK * 2  , STAGE_BYTES = 8 * HTB, NXCD = 8, WGM = 8;

__host__ __device__ __forceinline__ int lds_byte(int r, int c) { const int st = (r >> 4) * 2 + (c >> 5), rr = r & 15, cc = c & 31, ob = rr * 64 + cc * 2; return st * 1024 + (ob ^ (((ob >> 9) & 1) << 5)); }
__host__ __device__ __forceinline__ void stage_rc(int b, int& R, int& C) { const int st = b / 1024, sb = b % 1024, swz = sb ^ (((sb >> 9) & 1) << 5); R = (st >> 1) * 16 + swz / 64; C = (st & 1) * 32 + (swz % 64) / 2; }
__host__ __device__ __forceinline__ int perm32(int rho) { const int n = rho >> 4, i = rho & 15; return 8 * (i >> 2) + 4 * n + (i & 3); }

struct Unit { int pm, pn; };
struct Gemm { const bf16_t* A; const bf16_t* Bt; int M, N, K; };

struct StaticOrder {
    int nM, nN, nwg, G, c;
    __host__ __device__ void init(int M, int N, int G_, int c_) { nM = M / BM; nN = N / BM; nwg = nM * nN; G = G_; c = c_; }
    __host__ __device__ bool next(int i, Unit& u) const {
        const long L = (long)i * G + c; if (L >= nwg) return false;
        int wgid = (int)L; { const int q = nwg / NXCD, r = nwg % NXCD, xcd = wgid % NXCD, off = wgid / NXCD; wgid = (xcd < r ? xcd * (q + 1) : r * (q + 1) + (xcd - r) * q) + off; }
        const int nig = WGM * nN, gid = wgid / nig, fm = gid * WGM, gsz = (nM - fm) < WGM ? (nM - fm) : WGM;
        u.pm = fm + ((wgid % nig) % gsz); u.pn = (wgid % nig) / gsz; return true;
    }
    __device__ __forceinline__ void a_ready(const Unit&) const {}
    __device__ __forceinline__ void done(const Unit&) const {}
};

__device__ __forceinline__ unsigned cvt_pk_bf16(float lo, float hi) { unsigned r; asm volatile("v_cvt_pk_bf16_f32 %0, %1, %2" : "=v"(r) : "v"(lo), "v"(hi)); return r; }
typedef float f32x2 __attribute__((ext_vector_type(2)));
typedef unsigned u32x4e __attribute__((ext_vector_type(4)));
enum { EK_PLAIN = 0, EK_PAIRMUL = 1, EK_SWIGLU = 2, EK_SIGMOID = 3, EK_GATE = 4, EK_COMBINE = 5, EK_WIN = 6, EK_Q = 7 };
__device__ __forceinline__ float sigm(float x) { return __builtin_amdgcn_rcpf(1.0f + __builtin_amdgcn_exp2f(-1.4426950408889634f * x)); }
__device__ __forceinline__ float bflo(unsigned w) { return __uint_as_float(w << 16); }
__device__ __forceinline__ float bfhi(unsigned w) { return __uint_as_float(w & 0xffff0000u); }
struct EpiX {
    static constexpr bool PERM = true, AFTER_DRAIN = false;
    int kind; unsigned char* ws; size_t oO; int ldc; float scale; size_t oRS; int use_rs;
    __device__ __forceinline__ void operator()(const f32x4 (&acc)[2][2][4][2], const Unit& u, int wr, int wc, int fr, int fq) const {
        int k = kind; size_t ob = oO; int ld = ldc; int colt = u.pn * BM; const float sc = scale;
        if (k == EK_WIN) {
            const int pn = u.pn;
            if (pn < 4) { k = EK_PLAIN; }
            else if (pn < 12) { k = EK_PAIRMUL; ob = WS_U; colt = (pn - 4) * 128; }
            else if (pn < 16) { k = EK_SIGMOID; ob = WS_R1; colt = (pn - 12) * 256; }
            else if (pn < 20) { k = EK_SIGMOID; ob = WS_R2; colt = (pn - 16) * 256; }
            else { k = EK_PLAIN; ob = WS_LAT; colt = (pn - 20) * 256; ld = 768; }
        } else if (k == EK_Q) {
            k = EK_PLAIN; if (u.pn >= 4) { ob = WS_QR; colt = (u.pn - 4) * 256; ld = 512; }
        } else if (k == EK_PAIRMUL || k == EK_SWIGLU) colt = u.pn * 128;
        const int row0 = u.pm * BM + wr * 64 + fr;
        const int col0 = colt + wc * 32 + 8 * fq;
        bf16_t* base = (bf16_t*)(ws + ob); const bf16_t* aux1 = (const bf16_t*)(ws + WS_R1); const bf16_t* aux2 = (const bf16_t*)(ws + WS_R2);
        const float* rsp = (const float*)(ws + oRS);
        if (k == EK_PAIRMUL || k == EK_SWIGLU) {
#pragma unroll
            for (int ai = 0; ai < 2; ++ai)
#pragma unroll
                for (int m = 0; m < 4; ++m) {
                    bf16_t* rowp = base + (size_t)(row0 + ai * HALF + m * 16) * ld + col0;
                    const float rr = use_rs ? rsp[row0 + ai * HALF + m * 16] : 1.f;
                    f32x4 a0 = acc[ai][0][m][0] * rr, a1 = acc[ai][0][m][1] * rr; const f32x4 b0 = acc[ai][1][m][0] * rr, b1 = acc[ai][1][m][1] * rr;
                    if (k == EK_SWIGLU) {
#pragma unroll
                        for (int i = 0; i < 4; ++i) { a0[i] = a0[i] * sigm(a0[i]); a1[i] = a1[i] * sigm(a1[i]); }
                    }
                    const f32x4 v0 = a0 * b0, v1 = a1 * b1;
                    u32x4e w; w.x = cvt_pk_bf16(v0[0], v0[1]); w.y = cvt_pk_bf16(v0[2], v0[3]); w.z = cvt_pk_bf16(v1[0], v1[1]); w.w = cvt_pk_bf16(v1[2], v1[3]);
                    *(u32x4e*)rowp = w;
                }
        } else {
#pragma unroll
            for (int ai = 0; ai < 2; ++ai)
#pragma unroll
                for (int m = 0; m < 4; ++m) {
                    const size_t roff = (size_t)(row0 + ai * HALF + m * 16) * ld + col0;
                    const float rr = use_rs ? rsp[row0 + ai * HALF + m * 16] : 1.f;
#pragma unroll
                    for (int bj = 0; bj < 2; ++bj) {
                        f32x4 v0 = acc[ai][bj][m][0], v1 = acc[ai][bj][m][1];
                        const size_t off = roff + bj * HALF;
                        if (k == EK_PLAIN) { v0 = v0 * (sc * rr); v1 = v1 * (sc * rr); }
                        else if (k == EK_SIGMOID) {
#pragma unroll
                            for (int i = 0; i < 4; ++i) { v0[i] = sigm(v0[i] * rr); v1[i] = sigm(v1[i] * rr); }
                        } else if (k == EK_GATE) {
                            const u32x4e g = *(const u32x4e*)(aux1 + off);
                            v0[0] *= bflo(g.x); v0[1] *= bfhi(g.x); v0[2] *= bflo(g.y); v0[3] *= bfhi(g.y);
                            v1[0] *= bflo(g.z); v1[1] *= bfhi(g.z); v1[2] *= bflo(g.w); v1[3] *= bfhi(g.w);
                        } else {
                            const u32x4e y = *(const u32x4e*)(aux1 + off); const u32x4e g = *(const u32x4e*)(aux2 + off);
                            v0[0] = bflo(y.x) + bflo(g.x) * v0[0]; v0[1] = bfhi(y.x) + bfhi(g.x) * v0[1]; v0[2] = bflo(y.y) + bflo(g.y) * v0[2]; v0[3] = bfhi(y.y) + bfhi(g.y) * v0[3];
                            v1[0] = bflo(y.z) + bflo(g.z) * v1[0]; v1[1] = bfhi(y.z) + bfhi(g.z) * v1[1]; v1[2] = bflo(y.w) + bflo(g.w) * v1[2]; v1[3] = bfhi(y.w) + bfhi(g.w) * v1[3];
                        }
                        u32x4e w; w.x = cvt_pk_bf16(v0[0], v0[1]); w.y = cvt_pk_bf16(v0[2], v0[3]); w.z = cvt_pk_bf16(v1[0], v1[1]); w.w = cvt_pk_bf16(v1[2], v1[3]);
                        *(u32x4e*)(base + off) = w;
                    }
                }
        }
    }
};
template <class Epi, class Sched, bool ALIGN_EPI = false, bool SP2 = false>
__device__ __forceinline__ void gemm_phase(PG8_LAS unsigned char* lds, const Gemm g, const Sched& S, const Epi& E) {
    int tid_ = threadIdx.x; asm volatile("" : "+v"(tid_));
    const int tid = tid_, wid = __builtin_amdgcn_readfirstlane(tid >> 6), lane = tid & 63, wr = wid >> 2, wc = wid & 3, fr = lane & 15, fq = lane >> 4;
    const int K = g.K, nt = K / BK;
    unsigned voffA[2], voffB[2];
#pragma unroll
    for (int i = 0; i < 2; ++i) { int R, C; stage_rc(tid * 16 + i * 8192, R, C); const int Rb = Epi::PERM ? ((R & ~31) + perm32(R & 31)) : R;
        voffA[i] = (unsigned)(R * K + C) * 2u; voffB[i] = (unsigned)(Rb * K + C) * 2u; }
    const size_t kstep = (size_t)(BK * 2);
    const size_t hstep = (size_t)HALF * K * 2;
    const size_t tstep = 2 * hstep;
    const unsigned ldsw = (unsigned)wid * 1024u;
    const int aoff = lds_byte(wr * 64 + fr, fq * 8), boff = lds_byte(wc * 32 + fr, fq * 8);
#define PG8_SA(b, h) (((b) * 2 + (h)) * HTB)
#define PG8_SB(b, h) ((4 + (b) * 2 + (h)) * HTB)
#define PG8_STAGE(bufoff, gbase, voff) do { _Pragma("unroll") for (int _i = 0; _i < 2; ++_i) \
        __builtin_amdgcn_global_load_lds((const unsigned*)((const char*)(gbase) + (voff)[_i]), (PG8_LAS unsigned*)(lds + (bufoff) + ldsw + _i * 8192), 16, 0, 0); } while (0)
#define PG8_LDA(dst, b, h) do { _Pragma("unroll") for (int m = 0; m < 4; ++m) _Pragma("unroll") for (int k = 0; k < 2; ++k) dst[m][k] = *(const PG8_LAS bf16x8*)(lds + PG8_SA(b, h) + aoff + m * 2048 + k * 1024); } while (0)
#define PG8_LDB(dst, b, h) do { _Pragma("unroll") for (int n = 0; n < 2; ++n) _Pragma("unroll") for (int k = 0; k < 2; ++k) dst[n][k] = *(const PG8_LAS bf16x8*)(lds + PG8_SB(b, h) + boff + n * 2048 + k * 1024); } while (0)
#define PG8_MMA(ai, bj, At, Bt) do { __builtin_amdgcn_s_setprio(1); _Pragma("unroll") for (int m = 0; m < 4; ++m) _Pragma("unroll") for (int n = 0; n < 2; ++n) _Pragma("unroll") for (int k = 0; k < 2; ++k) \
        acc[ai][bj][m][n] = __builtin_amdgcn_mfma_f32_16x16x32_bf16(Bt[n][k], At[m][k], acc[ai][bj][m][n], 0, 0, 0); __builtin_amdgcn_s_setprio(0); } while (0)
#define PG8_WAIT_V(n) asm volatile("s_waitcnt vmcnt(" #n ")" ::: "memory")
#define PG8_WAIT_L(n) asm volatile("s_waitcnt lgkmcnt(" #n ")" ::: "memory")
#define PG8_BAR __builtin_amdgcn_s_barrier()
#define PG8_SCHED __builtin_amdgcn_sched_barrier(0)
    Unit cur, nxt; int ui = 0;
    if (!S.next(0, cur)) return;
    f32x4 acc[2][2][4][2];
#pragma unroll
    for (int a = 0; a < 2; ++a)
#pragma unroll
        for (int b = 0; b < 2; ++b)
#pragma unroll
            for (int m = 0; m < 4; ++m)
#pragma unroll
                for (int n = 0; n < 2; ++n) acc[a][b][m][n] = (f32x4){0.f, 0.f, 0.f, 0.f};
    bf16x8 At[4][2], B0[2][2], B1[2][2];
    const char* cA = (const char*)g.A + (size_t)cur.pm * tstep; const char* cB = (const char*)g.Bt + (size_t)cur.pn * tstep;
    S.a_ready(cur);
    if constexpr (SP2) {
        PG8_STAGE(PG8_SB(0, 0), cB, voffB); PG8_STAGE(PG8_SB(0, 1), cB + hstep, voffB); PG8_STAGE(PG8_SA(0, 0), cA, voffA); PG8_STAGE(PG8_SA(0, 1), cA + hstep, voffA);
        if (wr == 1) PG8_BAR;
        PG8_WAIT_V(2); PG8_BAR;
        PG8_STAGE(PG8_SB(1, 0), cB + kstep, voffB); PG8_STAGE(PG8_SA(1, 0), cA + kstep, voffA); PG8_STAGE(PG8_SB(1, 1), cB + hstep + kstep, voffB);
        PG8_WAIT_V(6); PG8_BAR;
    } else {
        PG8_STAGE(PG8_SB(0, 0), cB, voffB); PG8_STAGE(PG8_SA(0, 0), cA, voffA); PG8_STAGE(PG8_SB(0, 1), cB + hstep, voffB); PG8_STAGE(PG8_SA(0, 1), cA + hstep, voffA);
        if (wr == 1) PG8_BAR;
        PG8_WAIT_V(4); PG8_BAR;
        PG8_STAGE(PG8_SB(1, 0), cB + kstep, voffB); PG8_STAGE(PG8_SA(1, 0), cA + kstep, voffA); PG8_STAGE(PG8_SB(1, 1), cB + hstep + kstep, voffB);
        PG8_WAIT_V(6); PG8_BAR;
    }
    for (;;) {
        const bool has_next = S.next(ui + 1, nxt);
        const char* nA = has_next ? (const char*)g.A + (size_t)nxt.pm * tstep : cA; const char* nB = has_next ? (const char*)g.Bt + (size_t)nxt.pn * tstep : cB;
        for (int t = 0; t < nt; t += 2) {
            const bool last = (t == nt - 2);
            const char* a1 = cA + (size_t)(t + 1) * kstep;
            const char* a2 = last ? nA : cA + (size_t)(t + 2) * kstep; const char* b2 = last ? nB : cB + (size_t)(t + 2) * kstep;
            const char* a3 = a2 + kstep; const char* b3 = b2 + kstep;
            if (last && has_next) S.a_ready(nxt);
            if constexpr (SP2) {
            PG8_LDB(B0, 0, 0); PG8_LDB(B1, 0, 1); PG8_SCHED; PG8_LDA(At, 0, 0); PG8_STAGE(PG8_SA(1, 1), a1 + hstep, voffA);
            PG8_WAIT_V(8); PG8_WAIT_L(0); PG8_BAR; PG8_MMA(0, 0, At, B0); PG8_MMA(0, 1, At, B1); PG8_BAR; PG8_SCHED;
            PG8_LDA(At, 0, 1); PG8_STAGE(PG8_SB(0, 0), b2, voffB); PG8_STAGE(PG8_SB(0, 1), b2 + hstep, voffB); PG8_STAGE(PG8_SA(0, 0), a2, voffA);
            PG8_WAIT_V(8); PG8_WAIT_L(0); PG8_BAR; PG8_MMA(1, 0, At, B0); PG8_MMA(1, 1, At, B1); PG8_BAR; PG8_SCHED;
            PG8_LDB(B0, 1, 0); PG8_LDB(B1, 1, 1); PG8_SCHED; PG8_LDA(At, 1, 0); PG8_STAGE(PG8_SA(0, 1), a2 + hstep, voffA);
            PG8_WAIT_V(8); PG8_WAIT_L(0); PG8_BAR; PG8_MMA(0, 0, At, B0); PG8_MMA(0, 1, At, B1); PG8_BAR; PG8_SCHED;
            PG8_LDA(At, 1, 1); PG8_STAGE(PG8_SB(1, 0), b3, voffB); PG8_STAGE(PG8_SB(1, 1), b3 + hstep, voffB); PG8_STAGE(PG8_SA(1, 0), a3, voffA);
            PG8_WAIT_V(8); PG8_WAIT_L(0); PG8_BAR; PG8_MMA(1, 0, At, B0); PG8_MMA(1, 1, At, B1); PG8_BAR; PG8_SCHED;
            } else {
            PG8_LDB(B0, 0, 0); PG8_SCHED; PG8_LDA(At, 0, 0); PG8_STAGE(PG8_SA(1, 1), a1 + hstep, voffA);
            PG8_WAIT_L(8); PG8_BAR; PG8_WAIT_L(0); PG8_MMA(0, 0, At, B0); PG8_BAR; PG8_SCHED;
            PG8_LDB(B1, 0, 1); PG8_STAGE(PG8_SB(0, 0), b2, voffB);
            PG8_BAR; PG8_WAIT_L(0); PG8_MMA(0, 1, At, B1); PG8_BAR;
            PG8_LDA(At, 0, 1); PG8_STAGE(PG8_SA(0, 0), a2, voffA);
            PG8_BAR; PG8_WAIT_L(0); PG8_MMA(1, 0, At, B0); PG8_BAR; PG8_SCHED;
            PG8_STAGE(PG8_SB(0, 1), b2 + hstep, voffB);
            PG8_WAIT_V(6); PG8_BAR; PG8_MMA(1, 1, At, B1); PG8_BAR;
            PG8_LDB(B0, 1, 0); PG8_SCHED; PG8_LDA(At, 1, 0); PG8_STAGE(PG8_SA(0, 1), a2 + hstep, voffA);
            PG8_WAIT_L(8); PG8_BAR; PG8_WAIT_L(0); PG8_MMA(0, 0, At, B0); PG8_BAR; PG8_SCHED;
            PG8_LDB(B1, 1, 1); PG8_STAGE(PG8_SB(1, 0), b3, voffB);
            PG8_BAR; PG8_WAIT_L(0); PG8_MMA(0, 1, At, B1); PG8_BAR;
            PG8_LDA(At, 1, 1); PG8_STAGE(PG8_SA(1, 0), a3, voffA);
            PG8_BAR; PG8_WAIT_L(0); PG8_MMA(1, 0, At, B0); PG8_BAR; PG8_SCHED;
            PG8_STAGE(PG8_SB(1, 1), b3 + hstep, voffB);
            PG8_WAIT_V(6); PG8_BAR; PG8_MMA(1, 1, At, B1); PG8_BAR;
            }
        }
        if constexpr (ALIGN_EPI) { if (wr == 0) PG8_BAR; }
        if constexpr (!Epi::AFTER_DRAIN) { E(acc, cur, wr, wc, fr, fq); S.done(cur); }
        if (!has_next) break;
#pragma unroll
        for (int a = 0; a < 2; ++a)
#pragma unroll
            for (int b = 0; b < 2; ++b)
#pragma unroll
                for (int m = 0; m < 4; ++m)
#pragma unroll
                    for (int n = 0; n < 2; ++n) acc[a][b][m][n] = (f32x4){0.f, 0.f, 0.f, 0.f};
        cur = nxt; cA = nA; cB = nB; ++ui;
        if constexpr (ALIGN_EPI) { if (wr == 1) PG8_BAR; }
    }
    PG8_WAIT_V(0);
    if constexpr (!ALIGN_EPI) { if (wr == 0) PG8_BAR; }
    PG8_BAR;
    if constexpr (Epi::AFTER_DRAIN) { E.fused(acc, cur, wr, wc, fr, fq, lds, wid, lane); S.done(cur); }
#undef PG8_SA
#undef PG8_SB
#undef PG8_STAGE
#undef PG8_LDA
#undef PG8_LDB
#undef PG8_MMA
#undef PG8_WAIT_V
#undef PG8_WAIT_L
#undef PG8_BAR
#undef PG8_SCHED
}
}

#define LAS __attribute__((address_space(3)))
typedef unsigned short bf16_t;
typedef short bf16x8 __attribute__((ext_vector_type(8)));
typedef float f32x4 __attribute__((ext_vector_type(4)));
typedef float f32x16 __attribute__((ext_vector_type(16)));
typedef unsigned u32x4 __attribute__((ext_vector_type(4)));
typedef unsigned u32x2 __attribute__((ext_vector_type(2)));
struct Args { const float* in[20]; float* out; unsigned char* ws; int st_lo, st_hi; };

struct Frame {
    LAS unsigned char* lds; int tid, lane, wave, G;
    const float* const* in; float* out; unsigned char* ws;
};
__device__ __forceinline__ float wave_sum(float v) {
#pragma unroll
    for (int o = 1; o < 64; o <<= 1) v += __shfl_xor(v, o);
    return v;
}
__device__ __forceinline__ unsigned pk2(float lo, float hi) { return pg8::cvt_pk_bf16(lo, hi); }
__device__ __forceinline__ float bflo(unsigned w) { return __uint_as_float(w << 16); }
__device__ __forceinline__ float bfhi(unsigned w) { return __uint_as_float(w & 0xffff0000u); }
__device__ __forceinline__ float bf2f(bf16_t b) { return __uint_as_float(((unsigned)b) << 16); }

__device__ __forceinline__ void transpose_item(const float* W, int K, int N, bf16_t* dst_row0  , int k0, int n0, LAS float* scr, int lane, const float* gain) {
#pragma unroll 8
    for (int i = 0; i < 32; ++i) { const int kk = 2 * i + (lane >> 5); scr[kk * 33 + (lane & 31)] = W[(size_t)(k0 + kk) * N + n0 + (lane & 31)] * (gain ? gain[k0 + kk] : 1.f); }
    asm volatile("s_waitcnt lgkmcnt(0)" ::: "memory");
    const int c = lane & 7;
#pragma unroll
    for (int j = 0; j < 4; ++j) { const int n = (lane >> 3) + 8 * j; const LAS float* s = scr + (8 * c) * 33 + n;
        u32x4 o; o.x = pk2(s[0 * 33], s[1 * 33]); o.y = pk2(s[2 * 33], s[3 * 33]); o.z = pk2(s[4 * 33], s[5 * 33]); o.w = pk2(s[6 * 33], s[7 * 33]);
        *(u32x4*)(dst_row0 + (size_t)n * K + k0 + 8 * c) = o; }
    asm volatile("s_waitcnt lgkmcnt(0)" ::: "memory");
}
__device__ __forceinline__ size_t wdst(int mat, int n0) {
    switch (mat) {
    case 0: {
        int r;
        if (n0 < 1024) r = n0;
        else if (n0 < 2048) { const int j = n0 - 1024; r = 1024 + (j >> 7) * 256 + (j & 127); }
        else if (n0 < 3072) { const int j = n0 - 2048; r = 1024 + (j >> 7) * 256 + 128 + (j & 127); }
        else if (n0 < 3744) r = 5120 + (n0 - 3072);
        else r = 3072 + (n0 - 3744);
        return W_IN + (size_t)r * D; }
    case 1: { const int g = n0 >> 5, h = g / 3, part = g % 3; const int r = part < 2 ? h * 64 + part * 32 : 1024 + h * 32; return W_UQ + (size_t)r * QL; }
    case 2: { const int h = n0 >> 7, e = n0 & 127; return e < 64 ? W_UK + (size_t)(h * 64 + e) * KVL : W_UV + (size_t)(h * 64 + e - 64) * KVL; }
    case 3: return W_CONV + (size_t)n0 * D;
    case 4: return W_ATTN + (size_t)n0 * D;
    case 5: return W_MERGE + (size_t)n0 * D;
    case 6: { int r; if (n0 < DFF) r = (n0 >> 7) * 256 + (n0 & 127); else { const int j = n0 - DFF; r = (j >> 7) * 256 + 128 + (j & 127); } return W_GU + (size_t)r * D; }
    default: return W_DOWN + (size_t)n0 * DFF;
    }
}
__device__ __forceinline__ void convert_weights(Frame& F, int l) {
    LAS float* scr = (LAS float*)(F.lds + F.wave * 16384);
    bf16_t* Wb = (bf16_t*)(F.ws + WS_W);
    const int gw = blockIdx.x * NWAVES + F.wave, NGW = F.G * NWAVES;
    constexpr int I0 = 16 * (DIN / 32), I1 = 6 * 48, I2 = 4 * 64, I3 = 16 * 32, I6 = 16 * (2 * DFF / 32), I7 = 44 * 32;
    constexpr int NIT = I0 + I1 + I2 + 3 * I3 + I6 + I7;
    for (int it = gw; it < NIT; it += NGW) {
        int r = it, mat, K, N; const float* src; const float* gain = nullptr;
        if (r < I0) { mat = 0; K = D; N = DIN; src = F.in[5] + (size_t)l * D * DIN; gain = F.in[6] + l * D; }
        else if ((r -= I0) < I1) { mat = 1; K = QL; N = 1536; src = F.in[10] + (size_t)l * QL * 1536; }
        else if ((r -= I1) < I2) { mat = 2; K = KVL; N = 2048; src = F.in[11] + (size_t)l * KVL * 2048; }
        else if ((r -= I2) < I3) { mat = 3; K = D; N = D; src = F.in[13] + (size_t)l * D * D; }
        else if ((r -= I3) < I3) { mat = 4; K = D; N = D; src = F.in[14] + (size_t)l * D * D; }
        else if ((r -= I3) < I3) { mat = 5; K = D; N = D; src = F.in[15] + (size_t)l * D * D; }
        else if ((r -= I3) < I6) { mat = 6; K = D; N = 2 * DFF; src = F.in[18] + (size_t)l * D * 2 * DFF; gain = F.in[16] + l * D; }
        else { r -= I6; mat = 7; K = DFF; N = D; src = F.in[19] + (size_t)l * DFF * D; }
        const int nblk = N / 32, kb = r / nblk, nb = r % nblk;
        transpose_item(src, K, N, Wb + wdst(mat, nb * 32), kb * 64, nb * 32, scr, F.lane, gain);
    }
    for (int i = (blockIdx.x * 512 + F.tid); i < (DINP - DIN) * D / 8; i += F.G * 512) *(u32x4*)(Wb + W_IN + (size_t)DIN * D + (size_t)i * 8) = (u32x4){0u, 0u, 0u, 0u};
}
__device__ __forceinline__ void build_rope(Frame& F) {
    float* rope = (float*)(F.ws + WS_ROPE);
    for (int i = blockIdx.x * 512 + F.tid; i < SKEYS * 16; i += F.G * 512) {
        const int pos = i >> 4, f = i & 15;
        const int a = f & 3; const double q = a == 0 ? 1.0 : (a == 1 ? 0.5623413251903491 : (a == 2 ? 0.31622776601683794 : 0.1778279410038923));
        const int bq = f >> 2; const double p10 = bq == 0 ? 1.0 : (bq == 1 ? 0.1 : (bq == 2 ? 0.01 : 0.001));
        const double rev = (double)pos * (q * p10) * 0.15915494309189535;
        const float fr = (float)(rev - __builtin_rint(rev));
        rope[pos * 32 + f] = __builtin_amdgcn_cosf(fr); rope[pos * 32 + 16 + f] = __builtin_amdgcn_sinf(fr);
    }
}
__device__ __forceinline__ const float* xrow_in(Frame& F, int m) { return m < TP ? F.in[0] + (size_t)m * D : F.in[1] + (size_t)(m - TP) * D; }
__device__ __forceinline__ void store_norm_bf16(bf16_t* orow, const f32x4 (&v)[4], float rstd, const float* g, int lane) {
#pragma unroll
    for (int j = 0; j < 4; ++j) { const f32x4 gg = *(const f32x4*)(g + 4 * lane + 256 * j);
        u32x2 w; w.x = pk2(v[j][0] * rstd * gg[0], v[j][1] * rstd * gg[1]); w.y = pk2(v[j][2] * rstd * gg[2], v[j][3] * rstd * gg[3]);
        *(u32x2*)(orow + 4 * lane + 256 * j) = w; }
}
__device__ __forceinline__ float sumsq16(const f32x4 (&v)[4]) { float s = 0.f;
#pragma unroll
    for (int j = 0; j < 4; ++j) s += (v[j][0] * v[j][0] + v[j][1] * v[j][1]) + (v[j][2] * v[j][2] + v[j][3] * v[j][3]);
    return wave_sum(s); }
__device__ __forceinline__ void store_bf16_row(bf16_t* orow, const f32x4 (&v)[4], int lane) {
#pragma unroll
    for (int j = 0; j < 2; ++j) { u32x4 w; w.x = pk2(v[2 * j][0], v[2 * j][1]); w.y = pk2(v[2 * j][2], v[2 * j][3]); w.z = pk2(v[2 * j + 1][0], v[2 * j + 1][1]); w.w = pk2(v[2 * j + 1][2], v[2 * j + 1][3]); *(u32x4*)(orow + 8 * lane + 512 * j) = w; }
}
__device__ __forceinline__ void load_bf16_row(f32x4 (&v)[4], const bf16_t* irow, int lane) {
#pragma unroll
    for (int j = 0; j < 2; ++j) { const u32x4 w = *(const u32x4*)(irow + 8 * lane + 512 * j); v[2 * j] = (f32x4){bflo(w.x), bfhi(w.x), bflo(w.y), bfhi(w.y)}; v[2 * j + 1] = (f32x4){bflo(w.z), bfhi(w.z), bflo(w.w), bfhi(w.w)}; }
}
constexpr int RB = 4;
__device__ __forceinline__ void phase_norm_in(Frame& F) {
    bf16_t* XA = (bf16_t*)(F.out + O_Y); float* RSA = (float*)(F.ws + WS_RSA);
    const int gw = blockIdx.x * NWAVES + F.wave, NGW = F.G * NWAVES;
    for (int m0 = gw; m0 < T; m0 += RB * NGW) { f32x4 v[RB][4];
#pragma unroll
        for (int q = 0; q < RB; ++q) { const int m = m0 + q * NGW; if (m < T) { const float* xr = xrow_in(F, m);
#pragma unroll
            for (int j = 0; j < 4; ++j) v[q][j] = *(const f32x4*)(xr + 8 * F.lane + 512 * (j >> 1) + 4 * (j & 1)); } }
#pragma unroll
        for (int q = 0; q < RB; ++q) { const int m = m0 + q * NGW; if (m < T) {
            const float rstd = rsqrtf(sumsq16(v[q]) * (1.f / D) + EPS);
            store_bf16_row(XA + (size_t)m * D, v[q], F.lane); if (F.lane == 0) RSA[m] = rstd; } } }
}
__device__ __forceinline__ void phase_h(Frame& F, int l) {
    const bf16_t* XA = (const bf16_t*)(F.out + O_Y); bf16_t* XB = (bf16_t*)(F.ws + WS_R2); float* RSB = (float*)(F.ws + WS_RSB);
    const bf16_t* Mo = (const bf16_t*)(F.ws + WS_R3 + U1);
    const float* gp = F.in[7] + l * D;
    f32x4 gg[4];
#pragma unroll
    for (int j = 0; j < 4; ++j) gg[j] = *(const f32x4*)(gp + 8 * F.lane + 512 * (j >> 1) + 4 * (j & 1));
    const int gw = blockIdx.x * NWAVES + F.wave, NGW = F.G * NWAVES;
    for (int m0 = gw; m0 < T; m0 += RB * NGW) { f32x4 x[RB][4], mm[RB][4];
#pragma unroll
        for (int q = 0; q < RB; ++q) { const int m = m0 + q * NGW; if (m < T) { load_bf16_row(x[q], XA + (size_t)m * D, F.lane); load_bf16_row(mm[q], Mo + (size_t)m * D, F.lane); } }
#pragma unroll
        for (int q = 0; q < RB; ++q) { const int m = m0 + q * NGW; if (m < T) {
            const float rm = rsqrtf(sumsq16(mm[q]) * (1.f / D) + EPS);
#pragma unroll
            for (int j = 0; j < 4; ++j) x[q][j] = x[q][j] + mm[q][j] * rm * gg[j];
            const float rstd = rsqrtf(sumsq16(x[q]) * (1.f / D) + EPS);
            store_bf16_row(XB + (size_t)m * D, x[q], F.lane); if (F.lane == 0) RSB[m] = rstd; } } }
}
__device__ __forceinline__ void phase_k(Frame& F, int l) {
    bf16_t* XA = (bf16_t*)(F.out + O_Y); const bf16_t* XB = (const bf16_t*)(F.ws + WS_R2); float* RSA = (float*)(F.ws + WS_RSA);
    const bf16_t* Fo = (const bf16_t*)(F.ws + WS_R1); float* Y = F.out + O_Y;
    const float* gp = F.in[17] + l * D;
    f32x4 gg[4];
#pragma unroll
    for (int j = 0; j < 4; ++j) gg[j] = *(const f32x4*)(gp + 8 * F.lane + 512 * (j >> 1) + 4 * (j & 1));
    const int gw = blockIdx.x * NWAVES + F.wave, NGW = F.G * NWAVES;
    for (int m0 = gw; m0 < T; m0 += RB * NGW) { f32x4 x[RB][4], mm[RB][4];
#pragma unroll
        for (int q = 0; q < RB; ++q) { const int m = m0 + q * NGW; if (m < T) { load_bf16_row(x[q], XB + (size_t)m * D, F.lane); load_bf16_row(mm[q], Fo + (size_t)m * D, F.lane); } }
#pragma unroll
        for (int q = 0; q < RB; ++q) { const int m = m0 + q * NGW; if (m < T) {
            const float rm = rsqrtf(sumsq16(mm[q]) * (1.f / D) + EPS);
#pragma unroll
            for (int j = 0; j < 4; ++j) x[q][j] = x[q][j] + mm[q][j] * rm * gg[j];
            if (l == 0) { const float rstd = rsqrtf(sumsq16(x[q]) * (1.f / D) + EPS); store_bf16_row(XA + (size_t)m * D, x[q], F.lane); if (F.lane == 0) RSA[m] = rstd; }
            else {
#pragma unroll
                for (int j = 0; j < 4; ++j) *(f32x4*)(Y + (size_t)m * D + 8 * F.lane + 512 * (j >> 1) + 4 * (j & 1)) = x[q][j]; } } } }
}
__device__ __forceinline__ void ld16bf(float (&d)[16], const bf16_t* p) {
    const u32x4 a = *(const u32x4*)p, b = *(const u32x4*)(p + 8);
    d[0] = bflo(a.x); d[1] = bfhi(a.x); d[2] = bflo(a.y); d[3] = bfhi(a.y); d[4] = bflo(a.z); d[5] = bfhi(a.z); d[6] = bflo(a.w); d[7] = bfhi(a.w);
    d[8] = bflo(b.x); d[9] = bfhi(b.x); d[10] = bflo(b.y); d[11] = bfhi(b.y); d[12] = bflo(b.z); d[13] = bfhi(b.z); d[14] = bflo(b.w); d[15] = bfhi(b.w);
}
__device__ __forceinline__ void cvt16(float (&d)[16], const u32x4 a, const u32x4 b) {
    d[0] = bflo(a.x); d[1] = bfhi(a.x); d[2] = bflo(a.y); d[3] = bfhi(a.y); d[4] = bflo(a.z); d[5] = bfhi(a.z); d[6] = bflo(a.w); d[7] = bfhi(a.w);
    d[8] = bflo(b.x); d[9] = bfhi(b.x); d[10] = bflo(b.y); d[11] = bfhi(b.y); d[12] = bflo(b.z); d[13] = bfhi(b.z); d[14] = bflo(b.w); d[15] = bfhi(b.w);
}
__device__ __forceinline__ void ld16f(float (&d)[16], const float* p) {
#pragma unroll
    for (int j = 0; j < 4; ++j) { const f32x4 a = *(const f32x4*)(p + 4 * j); d[4 * j] = a[0]; d[4 * j + 1] = a[1]; d[4 * j + 2] = a[2]; d[4 * j + 3] = a[3]; }
}
__device__ __forceinline__ void phase_c(Frame& F, int l) {
    const bf16_t* Bg = (const bf16_t*)(F.ws + WS_BG); const bf16_t* U = (const bf16_t*)(F.ws + WS_U); const bf16_t* LAT = (const bf16_t*)(F.ws + WS_LAT);
    bf16_t* YAin = (bf16_t*)(F.ws + WS_R0); bf16_t* QLn = (bf16_t*)(F.ws + WS_QLN); bf16_t* Call = (bf16_t*)(F.ws + WS_CALL); bf16_t* KR = (bf16_t*)(F.ws + WS_KR);
    const float* rope = (const float*)(F.ws + WS_ROPE);
    const int lane = F.lane;
    { const float* cc = F.in[3] + (size_t)l * DB * PAST * KVL; const float* ck = F.in[4] + (size_t)l * DB * PAST * RP;
      for (int i = blockIdx.x * 512 + F.tid; i < DB * PAST * KVL / 8; i += F.G * 512) { const int e = i * 8, b = e / (PAST * KVL), r = e % (PAST * KVL);
          const f32x4 a = *(const f32x4*)(cc + e), c = *(const f32x4*)(cc + e + 4);
          *(u32x4*)(Call + (size_t)(TP + b * SKEYS) * KVL + r) = (u32x4){pk2(a[0], a[1]), pk2(a[2], a[3]), pk2(c[0], c[1]), pk2(c[2], c[3])}; }
      for (int i = blockIdx.x * 512 + F.tid; i < DB * PAST * RP / 8; i += F.G * 512) { const int e = i * 8, b = e / (PAST * RP), r = e % (PAST * RP);
          const f32x4 a = *(const f32x4*)(ck + e), c = *(const f32x4*)(ck + e + 4);
          *(u32x4*)(KR + (size_t)(TP + b * SKEYS) * RP + r) = (u32x4){pk2(a[0], a[1]), pk2(a[2], a[3]), pk2(c[0], c[1]), pk2(c[2], c[3])}; } }
    float cw0[16], cw1[16], cw2[16];
    ld16f(cw0, F.in[12] + (size_t)l * 3 * D + 16 * lane); ld16f(cw1, F.in[12] + (size_t)l * 3 * D + D + 16 * lane); ld16f(cw2, F.in[12] + (size_t)l * 3 * D + 2 * D + 16 * lane);
    float gq[8], gk[8];
#pragma unroll
    for (int i = 0; i < 8; ++i) { gq[i] = lane < 48 ? F.in[8][l * QL + 8 * lane + i] : 0.f; gk[i] = lane < 32 ? F.in[9][l * KVL + 8 * lane + i] : 0.f; }
    const int gw = blockIdx.x * NWAVES + F.wave, NGW = F.G * NWAVES;
    for (int run = gw; run < T / 8; run += NGW) {
        const int t0 = run * 8; const bool smp = t0 >= TP;
        const int b = smp ? (t0 - TP) / DSEQ : t0 / SEQ, s0 = smp ? (t0 - TP) % DSEQ : t0 % SEQ, slen = smp ? DSEQ : SEQ;
        float up1[16], up2[16];
        if (s0 == 0) {
            if (smp) { const float* hs = F.in[2] + ((size_t)(l * DB + b) * 2) * D + 16 * lane; ld16f(up2, hs); ld16f(up1, hs + D); }
            else {
#pragma unroll
                for (int i = 0; i < 16; ++i) { up1[i] = 0.f; up2[i] = 0.f; } }
        } else { ld16bf(up1, U + (size_t)(t0 - 1) * D + 16 * lane); ld16bf(up2, U + (size_t)(t0 - 2) * D + 16 * lane); }
#pragma unroll 1
        for (int i4 = 0; i4 < 8; i4 += 2) {
            u32x4 rU[2][2], rB[2][2], rQ[2], rC[2]; unsigned rR1[2], rR2[2];
#pragma unroll
            for (int q = 0; q < 2; ++q) { const int t = t0 + i4 + q; const bf16_t* lat = LAT + (size_t)t * LATP;
                rU[q][0] = *(const u32x4*)(U + (size_t)t * D + 16 * lane); rU[q][1] = *(const u32x4*)(U + (size_t)t * D + 16 * lane + 8);
                rB[q][0] = *(const u32x4*)(Bg + (size_t)t * D + 16 * lane); rB[q][1] = *(const u32x4*)(Bg + (size_t)t * D + 16 * lane + 8);
                rQ[q] = (u32x4){0u, 0u, 0u, 0u}; rC[q] = rQ[q]; rR1[q] = 0u; rR2[q] = 0u;
                if (lane < 48) rQ[q] = *(const u32x4*)(lat + 8 * lane);
                if (lane < 32) rC[q] = *(const u32x4*)(lat + QL + 8 * lane);
                if (lane < 16) { rR1[q] = lat[QL + KVL + lane]; rR2[q] = lat[QL + KVL + 16 + lane]; } }
#pragma unroll
            for (int q = 0; q < 2; ++q) {
            const int t = t0 + i4 + q, s = s0 + i4 + q;
            float uc[16], bg[16], y[16];
            cvt16(uc, rU[q][0], rU[q][1]); cvt16(bg, rB[q][0], rB[q][1]);
#pragma unroll
            for (int i = 0; i < 16; ++i) y[i] = bg[i] * (cw0[i] * up2[i] + cw1[i] * up1[i] + cw2[i] * uc[i]);
            *(u32x4*)(YAin + (size_t)t * D + 16 * lane) = (u32x4){pk2(y[0], y[1]), pk2(y[2], y[3]), pk2(y[4], y[5]), pk2(y[6], y[7])};
            *(u32x4*)(YAin + (size_t)t * D + 16 * lane + 8) = (u32x4){pk2(y[8], y[9]), pk2(y[10], y[11]), pk2(y[12], y[13]), pk2(y[14], y[15])};
            if (s >= slen - 2) {
                float* oc = smp ? F.out + O_CONV_S + ((size_t)(l * DB + b) * 2 + (s - (slen - 2))) * D : F.out + O_CONV_P + ((size_t)(l * NB + b) * 2 + (s - (slen - 2))) * D;
#pragma unroll
                for (int j = 0; j < 4; ++j) *(f32x4*)(oc + 16 * lane + 4 * j) = (f32x4){uc[4 * j], uc[4 * j + 1], uc[4 * j + 2], uc[4 * j + 3]};
            }
#pragma unroll
            for (int i = 0; i < 16; ++i) { up2[i] = up1[i]; up1[i] = uc[i]; }
            const size_t krow = smp ? (size_t)(TP + b * SKEYS + PAST + s) : (size_t)t;
            const int pos = smp ? PAST + s : s;
            { float v[8]; const u32x4 w = rQ[q];
              v[0] = bflo(w.x); v[1] = bfhi(w.x); v[2] = bflo(w.y); v[3] = bfhi(w.y); v[4] = bflo(w.z); v[5] = bfhi(w.z); v[6] = bflo(w.w); v[7] = bfhi(w.w);
              float ss = 0.f;
#pragma unroll
              for (int i = 0; i < 8; ++i) ss += v[i] * v[i];
              const float r = rsqrtf(wave_sum(ss) * (1.f / QL) + EPS);
              if (lane < 48) *(u32x4*)(QLn + (size_t)t * QL + 8 * lane) = (u32x4){pk2(v[0] * r * gq[0], v[1] * r * gq[1]), pk2(v[2] * r * gq[2], v[3] * r * gq[3]), pk2(v[4] * r * gq[4], v[5] * r * gq[5]), pk2(v[6] * r * gq[6], v[7] * r * gq[7])}; }
            { float v[8]; const u32x4 w = rC[q];
              v[0] = bflo(w.x); v[1] = bfhi(w.x); v[2] = bflo(w.y); v[3] = bfhi(w.y); v[4] = bflo(w.z); v[5] = bfhi(w.z); v[6] = bflo(w.w); v[7] = bfhi(w.w);
              float ss = 0.f;
#pragma unroll
              for (int i = 0; i < 8; ++i) ss += v[i] * v[i];
              const float r = rsqrtf(wave_sum(ss) * (1.f / KVL) + EPS);
              if (lane < 32) {
#pragma unroll
                  for (int i = 0; i < 8; ++i) v[i] = v[i] * r * gk[i];
                  float* oc = smp ? F.out + O_CKV_S + ((size_t)l * TS + (t - TP)) * KVL : F.out + O_CKV_P + ((size_t)l * TP + t) * KVL;
                  *(f32x4*)(oc + 8 * lane) = (f32x4){v[0], v[1], v[2], v[3]}; *(f32x4*)(oc + 8 * lane + 4) = (f32x4){v[4], v[5], v[6], v[7]};
                  *(u32x4*)(Call + krow * KVL + 8 * lane) = (u32x4){pk2(v[0], v[1]), pk2(v[2], v[3]), pk2(v[4], v[5]), pk2(v[6], v[7])}; } }
            if (lane < 16) { const float x1 = __uint_as_float(rR1[q] << 16), x2 = __uint_as_float(rR2[q] << 16); const float c = rope[pos * 32 + lane], sn = rope[pos * 32 + 16 + lane];
                const float o1 = x1 * c - x2 * sn, o2 = x1 * sn + x2 * c;
                float* ok = smp ? F.out + O_KR_S + ((size_t)l * TS + (t - TP)) * RP : F.out + O_KR_P + ((size_t)l * TP + t) * RP;
                ok[lane] = o1; ok[16 + lane] = o2;
                KR[krow * RP + lane] = (bf16_t)(pk2(o1, o1) & 0xffffu); KR[krow * RP + 16 + lane] = (bf16_t)(pk2(o2, o2) & 0xffffu); }
            }
        }
    }
}
namespace att {
constexpr int KP = 208, VP = 144, KB = 64 * KP, VB = 64 * VP, BUFB = KB + VB;
struct Ptrs { const bf16_t *Qn, *Qr, *Kn, *Vt, *KR; bf16_t* ATT; const float* rope; };
__device__ __forceinline__ float fmax3(float a, float b, float c) { return fmaxf(fmaxf(a, b), c); }
__device__ __forceinline__ void tile_core(const bf16x8 (&kf)[2][6], const bf16x8 (&vf)[2][4], const bf16x8 (&qf)[6], float& m, float& l, f32x16 (&o)[2], int nvalid, int hi) {
    f32x16 p0, p1;
#pragma unroll
    for (int r = 0; r < 16; ++r) { p0[r] = 0.f; p1[r] = 0.f; }
#pragma unroll
    for (int d0 = 0; d0 < 6; ++d0) { p0 = __builtin_amdgcn_mfma_f32_32x32x16_bf16(kf[0][d0], qf[d0], p0, 0, 0, 0); p1 = __builtin_amdgcn_mfma_f32_32x32x16_bf16(kf[1][d0], qf[d0], p1, 0, 0, 0); }
    if (nvalid < 64) {
#pragma unroll
        for (int r = 0; r < 16; ++r) { const int kv = (r & 3) + 8 * (r >> 2) + 4 * hi; if (kv >= nvalid) p0[r] = -1e30f; if (kv + 32 >= nvalid) p1[r] = -1e30f; }
    }
    float rm = fmax3(p0[0], p0[1], p1[0]);
#pragma unroll
    for (int r = 1; r < 16; ++r) rm = fmax3(rm, p0[r], p1[r]);
    rm = fmaxf(rm, __shfl_xor(rm, 32));
    if (__any(rm > m)) { const float mn = fmaxf(m, rm), f = __builtin_amdgcn_exp2f(m - mn); l *= f; m = mn;
#pragma unroll
        for (int r = 0; r < 16; ++r) { o[0][r] *= f; o[1][r] *= f; } }
    float s = 0.f;
#pragma unroll
    for (int r = 0; r < 16; ++r) { p0[r] = __builtin_amdgcn_exp2f(p0[r] - m); p1[r] = __builtin_amdgcn_exp2f(p1[r] - m); s += p0[r] + p1[r]; }
    l += s;
    bf16x8 pa[4];
    { u32x4 w;
      w = (u32x4){pk2(p0[0], p0[1]), pk2(p0[2], p0[3]), pk2(p0[4], p0[5]), pk2(p0[6], p0[7])}; pa[0] = __builtin_bit_cast(bf16x8, w);
      w = (u32x4){pk2(p0[8], p0[9]), pk2(p0[10], p0[11]), pk2(p0[12], p0[13]), pk2(p0[14], p0[15])}; pa[1] = __builtin_bit_cast(bf16x8, w);
      w = (u32x4){pk2(p1[0], p1[1]), pk2(p1[2], p1[3]), pk2(p1[4], p1[5]), pk2(p1[6], p1[7])}; pa[2] = __builtin_bit_cast(bf16x8, w);
      w = (u32x4){pk2(p1[8], p1[9]), pk2(p1[10], p1[11]), pk2(p1[12], p1[13]), pk2(p1[14], p1[15])}; pa[3] = __builtin_bit_cast(bf16x8, w); }
#pragma unroll
    for (int db = 0; db < 2; ++db)
#pragma unroll
        for (int s4 = 0; s4 < 4; ++s4) o[db] = __builtin_amdgcn_mfma_f32_32x32x16_bf16(vf[db][s4], pa[s4], o[db], 0, 0, 0);
}
__device__ __forceinline__ void load_q(bf16x8 (&qf)[6], const bf16_t* qn, const bf16_t* qr, const float* rp, int hi) {
#pragma unroll
    for (int d0 = 0; d0 < 4; ++d0) qf[d0] = *(const bf16x8*)(qn + d0 * 16 + hi * 8);
    const u32x4 a = *(const u32x4*)(qr + hi * 8), b = *(const u32x4*)(qr + 16 + hi * 8);
    const f32x4 c0 = *(const f32x4*)(rp + hi * 8), c1 = *(const f32x4*)(rp + hi * 8 + 4), s0 = *(const f32x4*)(rp + 16 + hi * 8), s1 = *(const f32x4*)(rp + 16 + hi * 8 + 4);
    const float x1[8] = {bflo(a.x), bfhi(a.x), bflo(a.y), bfhi(a.y), bflo(a.z), bfhi(a.z), bflo(a.w), bfhi(a.w)};
    const float x2[8] = {bflo(b.x), bfhi(b.x), bflo(b.y), bfhi(b.y), bflo(b.z), bfhi(b.z), bflo(b.w), bfhi(b.w)};
    const float cs[8] = {c0[0], c0[1], c0[2], c0[3], c1[0], c1[1], c1[2], c1[3]}, sn[8] = {s0[0], s0[1], s0[2], s0[3], s1[0], s1[1], s1[2], s1[3]};
    float o1[8], o2[8];
#pragma unroll
    for (int j = 0; j < 8; ++j) { o1[j] = x1[j] * cs[j] - x2[j] * sn[j]; o2[j] = x1[j] * sn[j] + x2[j] * cs[j]; }
    u32x4 w1 = (u32x4){pk2(o1[0], o1[1]), pk2(o1[2], o1[3]), pk2(o1[4], o1[5]), pk2(o1[6], o1[7])}, w2 = (u32x4){pk2(o2[0], o2[1]), pk2(o2[2], o2[3]), pk2(o2[4], o2[5]), pk2(o2[6], o2[7])};
    qf[4] = __builtin_bit_cast(bf16x8, w1); qf[5] = __builtin_bit_cast(bf16x8, w2);
}
__device__ __forceinline__ void prompt_unit(LAS unsigned char* lds, const Ptrs& P, int qloc0, int qglob0, int kloc0, int kglob0, int h, int qb) {
    int tid_ = threadIdx.x; asm volatile("" : "+v"(tid_));
    const int tid = tid_, lane = tid & 63, r32 = lane & 31, hi = lane >> 5; const int wid = __builtin_amdgcn_readfirstlane(tid >> 6);
    const int NTL = 4 * qb + 4, cq = 4 * qb + (wid >> 1);
    bf16x8 qf[6];
    { const int ql = qloc0 + 32 * wid + r32, pos = qb * 256 + 32 * wid + r32;
      load_q(qf, P.Qn + (size_t)ql * 1024 + h * 64, P.Qr + (size_t)ql * 512 + h * 32, P.rope + pos * 32, hi); }
    const bf16_t* kn_src = P.Kn + (size_t)(kloc0 + (tid >> 3)) * 1024 + h * 64 + (tid & 7) * 8;
    const bf16_t* vt_src = P.Vt + (size_t)(h * 64 + (tid >> 3)) * VT_LD + kloc0 + (tid & 7) * 8;
    const bf16_t* kr_src = P.KR + (size_t)(kglob0 + ((tid & 255) >> 2)) * 32 + (tid & 3) * 8;
    const int k_w = (tid >> 3) * KP + (tid & 7) * 16, r_w = ((tid & 255) >> 2) * KP + 128 + (tid & 3) * 16;
    const int v_w = KB + (tid >> 3) * VP + ((tid & 7) >> 1) * 32 + (tid & 1) * 8;
    u32x4 kreg, vreg, rreg = (u32x4){0u, 0u, 0u, 0u};
    kreg = *(const u32x4*)kn_src; vreg = *(const u32x4*)vt_src; if (tid < 256) rreg = *(const u32x4*)kr_src;
    *(LAS u32x4*)(lds + k_w) = kreg; if (tid < 256) *(LAS u32x4*)(lds + r_w) = rreg;
    *(LAS u32x2*)(lds + v_w) = (u32x2){vreg.x, vreg.y}; *(LAS u32x2*)(lds + v_w + 16) = (u32x2){vreg.z, vreg.w};
    __syncthreads();
    float m = -1e30f, l = 0.f; f32x16 o[2];
#pragma unroll
    for (int r = 0; r < 16; ++r) { o[0][r] = 0.f; o[1][r] = 0.f; }
    for (int j = 0; j < NTL; ++j) {
        const bool more = j + 1 < NTL;
        if (more) { kreg = *(const u32x4*)(kn_src + (size_t)(j + 1) * 64 * 1024); vreg = *(const u32x4*)(vt_src + (j + 1) * 64); if (tid < 256) rreg = *(const u32x4*)(kr_src + (size_t)(j + 1) * 64 * 32); }
        if (j <= cq) {
            const LAS unsigned char* buf = lds + (j & 1) * BUFB;
            bf16x8 kf[2][6], vf[2][4];
#pragma unroll
            for (int kb = 0; kb < 2; ++kb)
#pragma unroll
                for (int d0 = 0; d0 < 6; ++d0) kf[kb][d0] = *(const LAS bf16x8*)(buf + (kb * 32 + r32) * KP + d0 * 32 + hi * 16);
#pragma unroll
            for (int db = 0; db < 2; ++db)
#pragma unroll
                for (int s4 = 0; s4 < 4; ++s4) vf[db][s4] = *(const LAS bf16x8*)(buf + KB + (db * 32 + r32) * VP + s4 * 32 + hi * 16);
            tile_core(kf, vf, qf, m, l, o, 64, hi);
        }
        if (more) { LAS unsigned char* nb = lds + ((j + 1) & 1) * BUFB;
            *(LAS u32x4*)(nb + k_w) = kreg; if (tid < 256) *(LAS u32x4*)(nb + r_w) = rreg;
            *(LAS u32x2*)(nb + v_w) = (u32x2){vreg.x, vreg.y}; *(LAS u32x2*)(nb + v_w + 16) = (u32x2){vreg.z, vreg.w}; }
        __syncthreads();
    }
    l += __shfl_xor(l, 32);
    const float inv = 1.0f / l;
    bf16_t* orow = P.ATT + (size_t)(qglob0 + 32 * wid + r32) * 1024 + h * 64;
#pragma unroll
    for (int db = 0; db < 2; ++db)
#pragma unroll
        for (int g = 0; g < 4; ++g) { u32x2 w; w.x = pk2(o[db][4 * g] * inv, o[db][4 * g + 1] * inv); w.y = pk2(o[db][4 * g + 2] * inv, o[db][4 * g + 3] * inv);
            *(u32x2*)(orow + 32 * db + 8 * g + 4 * hi) = w; }
}
__device__ __forceinline__ void sample_unit(LAS unsigned char* lds, const Ptrs& P, int b, int h) {
    int tid_ = threadIdx.x; asm volatile("" : "+v"(tid_));
    const int tid = tid_, lane = tid & 63, r32 = lane & 31, hi = lane >> 5; const int wid = __builtin_amdgcn_readfirstlane(tid >> 6);
    const int qglob0 = TP + b * DSEQ, qloc0 = qglob0 - G0_ROWS, kglob0 = TP + b * SKEYS, kloc0 = kglob0 - G0_ROWS;
    bf16x8 qf[6];
    load_q(qf, P.Qn + (size_t)(qloc0 + r32) * 1024 + h * 64, P.Qr + (size_t)(qloc0 + r32) * 512 + h * 32, P.rope + (PAST + r32) * 32, hi);
    float m = -1e30f, l = 0.f; f32x16 o[2];
#pragma unroll
    for (int r = 0; r < 16; ++r) { o[0][r] = 0.f; o[1][r] = 0.f; }
    constexpr int NTS = (SKEYS + 63) / 64;
    for (int j = wid; j < NTS; j += NWAVES) {
        const int nvalid = (SKEYS - j * 64) < 64 ? (SKEYS - j * 64) : 64;
        bf16x8 kf[2][6], vf[2][4];
#pragma unroll
        for (int kb = 0; kb < 2; ++kb) { int key = j * 64 + kb * 32 + r32; key = key < SKEYS ? key : SKEYS - 1;
            const bf16_t* kn = P.Kn + (size_t)(kloc0 + key) * 1024 + h * 64 + hi * 8; const bf16_t* kr = P.KR + (size_t)(kglob0 + key) * 32 + hi * 8;
#pragma unroll
            for (int d0 = 0; d0 < 4; ++d0) kf[kb][d0] = *(const bf16x8*)(kn + d0 * 16);
            kf[kb][4] = *(const bf16x8*)(kr); kf[kb][5] = *(const bf16x8*)(kr + 16); }
#pragma unroll
        for (int db = 0; db < 2; ++db) { const bf16_t* vr = P.Vt + (size_t)(h * 64 + db * 32 + r32) * VT_LD + kloc0 + j * 64 + 4 * hi;
#pragma unroll
            for (int s4 = 0; s4 < 4; ++s4) { u32x2 a = (u32x2){0u, 0u}, c = (u32x2){0u, 0u};
                if (16 * s4 + 4 * hi < nvalid) a = *(const u32x2*)(vr + 16 * s4); if (16 * s4 + 8 + 4 * hi < nvalid) c = *(const u32x2*)(vr + 16 * s4 + 8);
                const u32x4 w = (u32x4){a.x, a.y, c.x, c.y}; vf[db][s4] = __builtin_bit_cast(bf16x8, w); } }
        tile_core(kf, vf, qf, m, l, o, nvalid, hi);
    }
    l += __shfl_xor(l, 32);
    LAS float* OL = (LAS float*)lds + wid * (32 * 68); LAS float* ML = (LAS float*)(lds + NWAVES * 32 * 68 * 4);
#pragma unroll
    for (int db = 0; db < 2; ++db)
#pragma unroll
        for (int g = 0; g < 4; ++g) *(LAS f32x4*)(OL + r32 * 68 + 32 * db + 8 * g + 4 * hi) = (f32x4){o[db][4 * g], o[db][4 * g + 1], o[db][4 * g + 2], o[db][4 * g + 3]};
    if (hi == 0) { ML[wid * 64 + r32] = m; ML[wid * 64 + 32 + r32] = l; }
    __syncthreads();
    { const int q = tid >> 4, d = (tid & 15) * 4; float M = -1e30f;
#pragma unroll
      for (int w = 0; w < NWAVES; ++w) M = fmaxf(M, ML[w * 64 + q]);
      float L = 0.f; f32x4 acc = (f32x4){0.f, 0.f, 0.f, 0.f};
#pragma unroll
      for (int w = 0; w < NWAVES; ++w) { const float f = __builtin_amdgcn_exp2f(ML[w * 64 + q] - M); L += f * ML[w * 64 + 32 + q]; acc = acc + *(const LAS f32x4*)((LAS float*)lds + w * (32 * 68) + q * 68 + d) * f; }
      const float inv = 1.0f / L; u32x2 wv; wv.x = pk2(acc[0] * inv, acc[1] * inv); wv.y = pk2(acc[2] * inv, acc[3] * inv);
      *(u32x2*)(P.ATT + (size_t)(qglob0 + q) * 1024 + h * 64 + d) = wv; }
    __syncthreads();
}
__device__ __forceinline__ void attn_phase(LAS unsigned char* lds, const Ptrs& P, int g, int G) {
    const int vb = (G % 8 == 0) ? (int)((blockIdx.x & 7) * (G >> 3) + (blockIdx.x >> 3)) : (int)blockIdx.x;
    for (int pi = vb; pi < 512; pi += G) { const int combo = pi >> 2, s = pi & 3, bl = combo >> 4, h = combo & 15;
        const int brow_glob = (g * 8 + bl) * SEQ, brow_loc = brow_glob - g * G0_ROWS;
#pragma unroll 1
        for (int hf = 0; hf < 2; ++hf) { const int qb = hf ? 7 - s : s; prompt_unit(lds, P, brow_loc + qb * 256, brow_glob + qb * 256, brow_loc, brow_glob, h, qb); } }
    if (g == 1) for (int ui = blockIdx.x; ui < DB * NH; ui += G) sample_unit(lds, P, ui >> 4, ui & 15);
}
}
#define XB_TMO      128
#define XB_XCNT(j)  (256  + 64 * (j))
#define XB_XSUB(j)  (1280 + 64 * (j))
#define XB_XGEN(j)  (2304 + 64 * (j))
#define XB_TOP      3328
#define XB_TOPGEN   3392
#define XCD_BAR_WORDS 3456
#define XB_SPIN_CAP (1u << 18)

__device__ __forceinline__ unsigned xb_ld(unsigned* p)              { return __hip_atomic_load(p, __ATOMIC_RELAXED, __HIP_MEMORY_SCOPE_AGENT); }
__device__ __forceinline__ unsigned xb_add(unsigned* p, unsigned v) { return __hip_atomic_fetch_add(p, v, __ATOMIC_RELAXED, __HIP_MEMORY_SCOPE_AGENT); }
__device__ __forceinline__ unsigned xb_xcc_id() { return (unsigned)__builtin_amdgcn_s_getreg((3 << 11) | 20) & 0xFu; }
#define XB_SPIN(cond, bar) do { unsigned _sp = 0; while (cond) { __builtin_amdgcn_s_sleep(1); \
    if ((++_sp & 255u) == 0u) { if (xb_ld(&(bar)[XB_TMO])) break; if (_sp > XB_SPIN_CAP) { atomicAdd(&(bar)[XB_TMO], 1u); break; } } } } while (0)

struct XcdBarrier {
    unsigned* bar; unsigned x;
    volatile __attribute__((address_space(3))) unsigned* st;
};

__device__ __forceinline__ XcdBarrier xcd_barrier_post(unsigned* bar, volatile __attribute__((address_space(3))) unsigned* st) {
    XcdBarrier b; b.bar = bar; b.x = xb_xcc_id(); b.st = st;
    if (threadIdx.x == 0) (void)xb_add(&bar[XB_XCNT(b.x)], 1u);
    return b;
}
__device__ __forceinline__ void xcd_barrier_complete(unsigned* bar, unsigned x, unsigned& nloc, unsigned& nx) {
    const unsigned G = gridDim.x * gridDim.y * gridDim.z;
    unsigned sum, cnt, mine, sp = 0u;
    for (;;) {
        sum = 0u; cnt = 0u; mine = 0u;
#pragma unroll
        for (unsigned j = 0; j < 16; ++j) { const unsigned c = xb_ld(&bar[XB_XCNT(j)]); sum += c; cnt += (c > 0u) ? 1u : 0u; mine = (j == x) ? c : mine; }
        if (sum == G) break;
        __builtin_amdgcn_s_sleep(1);
        if ((++sp & 255u) == 0u) { if (xb_ld(&bar[XB_TMO])) break; if (sp > XB_SPIN_CAP) { atomicAdd(&bar[XB_TMO], 1u); break; } }
    }
    nloc = mine > 0u ? mine : 1u; nx = cnt > 0u ? cnt : 1u;
}

__device__ __forceinline__ void xcd_barrier(const XcdBarrier& b) {
    asm volatile("s_waitcnt vmcnt(0)" ::: "memory");
    __syncthreads();
    if (threadIdx.x == 0) {
        unsigned* bar = b.bar;
        __builtin_amdgcn_s_waitcnt(0);
        unsigned nloc = b.st[0], nx = b.st[1];
        if (nloc == 0u) { xcd_barrier_complete(bar, b.x, nloc, nx); b.st[0] = nloc; b.st[1] = nx; }
        const unsigned old = xb_add(&bar[XB_XSUB(b.x)], 1u);
        const unsigned gen = old / nloc;
        if (old + 1u == (gen + 1u) * nloc) {
            __builtin_amdgcn_fence(__ATOMIC_RELEASE, "agent");
            asm volatile("s_waitcnt vmcnt(0)" ::: "memory");
            const unsigned og = xb_add(&bar[XB_TOP], 1u);
            const unsigned tg = og / nx;
            if (og + 1u == (tg + 1u) * nx) xb_add(&bar[XB_TOPGEN], 1u);
            else XB_SPIN(xb_ld(&bar[XB_TOPGEN]) == tg, bar);
            __builtin_amdgcn_fence(__ATOMIC_ACQUIRE, "agent");
            xb_add(&bar[XB_XGEN(b.x)], 1u);
            asm volatile("s_waitcnt vmcnt(0)" ::: "memory");
        } else {
            XB_SPIN(xb_ld(&bar[XB_XGEN(b.x)]) == gen, bar);
            __builtin_amdgcn_fence(__ATOMIC_ACQUIRE, "agent");
            asm volatile("s_waitcnt vmcnt(0)" ::: "memory");
        }
    }
    __syncthreads();
}

__device__ __forceinline__ void small_gemm(LAS unsigned char* lds, unsigned char* ws, size_t oA, size_t oB, int N_out, int K, int kind, size_t oO, int ldc, int G) {
    int tid_ = threadIdx.x; asm volatile("" : "+v"(tid_));
    const int tid = tid_, lane = tid & 63, r32 = lane & 31, hi = lane >> 5; const int wid = __builtin_amdgcn_readfirstlane(tid >> 6);
    const int kq = wid & 3, rh = wid >> 2;
    const bool paired = kind == pg8::EK_SWIGLU;
    const int nitems = 4 * (N_out / 64);
    const bf16_t* A = (const bf16_t*)(ws + oA) + (size_t)TP * K; const bf16_t* Bt = (const bf16_t*)(ws + oB);
    const int kslice = K / 4, k0 = kq * kslice;
    LAS float* PA = (LAS float*)lds; LAS float* PB = (LAS float*)(lds + 65536);
    for (int it = blockIdx.x; it < nitems; it += G) {
        const int rb = it & 3, cg = it >> 2;
        int browa, ocol;
        if (paired) { const int tile = cg >> 1, half = cg & 1; browa = tile * 256 + half * 64; ocol = tile * 128 + half * 64; } else { browa = cg * 64; ocol = cg * 64; }
        const bf16_t* ap = A + (size_t)(rb * 64 + rh * 32 + r32) * K + k0 + 8 * hi;
        const bf16_t* bp0 = Bt + (size_t)(browa + r32) * K + k0 + 8 * hi;
        f32x16 ca[2], cb[2];
#pragma unroll
        for (int r = 0; r < 16; ++r) { ca[0][r] = 0.f; ca[1][r] = 0.f; cb[0][r] = 0.f; cb[1][r] = 0.f; }
        if (paired) {
#pragma unroll 2
            for (int k = 0; k < kslice; k += 16) {
                const bf16x8 af = *(const bf16x8*)(ap + k);
                const bf16x8 b0 = *(const bf16x8*)(bp0 + k), b1 = *(const bf16x8*)(bp0 + (size_t)32 * K + k), b2 = *(const bf16x8*)(bp0 + (size_t)128 * K + k), b3 = *(const bf16x8*)(bp0 + (size_t)160 * K + k);
                ca[0] = __builtin_amdgcn_mfma_f32_32x32x16_bf16(af, b0, ca[0], 0, 0, 0); ca[1] = __builtin_amdgcn_mfma_f32_32x32x16_bf16(af, b1, ca[1], 0, 0, 0);
                cb[0] = __builtin_amdgcn_mfma_f32_32x32x16_bf16(af, b2, cb[0], 0, 0, 0); cb[1] = __builtin_amdgcn_mfma_f32_32x32x16_bf16(af, b3, cb[1], 0, 0, 0);
            }
        } else {
#pragma unroll 4
            for (int k = 0; k < kslice; k += 16) {
                const bf16x8 af = *(const bf16x8*)(ap + k);
                const bf16x8 b0 = *(const bf16x8*)(bp0 + k), b1 = *(const bf16x8*)(bp0 + (size_t)32 * K + k);
                ca[0] = __builtin_amdgcn_mfma_f32_32x32x16_bf16(af, b0, ca[0], 0, 0, 0); ca[1] = __builtin_amdgcn_mfma_f32_32x32x16_bf16(af, b1, ca[1], 0, 0, 0);
            }
        }
#pragma unroll
        for (int nb = 0; nb < 2; ++nb)
#pragma unroll
            for (int r = 0; r < 16; ++r) { PA[((kq * 4 + rh * 2 + nb) * 16 + r) * 64 + lane] = ca[nb][r]; if (paired) PB[((kq * 4 + rh * 2 + nb) * 16 + r) * 64 + lane] = cb[nb][r]; }
        __syncthreads();
        { const int blk = tid >> 7, r = (tid >> 3) & 15, h2 = (tid >> 2) & 1, g = tid & 3;
          f32x4 v0 = (f32x4){0.f, 0.f, 0.f, 0.f}, v1 = v0, w0 = v0, w1 = v0;
#pragma unroll
          for (int q = 0; q < 4; ++q) { const int o = ((q * 4 + blk) * 16 + r) * 64 + h2 * 32 + 8 * g;
              v0 = v0 + *(const LAS f32x4*)(PA + o); v1 = v1 + *(const LAS f32x4*)(PA + o + 4);
              if (paired) { w0 = w0 + *(const LAS f32x4*)(PB + o); w1 = w1 + *(const LAS f32x4*)(PB + o + 4); } }
          const int orow = TP + rb * 64 + (blk >> 1) * 32 + (r & 3) + 8 * (r >> 2) + 4 * h2, c = ocol + (blk & 1) * 32 + 8 * g;
          const size_t off = (size_t)orow * ldc + c; bf16_t* O = (bf16_t*)(ws + oO);
          if (kind == pg8::EK_SWIGLU) {
              { const float rr = ((const float*)(ws + WS_RSB))[orow]; v0 = v0 * rr; v1 = v1 * rr; w0 = w0 * rr; w1 = w1 * rr; }
#pragma unroll
              for (int i = 0; i < 4; ++i) { v0[i] = v0[i] * pg8::sigm(v0[i]) * w0[i]; v1[i] = v1[i] * pg8::sigm(v1[i]) * w1[i]; }
          } else if (kind == pg8::EK_GATE) { const u32x4 gg = *(const u32x4*)((const bf16_t*)(ws + WS_R1) + off);
              v0[0] *= bflo(gg.x); v0[1] *= bfhi(gg.x); v0[2] *= bflo(gg.y); v0[3] *= bfhi(gg.y); v1[0] *= bflo(gg.z); v1[1] *= bfhi(gg.z); v1[2] *= bflo(gg.w); v1[3] *= bfhi(gg.w);
          } else if (kind == pg8::EK_COMBINE) { const u32x4 y = *(const u32x4*)((const bf16_t*)(ws + WS_R1) + off); const u32x4 gg = *(const u32x4*)((const bf16_t*)(ws + WS_R2) + off);
              v0[0] = bflo(y.x) + bflo(gg.x) * v0[0]; v0[1] = bfhi(y.x) + bfhi(gg.x) * v0[1]; v0[2] = bflo(y.y) + bflo(gg.y) * v0[2]; v0[3] = bfhi(y.y) + bfhi(gg.y) * v0[3];
              v1[0] = bflo(y.z) + bflo(gg.z) * v1[0]; v1[1] = bfhi(y.z) + bfhi(gg.z) * v1[1]; v1[2] = bflo(y.w) + bflo(gg.w) * v1[2]; v1[3] = bfhi(y.w) + bfhi(gg.w) * v1[3]; }
          *(u32x4*)(O + off) = (u32x4){pk2(v0[0], v0[1]), pk2(v0[2], v0[3]), pk2(v1[0], v1[1]), pk2(v1[2], v1[3])}; }
        __syncthreads();
    }
}

constexpr int NSTEP = 18;
__host__ __device__ constexpr bool step_sync(int l, int s) { return !(s == 3 || s == 4 || s == 5 || s == 8 || s == 9 || (s == 0 && l != 0)); }
__device__ __forceinline__ void run_gemm(Frame& F, int s) {
    unsigned char* ws = F.ws;
    const int grp = (s >= 8) ? 1 : 0;
    size_t oA = WS_R0, oB = WS_W, oO = WS_R1;
    int M = T, N = D, K = D, kind = pg8::EK_PLAIN, ldc = 1024, rot = 0; float scale = 1.f;
    if (s == 1) { oB = WS_W + W_IN * 2; N = DINP; kind = pg8::EK_WIN; oO = WS_BG; }
    else if (s == 3) { oB = WS_W + W_CONV * 2; kind = pg8::EK_GATE; oO = WS_R1; }
    else if (s == 4 || s == 8) { oA = WS_QLN + (size_t)grp * G0_ROWS * QL * 2; oB = WS_W + W_UQ * 2; M = grp ? G1_ROWS : G0_ROWS; N = 1536; K = QL; kind = pg8::EK_Q; oO = WS_QN; scale = QSCALE; rot = grp ? 0 : 128; }
    else if (s == 5 || s == 9) { oA = WS_CALL + (size_t)grp * G0_ROWS * KVL * 2; oB = WS_W + W_UK * 2; M = grp ? G1_KEYS : G0_ROWS; N = 1024; K = KVL; oO = WS_KN; rot = grp ? 112 : 0; }
    else if (s == 6 || s == 10) { oA = WS_W + W_UV * 2; oB = WS_CALL + (size_t)grp * G0_ROWS * KVL * 2; M = 1024; N = grp ? G1_KEYS : G0_ROWS; K = KVL; oO = WS_VT; ldc = VT_LD; rot = grp ? 104 : 0; }
    else if (s == 12) { oB = WS_W + W_ATTN * 2; kind = pg8::EK_COMBINE; oO = WS_R3; }
    else if (s == 13) { oA = WS_R3; oB = WS_W + W_MERGE * 2; oO = WS_R3 + U1; }
    else if (s == 15) { oA = WS_R2; oB = WS_W + W_GU * 2; N = 2 * DFF; kind = pg8::EK_SWIGLU; oO = WS_R3; ldc = DFF; }
    else { oA = WS_R3; oB = WS_W + W_DOWN * 2; K = DFF; oO = WS_R1; }
    const bool split_sample = (s == 3 || s == 12 || s == 13 || s == 15 || s == 16);
    if (split_sample) M = TP;
    const pg8::bf16_t* Ap = (s == 1) ? (const pg8::bf16_t*)(F.out + O_Y) : (const pg8::bf16_t*)(ws + oA);
    const pg8::Gemm g{Ap, (const pg8::bf16_t*)(ws + oB), M, N, K};
    const pg8::EpiX E{kind, ws, oO, ldc, scale, (s == 15) ? WS_RSB : WS_RSA, (s == 1 || s == 15) ? 1 : 0};
    pg8::StaticOrder S; S.init(g.M, g.N, F.G, (int)((blockIdx.x + rot) % F.G));
    pg8::gemm_phase<pg8::EpiX, pg8::StaticOrder, true, true>(F.lds, g, S, E);
    if (split_sample) small_gemm(F.lds, ws, oA, oB, kind == pg8::EK_SWIGLU ? N / 2 : N, K, kind, oO, ldc, F.G);
}

__global__ void __launch_bounds__(NWAVES * 64, 2) fwd_mega(Args args) {
    extern __shared__ __attribute__((aligned(16))) unsigned char lds_raw[];
    cg::grid_group grid = cg::this_grid();
    Frame F;
    F.lds = (LAS unsigned char*)lds_raw; F.tid = threadIdx.x; F.lane = F.tid & 63; F.wave = __builtin_amdgcn_readfirstlane(F.tid >> 6); F.G = gridDim.x;
    F.in = args.in;
    F.out = args.out; F.ws = args.ws;
    volatile LAS unsigned* bst = (volatile LAS unsigned*)(F.lds + 131072);
    if (F.tid < 64) bst[F.tid] = 0u;
    __syncthreads();
    XcdBarrier bar = xcd_barrier_post((unsigned*)(args.ws) + 1024, bst + 8);
    for (int vst = args.st_lo * 2; vst < args.st_hi * 2; ++vst) {
        const int st = vst >> 1, rep = vst & 1;
        const int l = st / NSTEP, s = st % NSTEP;
        { int t_ = threadIdx.x; asm volatile("" : "+v"(t_)); F.tid = t_; F.lane = t_ & 63; F.wave = __builtin_amdgcn_readfirstlane(t_ >> 6); }
#ifndef PROBE_GEMM
#define PROBE_GEMM 0
#endif
#ifndef PROBE_ATT
#define PROBE_ATT 0
#endif
        const bool is_g = (s == 1 || s == 4 || s == 5 || s == 6 || s == 8 || s == 9 || s == 10 || s == 12 || s == 13 || s == 15 || s == 16);
        const int reps = ((PROBE_GEMM && is_g) || (PROBE_ATT && (s == 7 || s == 11))) ? 2 : 1;
        if (rep >= reps) continue;
        if (l == 0 && (s == 0 || s == 17)) convert_weights(F, s == 0 ? 0 : 1);
        if (s == 0) { if (l == 0) { build_rope(F); phase_norm_in(F); } }
        else if (s == 2) phase_c(F, l);
        else if (s == 7 || s == 11) {
            att::Ptrs P; P.Qn = (const bf16_t*)(F.ws + WS_QN); P.Qr = (const bf16_t*)(F.ws + WS_QR); P.Kn = (const bf16_t*)(F.ws + WS_KN); P.Vt = (const bf16_t*)(F.ws + WS_VT);
            P.KR = (const bf16_t*)(F.ws + WS_KR); P.ATT = (bf16_t*)(F.ws + WS_R0); P.rope = (const float*)(F.ws + WS_ROPE);
            att::attn_phase(F.lds, P, s == 7 ? 0 : 1, F.G);
        }
        else if (s == 14) phase_h(F, l);
        else if (s == 17) phase_k(F, l);
        else run_gemm(F, s);
        if (rep + 1 == reps && step_sync(l, s) && st + 1 < args.st_hi) { if (args.st_lo < 0) grid.sync(); else xcd_barrier(bar); }
    }
}

#ifndef MK_MULTI
#define MK_MULTI 0
#endif
extern "C" void kernel_launch(void* const* d_in, const int* in_sizes, int n_in, void* d_out, int out_size, void* d_ws, size_t ws_size, hipStream_t stream) {
    static int grid_blocks = 0;
    if (grid_blocks == 0) {
        if (n_in != 20 || out_size != (int)O_END || ws_size < WS_END) { fprintf(stderr, "kernel_launch: unexpected shapes n_in %d out %d ws %zu (need %zu)\n", n_in, out_size, ws_size, (size_t)WS_END); grid_blocks = -1; return; }
        int dev = 0, cus = 0, per_cu = 0;
        (void)hipGetDevice(&dev); (void)hipDeviceGetAttribute(&cus, hipDeviceAttributeMultiprocessorCount, dev);
        (void)hipFuncSetAttribute((const void*)fwd_mega, hipFuncAttributeMaxDynamicSharedMemorySize, LDS_BYTES);
        (void)hipOccupancyMaxActiveBlocksPerMultiprocessor(&per_cu, (const void*)fwd_mega, NWAVES * 64, LDS_BYTES);
        if (per_cu < 1) per_cu = 1;
        if (cus <= 0) cus = 256;
        grid_blocks = cus * per_cu;
    }
    if (grid_blocks < 0) return;
    Args a{};
    for (int i = 0; i < 20; ++i) a.in[i] = (const float*)d_in[i];
    a.out = (float*)d_out; a.ws = (unsigned char*)d_ws;
    (void)hipMemsetAsync(d_ws, 0, 65536, stream);
#if MK_MULTI
    int lo = 0;
    for (int st = 0; st < 2 * NSTEP; ++st) {
        if (step_sync(st / NSTEP, st % NSTEP) || st + 1 == 2 * NSTEP) { a.st_lo = lo; a.st_hi = st + 1; hipLaunchKernelGGL(fwd_mega, dim3(grid_blocks), dim3(NWAVES * 64), LDS_BYTES, stream, a); lo = st + 1; }
    }
#else
    a.st_lo = 0; a.st_hi = 2 * NSTEP;
    void* params[] = {&a};
    hipError_t e = hipLaunchCooperativeKernel((const void*)fwd_mega, dim3(grid_blocks), dim3(NWAVES * 64), params, LDS_BYTES, stream);
    if (e != hipSuccess) fprintf(stderr, "cooperative launch failed: %s (grid %d)\n", hipGetErrorString(e), grid_blocks);
#endif
}
```

```cpp
#include <hip/hip_runtime.h>
#include <hip/hip_cooperative_groups.h>
#include <cstdio>
#include <cstdint>
namespace cg = cooperative_groups;
constexpr int NWAVES = 8;
constexpr int D = 1024, TP = 32768, TS = 256, T = TP + TS, SEQ = 2048, NB = 16, DB = 8, DSEQ = 32, PAST = 2048, SKEYS = PAST + DSEQ, KT = TP + DB * SKEYS;
constexpr int DIN = 5792, DINP = 5888, QL = 384, KVL = 256, RP = 32, DFF = 2816, NH = 16, LATP = 768;
constexpr int G0_ROWS = 16384, G1_ROWS = T - G0_ROWS, G1_KEYS = KT - G0_ROWS, VT_LD = 33024;
constexpr float EPS = 1e-6f;
constexpr float QSCALE = 0.10206207261596577f * 1.4426950408889634f;
static_assert(T % 256 == 0 && G1_ROWS % 256 == 0 && G1_KEYS % 256 == 0 && KT % 256 == 0 && G1_KEYS == VT_LD, "tiles");
constexpr size_t O_Y = 0, O_CONV_P = (size_t)T * D, O_CKV_P = O_CONV_P + 2 * NB * 2 * D, O_KR_P = O_CKV_P + (size_t)2 * TP * KVL, O_CONV_S = O_KR_P + (size_t)2 * TP * RP,
                 O_CKV_S = O_CONV_S + 2 * DB * 2 * D, O_KR_S = O_CKV_S + (size_t)2 * TS * KVL, O_END = O_KR_S + (size_t)2 * TS * RP;
static_assert(O_END == 52936704, "d_out size");
constexpr size_t MiB = 1u << 20, U1 = (size_t)T * D * 2;
constexpr size_t WS_RSA = 256 * 1024, WS_RSB = 512 * 1024;
constexpr size_t WS_ROPE = 1 * MiB, WS_W = 2 * MiB, WS_R0 = 40 * MiB, WS_R1 = WS_R0 + U1, WS_R2 = WS_R1 + U1, WS_R3 = WS_R2 + U1, WS_R6 = WS_R3 + 178 * MiB;
constexpr size_t WS_QLN = WS_R6, WS_CALL = WS_QLN + (size_t)T * QL * 2, WS_KR = WS_CALL + (size_t)KT * KVL * 2, WS_END = WS_KR + (size_t)KT * RP * 2;
constexpr size_t W_IN = 0, W_UQ = W_IN + (size_t)DINP * D, W_UK = W_UQ + (size_t)1536 * QL, W_UV = W_UK + (size_t)1024 * KVL, W_CONV = W_UV + (size_t)1024 * KVL,
                 W_ATTN = W_CONV + (size_t)D * D, W_MERGE = W_ATTN + (size_t)D * D, W_GU = W_MERGE + (size_t)D * D, W_DOWN = W_GU + (size_t)2 * DFF * D, W_END = W_DOWN + (size_t)D * DFF;
static_assert(WS_W + W_END * 2 <= WS_R0, "weights fit");
constexpr size_t WS_BG = WS_R3, WS_U = WS_R3 + U1, WS_LAT = WS_R3 + 2 * U1;
constexpr size_t WS_QN = WS_R3, WS_QR = WS_QN + (size_t)G1_ROWS * 1024 * 2, WS_KN = WS_QR + (size_t)G1_ROWS * 512 * 2, WS_VT = WS_KN + (size_t)G1_KEYS * 1024 * 2, WS_GEND = WS_VT + (size_t)1024 * VT_LD * 2;
static_assert(WS_GEND <= WS_R6 && WS_LAT + (size_t)T * LATP * 2 <= WS_R6 && WS_R3 + (size_t)T * DFF * 2 <= WS_R6, "R3 region");
static_assert(WS_END <= 536870912, "d_ws budget (512 MiB)");
constexpr int LDS_BYTES = 131072 + 1024;


namespace pg8 {
#define PG8_LAS __attribute__((address_space(3)))
typedef unsigned short bf16_t;
typedef short bf16x8 __attribute__((ext_vector_type(8)));
typedef float f32x4 __attribute__((ext_vector_type(4)));
typedef unsigned u32x4 __attribute__((ext_vector_type(4)));
constexpr int BM = 256, BK = 64, HALF = 128, HTB = HALF * BK * 2  , STAGE_BYTES = 8 * HTB, NXCD = 8, WGM = 8;

__host__ __device__ __forceinline__ int lds_byte(int r, int c) { const int st = (r >> 4) * 2 + (c >> 5), rr = r & 15, cc = c & 31, ob = rr * 64 + cc * 2; return st * 1024 + (ob ^ (((ob >> 9) & 1) << 5)); }
__host__ __device__ __forceinline__ void stage_rc(int b, int& R, int& C) { const int st = b / 1024, sb = b % 1024, swz = sb ^ (((sb >> 9) & 1) << 5); R = (st >> 1) * 16 + swz / 64; C = (st & 1) * 32 + (swz % 64) / 2; }
__host__ __device__ __forceinline__ int perm32(int rho) { const int n = rho >> 4, i = rho & 15; return 8 * (i >> 2) + 4 * n + (i & 3); }

struct Unit { int pm, pn; };
struct Gemm { const bf16_t* A; const bf16_t* Bt; int M, N, K; };

struct StaticOrder {
    int nM, nN, nwg, G, c;
    __host__ __device__ void init(int M, int N, int G_, int c_) { nM = M / BM; nN = N / BM; nwg = nM * nN; G = G_; c = c_; }
    __host__ __device__ bool next(int i, Unit& u) const {
        const long L = (long)i * G + c; if (L >= nwg) return false;
        int wgid = (int)L; { const int q = nwg / NXCD, r = nwg % NXCD, xcd = wgid % NXCD, off = wgid / NXCD; wgid = (xcd < r ? xcd * (q + 1) : r * (q + 1) + (xcd - r) * q) + off; }
        const int nig = WGM * nN, gid = wgid / nig, fm = gid * WGM, gsz = (nM - fm) < WGM ? (nM - fm) : WGM;
        u.pm = fm + ((wgid % nig) % gsz); u.pn = (wgid % nig) / gsz; return true;
    }
    __device__ __forceinline__ void a_ready(const Unit&) const {}
    __device__ __forceinline__ void done(const Unit&) const {}
};

__device__ __forceinline__ unsigned cvt_pk_bf16(float lo, float hi) { unsigned r; asm volatile("v_cvt_pk_bf16_f32 %0, %1, %2" : "=v"(r) : "v"(lo), "v"(hi)); return r; }
typedef float f32x2 __attribute__((ext_vector_type(2)));
typedef unsigned u32x4e __attribute__((ext_vector_type(4)));
enum { EK_PLAIN = 0, EK_PAIRMUL = 1, EK_SWIGLU = 2, EK_SIGMOID = 3, EK_GATE = 4, EK_COMBINE = 5, EK_WIN = 6, EK_Q = 7 };
__device__ __forceinline__ float sigm(float x) { return __builtin_amdgcn_rcpf(1.0f + __builtin_amdgcn_exp2f(-1.4426950408889634f * x)); }
__device__ __forceinline__ float bflo(unsigned w) { return __uint_as_float(w << 16); }
__device__ __forceinline__ float bfhi(unsigned w) { return __uint_as_float(w & 0xffff0000u); }
struct EpiX {
    static constexpr bool PERM = true, AFTER_DRAIN = false;
    int kind; unsigned char* ws; size_t oO; int ldc; float scale; size_t oRS; int use_rs;
    __device__ __forceinline__ void operator()(const f32x4 (&acc)[2][2][4][2], const Unit& u, int wr, int wc, int fr, int fq) const {
        int k = kind; size_t ob = oO; int ld = ldc; int colt = u.pn * BM; const float sc = scale;
        if (k == EK_WIN) {
            const int pn = u.pn;
            if (pn < 4) { k = EK_PLAIN; }
            else if (pn < 12) { k = EK_PAIRMUL; ob = WS_U; colt = (pn - 4) * 128; }
            else if (pn < 16) { k = EK_SIGMOID; ob = WS_R1; colt = (pn - 12) * 256; }
            else if (pn < 20) { k = EK_SIGMOID; ob = WS_R2; colt = (pn - 16) * 256; }
            else { k = EK_PLAIN; ob = WS_LAT; colt = (pn - 20) * 256; ld = 768; }
        } else if (k == EK_Q) {
            k = EK_PLAIN; if (u.pn >= 4) { ob = WS_QR; colt = (u.pn - 4) * 256; ld = 512; }
        } else if (k == EK_PAIRMUL || k == EK_SWIGLU) colt = u.pn * 128;
        const int row0 = u.pm * BM + wr * 64 + fr;
        const int col0 = colt + wc * 32 + 8 * fq;
        bf16_t* base = (bf16_t*)(ws + ob); const bf16_t* aux1 = (const bf16_t*)(ws + WS_R1); const bf16_t* aux2 = (const bf16_t*)(ws + WS_R2);
        const float* rsp = (const float*)(ws + oRS);
        if (k == EK_PAIRMUL || k == EK_SWIGLU) {
#pragma unroll
            for (int ai = 0; ai < 2; ++ai)
#pragma unroll
                for (int m = 0; m < 4; ++m) {
                    bf16_t* rowp = base + (size_t)(row0 + ai * HALF + m * 16) * ld + col0;
                    const float rr = use_rs ? rsp[row0 + ai * HALF + m * 16] : 1.f;
                    f32x4 a0 = acc[ai][0][m][0] * rr, a1 = acc[ai][0][m][1] * rr; const f32x4 b0 = acc[ai][1][m][0] * rr, b1 = acc[ai][1][m][1] * rr;
                    if (k == EK_SWIGLU) {
#pragma unroll
                        for (int i = 0; i < 4; ++i) { a0[i] = a0[i] * sigm(a0[i]); a1[i] = a1[i] * sigm(a1[i]); }
                    }
                    const f32x4 v0 = a0 * b0, v1 = a1 * b1;
                    u32x4e w; w.x = cvt_pk_bf16(v0[0], v0[1]); w.y = cvt_pk_bf16(v0[2], v0[3]); w.z = cvt_pk_bf16(v1[0], v1[1]); w.w = cvt_pk_bf16(v1[2], v1[3]);
                    *(u32x4e*)rowp = w;
                }
        } else {
#pragma unroll
            for (int ai = 0; ai < 2; ++ai)
#pragma unroll
                for (int m = 0; m < 4; ++m) {
                    const size_t roff = (size_t)(row0 + ai * HALF + m * 16) * ld + col0;
                    const float rr = use_rs ? rsp[row0 + ai * HALF + m * 16] : 1.f;
#pragma unroll
                    for (int bj = 0; bj < 2; ++bj) {
                        f32x4 v0 = acc[ai][bj][m][0], v1 = acc[ai][bj][m][1];
                        const size_t off = roff + bj * HALF;
                        if (k == EK_PLAIN) { v0 = v0 * (sc * rr); v1 = v1 * (sc * rr); }
                        else if (k == EK_SIGMOID) {
#pragma unroll
                            for (int i = 0; i < 4; ++i) { v0[i] = sigm(v0[i] * rr); v1[i] = sigm(v1[i] * rr); }
                        } else if (k == EK_GATE) {
                            const u32x4e g = *(const u32x4e*)(aux1 + off);
                            v0[0] *= bflo(g.x); v0[1] *= bfhi(g.x); v0[2] *= bflo(g.y); v0[3] *= bfhi(g.y);
                            v1[0] *= bflo(g.z); v1[1] *= bfhi(g.z); v1[2] *= bflo(g.w); v1[3] *= bfhi(g.w);
                        } else {
                            const u32x4e y = *(const u32x4e*)(aux1 + off); const u32x4e g = *(const u32x4e*)(aux2 + off);
                            v0[0] = bflo(y.x) + bflo(g.x) * v0[0]; v0[1] = bfhi(y.x) + bfhi(g.x) * v0[1]; v0[2] = bflo(y.y) + bflo(g.y) * v0[2]; v0[3] = bfhi(y.y) + bfhi(g.y) * v0[3];
                            v1[0] = bflo(y.z) + bflo(g.z) * v1[0]; v1[1] = bfhi(y.z) + bfhi(g.z) * v1[1]; v1[2] = bflo(y.w) + bflo(g.w) * v1[2]; v1[3] = bfhi(y.w) + bfhi(g.w) * v1[3];
                        }
                        u32x4e w; w.x = cvt_pk_bf16(v0[0], v0[1]); w.y = cvt_pk_bf16(v0[2], v0[3]); w.z = cvt_pk_bf16(v1[0], v1[1]); w.w = cvt_pk_bf16(v1[2], v1[3]);
                        *(u32x4e*)(base + off) = w;
                    }
                }
        }
    }
};
template <class Epi, class Sched, bool ALIGN_EPI = false, bool SP2 = false>
__device__ __forceinline__ void gemm_phase(PG8_LAS unsigned char* lds, const Gemm g, const Sched& S, const Epi& E) {
    int tid_ = threadIdx.x; asm volatile("" : "+v"(tid_));
    const int tid = tid_, wid = __builtin_amdgcn_readfirstlane(tid >> 6), lane = tid & 63, wr = wid >> 2, wc = wid & 3, fr = lane & 15, fq = lane >> 4;
    const int K = g.K, nt = K / BK;
    unsigned voffA[2], voffB[2];
#pragma unroll
    for (int i = 0; i < 2; ++i) { int R, C; stage_rc(tid * 16 + i * 8192, R, C); const int Rb = Epi::PERM ? ((R & ~31) + perm32(R & 31)) : R;
        voffA[i] = (unsigned)(R * K + C) * 2u; voffB[i] = (unsigned)(Rb * K + C) * 2u; }
    const size_t kstep = (size_t)(BK * 2);
    const size_t hstep = (size_t)HALF * K * 2;
    const size_t tstep = 2 * hstep;
    const unsigned ldsw = (unsigned)wid * 1024u;
    const int aoff = lds_byte(wr * 64 + fr, fq * 8), boff = lds_byte(wc * 32 + fr, fq * 8);
#define PG8_SA(b, h) (((b) * 2 + (h)) * HTB)
#define PG8_SB(b, h) ((4 + (b) * 2 + (h)) * HTB)
#define PG8_STAGE(bufoff, gbase, voff) do { _Pragma("unroll") for (int _i = 0; _i < 2; ++_i) \
        __builtin_amdgcn_global_load_lds((const unsigned*)((const char*)(gbase) + (voff)[_i]), (PG8_LAS unsigned*)(lds + (bufoff) + ldsw + _i * 8192), 16, 0, 0); } while (0)
#define PG8_LDA(dst, b, h) do { _Pragma("unroll") for (int m = 0; m < 4; ++m) _Pragma("unroll") for (int k = 0; k < 2; ++k) dst[m][k] = *(const PG8_LAS bf16x8*)(lds + PG8_SA(b, h) + aoff + m * 2048 + k * 1024); } while (0)
#define PG8_LDB(dst, b, h) do { _Pragma("unroll") for (int n = 0; n < 2; ++n) _Pragma("unroll") for (int k = 0; k < 2; ++k) dst[n][k] = *(const PG8_LAS bf16x8*)(lds + PG8_SB(b, h) + boff + n * 2048 + k * 1024); } while (0)
#define PG8_MMA(ai, bj, At, Bt) do { __builtin_amdgcn_s_setprio(1); _Pragma("unroll") for (int m = 0; m < 4; ++m) _Pragma("unroll") for (int n = 0; n < 2; ++n) _Pragma("unroll") for (int k = 0; k < 2; ++k) \
        acc[ai][bj][m][n] = __builtin_amdgcn_mfma_f32_16x16x32_bf16(Bt[n][k], At[m][k], acc[ai][bj][m][n], 0, 0, 0); __builtin_amdgcn_s_setprio(0); } while (0)
#define PG8_WAIT_V(n) asm volatile("s_waitcnt vmcnt(" #n ")" ::: "memory")
#define PG8_WAIT_L(n) asm volatile("s_waitcnt lgkmcnt(" #n ")" ::: "memory")
#define PG8_BAR __builtin_amdgcn_s_barrier()
#define PG8_SCHED __builtin_amdgcn_sched_barrier(0)
    Unit cur, nxt; int ui = 0;
    if (!S.next(0, cur)) return;
    f32x4 acc[2][2][4][2];
#pragma unroll
    for (int a = 0; a < 2; ++a)
#pragma unroll
        for (int b = 0; b < 2; ++b)
#pragma unroll
            for (int m = 0; m < 4; ++m)
#pragma unroll
                for (int n = 0; n < 2; ++n) acc[a][b][m][n] = (f32x4){0.f, 0.f, 0.f, 0.f};
    bf16x8 At[4][2], B0[2][2], B1[2][2];
    const char* cA = (const char*)g.A + (size_t)cur.pm * tstep; const char* cB = (const char*)g.Bt + (size_t)cur.pn * tstep;
    S.a_ready(cur);
    if constexpr (SP2) {
        PG8_STAGE(PG8_SB(0, 0), cB, voffB); PG8_STAGE(PG8_SB(0, 1), cB + hstep, voffB); PG8_STAGE(PG8_SA(0, 0), cA, voffA); PG8_STAGE(PG8_SA(0, 1), cA + hstep, voffA);
        if (wr == 1) PG8_BAR;
        PG8_WAIT_V(2); PG8_BAR;
        PG8_STAGE(PG8_SB(1, 0), cB + kstep, voffB); PG8_STAGE(PG8_SA(1, 0), cA + kstep, voffA); PG8_STAGE(PG8_SB(1, 1), cB + hstep + kstep, voffB);
        PG8_WAIT_V(6); PG8_BAR;
    } else {
        PG8_STAGE(PG8_SB(0, 0), cB, voffB); PG8_STAGE(PG8_SA(0, 0), cA, voffA); PG8_STAGE(PG8_SB(0, 1), cB + hstep, voffB); PG8_STAGE(PG8_SA(0, 1), cA + hstep, voffA);
        if (wr == 1) PG8_BAR;
        PG8_WAIT_V(4); PG8_BAR;
        PG8_STAGE(PG8_SB(1, 0), cB + kstep, voffB); PG8_STAGE(PG8_SA(1, 0), cA + kstep, voffA); PG8_STAGE(PG8_SB(1, 1), cB + hstep + kstep, voffB);
        PG8_WAIT_V(6); PG8_BAR;
    }
    for (;;) {
        const bool has_next = S.next(ui + 1, nxt);
        const char* nA = has_next ? (const char*)g.A + (size_t)nxt.pm * tstep : cA; const char* nB = has_next ? (const char*)g.Bt + (size_t)nxt.pn * tstep : cB;
        for (int t = 0; t < nt; t += 2) {
            const bool last = (t == nt - 2);
            const char* a1 = cA + (size_t)(t + 1) * kstep;
            const char* a2 = last ? nA : cA + (size_t)(t + 2) * kstep; const char* b2 = last ? nB : cB + (size_t)(t + 2) * kstep;
            const char* a3 = a2 + kstep; const char* b3 = b2 + kstep;
            if (last && has_next) S.a_ready(nxt);
            if constexpr (SP2) {
            PG8_LDB(B0, 0, 0); PG8_LDB(B1, 0, 1); PG8_SCHED; PG8_LDA(At, 0, 0); PG8_STAGE(PG8_SA(1, 1), a1 + hstep, voffA);
            PG8_WAIT_V(8); PG8_WAIT_L(0); PG8_BAR; PG8_MMA(0, 0, At, B0); PG8_MMA(0, 1, At, B1); PG8_BAR; PG8_SCHED;
            PG8_LDA(At, 0, 1); PG8_STAGE(PG8_SB(0, 0), b2, voffB); PG8_STAGE(PG8_SB(0, 1), b2 + hstep, voffB); PG8_STAGE(PG8_SA(0, 0), a2, voffA);
            PG8_WAIT_V(8); PG8_WAIT_L(0); PG8_BAR; PG8_MMA(1, 0, At, B0); PG8_MMA(1, 1, At, B1); PG8_BAR; PG8_SCHED;
            PG8_LDB(B0, 1, 0); PG8_LDB(B1, 1, 1); PG8_SCHED; PG8_LDA(At, 1, 0); PG8_STAGE(PG8_SA(0, 1), a2 + hstep, voffA);
            PG8_WAIT_V(8); PG8_WAIT_L(0); PG8_BAR; PG8_MMA(0, 0, At, B0); PG8_MMA(0, 1, At, B1); PG8_BAR; PG8_SCHED;
            PG8_LDA(At, 1, 1); PG8_STAGE(PG8_SB(1, 0), b3, voffB); PG8_STAGE(PG8_SB(1, 1), b3 + hstep, voffB); PG8_STAGE(PG8_SA(1, 0), a3, voffA);
            PG8_WAIT_V(8); PG8_WAIT_L(0); PG8_BAR; PG8_MMA(1, 0, At, B0); PG8_MMA(1, 1, At, B1); PG8_BAR; PG8_SCHED;
            } else {
            PG8_LDB(B0, 0, 0); PG8_SCHED; PG8_LDA(At, 0, 0); PG8_STAGE(PG8_SA(1, 1), a1 + hstep, voffA);
            PG8_WAIT_L(8); PG8_BAR; PG8_WAIT_L(0); PG8_MMA(0, 0, At, B0); PG8_BAR; PG8_SCHED;
            PG8_LDB(B1, 0, 1); PG8_STAGE(PG8_SB(0, 0), b2, voffB);
            PG8_BAR; PG8_WAIT_L(0); PG8_MMA(0, 1, At, B1); PG8_BAR;
            PG8_LDA(At, 0, 1); PG8_STAGE(PG8_SA(0, 0), a2, voffA);
            PG8_BAR; PG8_WAIT_L(0); PG8_MMA(1, 0, At, B0); PG8_BAR; PG8_SCHED;
            PG8_STAGE(PG8_SB(0, 1), b2 + hstep, voffB);
            PG8_WAIT_V(6); PG8_BAR; PG8_MMA(1, 1, At, B1); PG8_BAR;
            PG8_LDB(B0, 1, 0); PG8_SCHED; PG8_LDA(At, 1, 0); PG8_STAGE(PG8_SA(0, 1), a2 + hstep, voffA);
            PG8_WAIT_L(8); PG8_BAR; PG8_WAIT_L(0); PG8_MMA(0, 0, At, B0); PG8_BAR; PG8_SCHED;
            PG8_LDB(B1, 1, 1); PG8_STAGE(PG8_SB(1, 0), b3, voffB);
            PG8_BAR; PG8_WAIT_L(0); PG8_MMA(0, 1, At, B1); PG8_BAR;
            PG8_LDA(At, 1, 1); PG8_STAGE(PG8_SA(1, 0), a3, voffA);
            PG8_BAR; PG8_WAIT_L(0); PG8_MMA(1, 0, At, B0); PG8_BAR; PG8_SCHED;
            PG8_STAGE(PG8_SB(1, 1), b3 + hstep, voffB);
            PG8_WAIT_V(6); PG8_BAR; PG8_MMA(1, 1, At, B1); PG8_BAR;
            }
        }
        if constexpr (ALIGN_EPI) { if (wr == 0) PG8_BAR; }
        if constexpr (!Epi::AFTER_DRAIN) { E(acc, cur, wr, wc, fr, fq); S.done(cur); }
        if (!has_next) break;
#pragma unroll
        for (int a = 0; a < 2; ++a)
#pragma unroll
            for (int b = 0; b < 2; ++b)
#pragma unroll
                for (int m = 0; m < 4; ++m)
#pragma unroll
                    for (int n = 0; n < 2; ++n) acc[a][b][m][n] = (f32x4){0.f, 0.f, 0.f, 0.f};
        cur = nxt; cA = nA; cB = nB; ++ui;
        if constexpr (ALIGN_EPI) { if (wr == 1) PG8_BAR; }
    }
    PG8_WAIT_V(0);
    if constexpr (!ALIGN_EPI) { if (wr == 0) PG8_BAR; }
    PG8_BAR;
    if constexpr (Epi::AFTER_DRAIN) { E.fused(acc, cur, wr, wc, fr, fq, lds, wid, lane); S.done(cur); }
#undef PG8_SA
#undef PG8_SB
#undef PG8_STAGE
#undef PG8_LDA
#undef PG8_LDB
#undef PG8_MMA
#undef PG8_WAIT_V
#undef PG8_WAIT_L
#undef PG8_BAR
#undef PG8_SCHED
}
}

#define LAS __attribute__((address_space(3)))
typedef unsigned short bf16_t;
typedef short bf16x8 __attribute__((ext_vector_type(8)));
typedef float f32x4 __attribute__((ext_vector_type(4)));
typedef float f32x16 __attribute__((ext_vector_type(16)));
typedef unsigned u32x4 __attribute__((ext_vector_type(4)));
typedef unsigned u32x2 __attribute__((ext_vector_type(2)));
struct Args { const float* in[20]; float* out; unsigned char* ws; int st_lo, st_hi; };

struct Frame {
    LAS unsigned char* lds; int tid, lane, wave, G;
    const float* const* in; float* out; unsigned char* ws;
};
__device__ __forceinline__ float wave_sum(float v) {
#pragma unroll
    for (int o = 1; o < 64; o <<= 1) v += __shfl_xor(v, o);
    return v;
}
__device__ __forceinline__ unsigned pk2(float lo, float hi) { return pg8::cvt_pk_bf16(lo, hi); }
__device__ __forceinline__ float bflo(unsigned w) { return __uint_as_float(w << 16); }
__device__ __forceinline__ float bfhi(unsigned w) { return __uint_as_float(w & 0xffff0000u); }
__device__ __forceinline__ float bf2f(bf16_t b) { return __uint_as_float(((unsigned)b) << 16); }

__device__ __forceinline__ void tr_load(float (&v)[32], const float* W, int N, int k0, int n0, int lane, const float* gain) {
#pragma unroll
    for (int i = 0; i < 32; ++i) { const int kk = 2 * i + (lane >> 5); v[i] = W[(size_t)(k0 + kk) * N + n0 + (lane & 31)] * (gain ? gain[k0 + kk] : 1.f); }
}
__device__ __forceinline__ void tr_finish(const float (&v)[32], int K, bf16_t* dst_row0  , int k0, LAS float* scr, int lane) {
#pragma unroll
    for (int i = 0; i < 32; ++i) { const int kk = 2 * i + (lane >> 5); scr[kk * 33 + (lane & 31)] = v[i]; }
    asm volatile("s_waitcnt lgkmcnt(0)" ::: "memory");
    const int c = lane & 7;
#pragma unroll
    for (int j = 0; j < 4; ++j) { const int n = (lane >> 3) + 8 * j; const LAS float* s = scr + (8 * c) * 33 + n;
        u32x4 o; o.x = pk2(s[0 * 33], s[1 * 33]); o.y = pk2(s[2 * 33], s[3 * 33]); o.z = pk2(s[4 * 33], s[5 * 33]); o.w = pk2(s[6 * 33], s[7 * 33]);
        *(u32x4*)(dst_row0 + (size_t)n * K + k0 + 8 * c) = o; }
    asm volatile("s_waitcnt lgkmcnt(0)" ::: "memory");
}
__device__ __forceinline__ size_t wdst(int mat, int n0) {
    switch (mat) {
    case 0: {
        int r;
        if (n0 < 1024) r = n0;
        else if (n0 < 2048) { const int j = n0 - 1024; r = 1024 + (j >> 7) * 256 + (j & 127); }
        else if (n0 < 3072) { const int j = n0 - 2048; r = 1024 + (j >> 7) * 256 + 128 + (j & 127); }
        else if (n0 < 3744) r = 5120 + (n0 - 3072);
        else r = 3072 + (n0 - 3744);
        return W_IN + (size_t)r * D; }
    case 1: { const int g = n0 >> 5, h = g / 3, part = g % 3; const int r = part < 2 ? h * 64 + part * 32 : 1024 + h * 32; return W_UQ + (size_t)r * QL; }
    case 2: { const int h = n0 >> 7, e = n0 & 127; return e < 64 ? W_UK + (size_t)(h * 64 + e) * KVL : W_UV + (size_t)(h * 64 + e - 64) * KVL; }
    case 3: return W_CONV + (size_t)n0 * D;
    case 4: return W_ATTN + (size_t)n0 * D;
    case 5: return W_MERGE + (size_t)n0 * D;
    case 6: { int r; if (n0 < DFF) r = (n0 >> 7) * 256 + (n0 & 127); else { const int j = n0 - DFF; r = (j >> 7) * 256 + 128 + (j & 127); } return W_GU + (size_t)r * D; }
    default: return W_DOWN + (size_t)n0 * DFF;
    }
}
__device__ __forceinline__ void convert_weights(Frame& F, int l) {
    LAS float* scr = (LAS float*)(F.lds + F.wave * 16384);
    bf16_t* Wb = (bf16_t*)(F.ws + WS_W);
    const int gw = blockIdx.x * NWAVES + F.wave, NGW = F.G * NWAVES;
    constexpr int I0 = 16 * (DIN / 32), I1 = 6 * 48, I2 = 4 * 64, I3 = 16 * 32, I6 = 16 * (2 * DFF / 32), I7 = 44 * 32;
    constexpr int NIT = I0 + I1 + I2 + 3 * I3 + I6 + I7;
#define CW_DECODE(it_, K_, N_, src_, gain_, dst_, k0_, n0_) do { int r = (it_), mat; gain_ = nullptr; \
        if (r < I0) { mat = 0; K_ = D; N_ = DIN; src_ = F.in[5] + (size_t)l * D * DIN; gain_ = F.in[6] + l * D; } \
        else if ((r -= I0) < I1) { mat = 1; K_ = QL; N_ = 1536; src_ = F.in[10] + (size_t)l * QL * 1536; } \
        else if ((r -= I1) < I2) { mat = 2; K_ = KVL; N_ = 2048; src_ = F.in[11] + (size_t)l * KVL * 2048; } \
        else if ((r -= I2) < I3) { mat = 3; K_ = D; N_ = D; src_ = F.in[13] + (size_t)l * D * D; } \
        else if ((r -= I3) < I3) { mat = 4; K_ = D; N_ = D; src_ = F.in[14] + (size_t)l * D * D; } \
        else if ((r -= I3) < I3) { mat = 5; K_ = D; N_ = D; src_ = F.in[15] + (size_t)l * D * D; } \
        else if ((r -= I3) < I6) { mat = 6; K_ = D; N_ = 2 * DFF; src_ = F.in[18] + (size_t)l * D * 2 * DFF; gain_ = F.in[16] + l * D; } \
        else { r -= I6; mat = 7; K_ = DFF; N_ = D; src_ = F.in[19] + (size_t)l * DFF * D; } \
        const int nblk = N_ / 32, kb = r / nblk, nb = r % nblk; k0_ = kb * 64; n0_ = nb * 32; dst_ = Wb + wdst(mat, nb * 32); } while (0)
    {
        float va[32], vb[32];
        int it = gw, Ka = 0, Na = 0, k0a = 0, n0a = 0, Kb = 0, Nb = 0, k0b = 0, n0b = 0; const float* sa = nullptr; const float* ga = nullptr; bf16_t* da = nullptr; const float* sb = nullptr; const float* gb = nullptr; bf16_t* db = nullptr;
        if (it < NIT) { CW_DECODE(it, Ka, Na, sa, ga, da, k0a, n0a); tr_load(va, sa, Na, k0a, n0a, F.lane, ga); }
        while (it < NIT) {
            const int itb = it + NGW;
            if (itb < NIT) { CW_DECODE(itb, Kb, Nb, sb, gb, db, k0b, n0b); tr_load(vb, sb, Nb, k0b, n0b, F.lane, gb); }
            tr_finish(va, Ka, da, k0a, scr, F.lane);
            if (itb >= NIT) break;
            const int itc = itb + NGW;
            if (itc < NIT) { CW_DECODE(itc, Ka, Na, sa, ga, da, k0a, n0a); tr_load(va, sa, Na, k0a, n0a, F.lane, ga); }
            tr_finish(vb, Kb, db, k0b, scr, F.lane);
            it = itc;
        }
    }
#undef CW_DECODE
    for (int i = (blockIdx.x * 512 + F.tid); i < (DINP - DIN) * D / 8; i += F.G * 512) *(u32x4*)(Wb + W_IN + (size_t)DIN * D + (size_t)i * 8) = (u32x4){0u, 0u, 0u, 0u};
}
__device__ __forceinline__ void build_rope(Frame& F) {
    float* rope = (float*)(F.ws + WS_ROPE);
    for (int i = blockIdx.x * 512 + F.tid; i < SKEYS * 16; i += F.G * 512) {
        const int pos = i >> 4, f = i & 15;
        const int a = f & 3; const double q = a == 0 ? 1.0 : (a == 1 ? 0.5623413251903491 : (a == 2 ? 0.31622776601683794 : 0.1778279410038923));
        const int bq = f >> 2; const double p10 = bq == 0 ? 1.0 : (bq == 1 ? 0.1 : (bq == 2 ? 0.01 : 0.001));
        const double rev = (double)pos * (q * p10) * 0.15915494309189535;
        const float fr = (float)(rev - __builtin_rint(rev));
        rope[pos * 32 + f] = __builtin_amdgcn_cosf(fr); rope[pos * 32 + 16 + f] = __builtin_amdgcn_sinf(fr);
    }
}
__device__ __forceinline__ const float* xrow_in(Frame& F, int m) { return m < TP ? F.in[0] + (size_t)m * D : F.in[1] + (size_t)(m - TP) * D; }
__device__ __forceinline__ void store_norm_bf16(bf16_t* orow, const f32x4 (&v)[4], float rstd, const float* g, int lane) {
#pragma unroll
    for (int j = 0; j < 4; ++j) { const f32x4 gg = *(const f32x4*)(g + 4 * lane + 256 * j);
        u32x2 w; w.x = pk2(v[j][0] * rstd * gg[0], v[j][1] * rstd * gg[1]); w.y = pk2(v[j][2] * rstd * gg[2], v[j][3] * rstd * gg[3]);
        *(u32x2*)(orow + 4 * lane + 256 * j) = w; }
}
__device__ __forceinline__ float sumsq16(const f32x4 (&v)[4]) { float s = 0.f;
#pragma unroll
    for (int j = 0; j < 4; ++j) s += (v[j][0] * v[j][0] + v[j][1] * v[j][1]) + (v[j][2] * v[j][2] + v[j][3] * v[j][3]);
    return wave_sum(s); }
__device__ __forceinline__ void store_bf16_row(bf16_t* orow, const f32x4 (&v)[4], int lane) {
#pragma unroll
    for (int j = 0; j < 4; ++j) { u32x2 w; w.x = pk2(v[j][0], v[j][1]); w.y = pk2(v[j][2], v[j][3]); *(u32x2*)(orow + 4 * lane + 256 * j) = w; }
}
__device__ __forceinline__ void load_bf16_row(f32x4 (&v)[4], const bf16_t* irow, int lane) {
#pragma unroll
    for (int j = 0; j < 4; ++j) { const u32x2 w = *(const u32x2*)(irow + 4 * lane + 256 * j); v[j] = (f32x4){bflo(w.x), bfhi(w.x), bflo(w.y), bfhi(w.y)}; }
}
constexpr int RB = 4;
__device__ __forceinline__ void phase_norm_in(Frame& F) {
    bf16_t* XA = (bf16_t*)(F.out + O_Y); float* RSA = (float*)(F.ws + WS_RSA);
    const int gw = blockIdx.x * NWAVES + F.wave, NGW = F.G * NWAVES;
    for (int m0 = gw; m0 < T; m0 += RB * NGW) { f32x4 v[RB][4];
#pragma unroll
        for (int q = 0; q < RB; ++q) { const int m = m0 + q * NGW; if (m < T) { const float* xr = xrow_in(F, m);
#pragma unroll
            for (int j = 0; j < 4; ++j) v[q][j] = *(const f32x4*)(xr + 4 * F.lane + 256 * j); } }
#pragma unroll
        for (int q = 0; q < RB; ++q) { const int m = m0 + q * NGW; if (m < T) {
            const float rstd = rsqrtf(sumsq16(v[q]) * (1.f / D) + EPS);
            store_bf16_row(XA + (size_t)m * D, v[q], F.lane); if (F.lane == 0) RSA[m] = rstd; } } }
}
__device__ __forceinline__ void phase_h(Frame& F, int l) {
    const bf16_t* XA = (const bf16_t*)(F.out + O_Y); bf16_t* XB = (bf16_t*)(F.ws + WS_R2); float* RSB = (float*)(F.ws + WS_RSB);
    const bf16_t* Mo = (const bf16_t*)(F.ws + WS_R3 + U1);
    const float* gp = F.in[7] + l * D;
    f32x4 gg[4];
#pragma unroll
    for (int j = 0; j < 4; ++j) gg[j] = *(const f32x4*)(gp + 4 * F.lane + 256 * j);
    const int gw = blockIdx.x * NWAVES + F.wave, NGW = F.G * NWAVES;
    for (int m0 = gw; m0 < T; m0 += RB * NGW) { f32x4 x[RB][4], mm[RB][4];
#pragma unroll
        for (int q = 0; q < RB; ++q) { const int m = m0 + q * NGW; if (m < T) { load_bf16_row(x[q], XA + (size_t)m * D, F.lane); load_bf16_row(mm[q], Mo + (size_t)m * D, F.lane); } }
#pragma unroll
        for (int q = 0; q < RB; ++q) { const int m = m0 + q * NGW; if (m < T) {
            const float rm = rsqrtf(sumsq16(mm[q]) * (1.f / D) + EPS);
#pragma unroll
            for (int j = 0; j < 4; ++j) x[q][j] = x[q][j] + mm[q][j] * rm * gg[j];
            const float rstd = rsqrtf(sumsq16(x[q]) * (1.f / D) + EPS);
            store_bf16_row(XB + (size_t)m * D, x[q], F.lane); if (F.lane == 0) RSB[m] = rstd; } } }
}
__device__ __forceinline__ void phase_k(Frame& F, int l) {
    bf16_t* XA = (bf16_t*)(F.out + O_Y); const bf16_t* XB = (const bf16_t*)(F.ws + WS_R2); float* RSA = (float*)(F.ws + WS_RSA);
    const bf16_t* Fo = (const bf16_t*)(F.ws + WS_R1); float* Y = F.out + O_Y;
    const float* gp = F.in[17] + l * D;
    f32x4 gg[4];
#pragma unroll
    for (int j = 0; j < 4; ++j) gg[j] = *(const f32x4*)(gp + 4 * F.lane + 256 * j);
    const int gw = blockIdx.x * NWAVES + F.wave, NGW = F.G * NWAVES;
    for (int m0 = gw; m0 < T; m0 += RB * NGW) { f32x4 x[RB][4], mm[RB][4];
#pragma unroll
        for (int q = 0; q < RB; ++q) { const int m = m0 + q * NGW; if (m < T) { load_bf16_row(x[q], XB + (size_t)m * D, F.lane); load_bf16_row(mm[q], Fo + (size_t)m * D, F.lane); } }
#pragma unroll
        for (int q = 0; q < RB; ++q) { const int m = m0 + q * NGW; if (m < T) {
            const float rm = rsqrtf(sumsq16(mm[q]) * (1.f / D) + EPS);
#pragma unroll
            for (int j = 0; j < 4; ++j) x[q][j] = x[q][j] + mm[q][j] * rm * gg[j];
            if (l == 0) { const float rstd = rsqrtf(sumsq16(x[q]) * (1.f / D) + EPS); store_bf16_row(XA + (size_t)m * D, x[q], F.lane); if (F.lane == 0) RSA[m] = rstd; }
            else {
#pragma unroll
                for (int j = 0; j < 4; ++j) *(f32x4*)(Y + (size_t)m * D + 4 * F.lane + 256 * j) = x[q][j]; } } } }
}
__device__ __forceinline__ void ld16bf(float (&d)[16], const bf16_t* p) {
    const u32x4 a = *(const u32x4*)p, b = *(const u32x4*)(p + 8);
    d[0] = bflo(a.x); d[1] = bfhi(a.x); d[2] = bflo(a.y); d[3] = bfhi(a.y); d[4] = bflo(a.z); d[5] = bfhi(a.z); d[6] = bflo(a.w); d[7] = bfhi(a.w);
    d[8] = bflo(b.x); d[9] = bfhi(b.x); d[10] = bflo(b.y); d[11] = bfhi(b.y); d[12] = bflo(b.z); d[13] = bfhi(b.z); d[14] = bflo(b.w); d[15] = bfhi(b.w);
}
__device__ __forceinline__ void cvt16(float (&d)[16], const u32x4 a, const u32x4 b) {
    d[0] = bflo(a.x); d[1] = bfhi(a.x); d[2] = bflo(a.y); d[3] = bfhi(a.y); d[4] = bflo(a.z); d[5] = bfhi(a.z); d[6] = bflo(a.w); d[7] = bfhi(a.w);
    d[8] = bflo(b.x); d[9] = bfhi(b.x); d[10] = bflo(b.y); d[11] = bfhi(b.y); d[12] = bflo(b.z); d[13] = bfhi(b.z); d[14] = bflo(b.w); d[15] = bfhi(b.w);
}
__device__ __forceinline__ void ld16f(float (&d)[16], const float* p) {
#pragma unroll
    for (int j = 0; j < 4; ++j) { const f32x4 a = *(const f32x4*)(p + 4 * j); d[4 * j] = a[0]; d[4 * j + 1] = a[1]; d[4 * j + 2] = a[2]; d[4 * j + 3] = a[3]; }
}
__device__ __forceinline__ void phase_c(Frame& F, int l) {
    const bf16_t* Bg = (const bf16_t*)(F.ws + WS_BG); const bf16_t* U = (const bf16_t*)(F.ws + WS_U); const bf16_t* LAT = (const bf16_t*)(F.ws + WS_LAT);
    bf16_t* YAin = (bf16_t*)(F.ws + WS_R0); bf16_t* QLn = (bf16_t*)(F.ws + WS_QLN); bf16_t* Call = (bf16_t*)(F.ws + WS_CALL); bf16_t* KR = (bf16_t*)(F.ws + WS_KR);
    const float* rope = (const float*)(F.ws + WS_ROPE);
    const int lane = F.lane;
    { const float* cc = F.in[3] + (size_t)l * DB * PAST * KVL; const float* ck = F.in[4] + (size_t)l * DB * PAST * RP;
      for (int i = blockIdx.x * 512 + F.tid; i < DB * PAST * KVL / 8; i += F.G * 512) { const int e = i * 8, b = e / (PAST * KVL), r = e % (PAST * KVL);
          const f32x4 a = *(const f32x4*)(cc + e), c = *(const f32x4*)(cc + e + 4);
          *(u32x4*)(Call + (size_t)(TP + b * SKEYS) * KVL + r) = (u32x4){pk2(a[0], a[1]), pk2(a[2], a[3]), pk2(c[0], c[1]), pk2(c[2], c[3])}; }
      for (int i = blockIdx.x * 512 + F.tid; i < DB * PAST * RP / 8; i += F.G * 512) { const int e = i * 8, b = e / (PAST * RP), r = e % (PAST * RP);
          const f32x4 a = *(const f32x4*)(ck + e), c = *(const f32x4*)(ck + e + 4);
          *(u32x4*)(KR + (size_t)(TP + b * SKEYS) * RP + r) = (u32x4){pk2(a[0], a[1]), pk2(a[2], a[3]), pk2(c[0], c[1]), pk2(c[2], c[3])}; } }
    float cw0[16], cw1[16], cw2[16];
    ld16f(cw0, F.in[12] + (size_t)l * 3 * D + 16 * lane); ld16f(cw1, F.in[12] + (size_t)l * 3 * D + D + 16 * lane); ld16f(cw2, F.in[12] + (size_t)l * 3 * D + 2 * D + 16 * lane);
    float gq[8], gk[8];
#pragma unroll
    for (int i = 0; i < 8; ++i) { gq[i] = lane < 48 ? F.in[8][l * QL + 8 * lane + i] : 0.f; gk[i] = lane < 32 ? F.in[9][l * KVL + 8 * lane + i] : 0.f; }
    const int gw = blockIdx.x * NWAVES + F.wave, NGW = F.G * NWAVES;
    for (int run = gw; run < T / 8; run += NGW) {
        const int t0 = run * 8; const bool smp = t0 >= TP;
        const int b = smp ? (t0 - TP) / DSEQ : t0 / SEQ, s0 = smp ? (t0 - TP) % DSEQ : t0 % SEQ, slen = smp ? DSEQ : SEQ;
        float up1[16], up2[16];
        if (s0 == 0) {
            if (smp) { const float* hs = F.in[2] + ((size_t)(l * DB + b) * 2) * D + 16 * lane; ld16f(up2, hs); ld16f(up1, hs + D); }
            else {
#pragma unroll
                for (int i = 0; i < 16; ++i) { up1[i] = 0.f; up2[i] = 0.f; } }
        } else { ld16bf(up1, U + (size_t)(t0 - 1) * D + 16 * lane); ld16bf(up2, U + (size_t)(t0 - 2) * D + 16 * lane); }
#pragma unroll 1
        for (int i4 = 0; i4 < 8; i4 += 2) {
            u32x4 rU[2][2], rB[2][2], rQ[2], rC[2]; unsigned rR1[2], rR2[2];
#pragma unroll
            for (int q = 0; q < 2; ++q) { const int t = t0 + i4 + q; const bf16_t* lat = LAT + (size_t)t * LATP;
                rU[q][0] = *(const u32x4*)(U + (size_t)t * D + 16 * lane); rU[q][1] = *(const u32x4*)(U + (size_t)t * D + 16 * lane + 8);
                rB[q][0] = *(const u32x4*)(Bg + (size_t)t * D + 16 * lane); rB[q][1] = *(const u32x4*)(Bg + (size_t)t * D + 16 * lane + 8);
                rQ[q] = (u32x4){0u, 0u, 0u, 0u}; rC[q] = rQ[q]; rR1[q] = 0u; rR2[q] = 0u;
                if (lane < 48) rQ[q] = *(const u32x4*)(lat + 8 * lane);
                if (lane < 32) rC[q] = *(const u32x4*)(lat + QL + 8 * lane);
                if (lane < 16) { rR1[q] = lat[QL + KVL + lane]; rR2[q] = lat[QL + KVL + 16 + lane]; } }
#pragma unroll
            for (int q = 0; q < 2; ++q) {
            const int t = t0 + i4 + q, s = s0 + i4 + q;
            float uc[16], bg[16], y[16];
            cvt16(uc, rU[q][0], rU[q][1]); cvt16(bg, rB[q][0], rB[q][1]);
#pragma unroll
            for (int i = 0; i < 16; ++i) y[i] = bg[i] * (cw0[i] * up2[i] + cw1[i] * up1[i] + cw2[i] * uc[i]);
            *(u32x4*)(YAin + (size_t)t * D + 16 * lane) = (u32x4){pk2(y[0], y[1]), pk2(y[2], y[3]), pk2(y[4], y[5]), pk2(y[6], y[7])};
            *(u32x4*)(YAin + (size_t)t * D + 16 * lane + 8) = (u32x4){pk2(y[8], y[9]), pk2(y[10], y[11]), pk2(y[12], y[13]), pk2(y[14], y[15])};
            if (s >= slen - 2) {
                float* oc = smp ? F.out + O_CONV_S + ((size_t)(l * DB + b) * 2 + (s - (slen - 2))) * D : F.out + O_CONV_P + ((size_t)(l * NB + b) * 2 + (s - (slen - 2))) * D;
#pragma unroll
                for (int j = 0; j < 4; ++j) *(f32x4*)(oc + 16 * lane + 4 * j) = (f32x4){uc[4 * j], uc[4 * j + 1], uc[4 * j + 2], uc[4 * j + 3]};
            }
#pragma unroll
            for (int i = 0; i < 16; ++i) { up2[i] = up1[i]; up1[i] = uc[i]; }
            const size_t krow = smp ? (size_t)(TP + b * SKEYS + PAST + s) : (size_t)t;
            const int pos = smp ? PAST + s : s;
            { float v[8]; const u32x4 w = rQ[q];
              v[0] = bflo(w.x); v[1] = bfhi(w.x); v[2] = bflo(w.y); v[3] = bfhi(w.y); v[4] = bflo(w.z); v[5] = bfhi(w.z); v[6] = bflo(w.w); v[7] = bfhi(w.w);
              float ss = 0.f;
#pragma unroll
              for (int i = 0; i < 8; ++i) ss += v[i] * v[i];
              const float r = rsqrtf(wave_sum(ss) * (1.f / QL) + EPS);
              if (lane < 48) *(u32x4*)(QLn + (size_t)t * QL + 8 * lane) = (u32x4){pk2(v[0] * r * gq[0], v[1] * r * gq[1]), pk2(v[2] * r * gq[2], v[3] * r * gq[3]), pk2(v[4] * r * gq[4], v[5] * r * gq[5]), pk2(v[6] * r * gq[6], v[7] * r * gq[7])}; }
            { float v[8]; const u32x4 w = rC[q];
              v[0] = bflo(w.x); v[1] = bfhi(w.x); v[2] = bflo(w.y); v[3] = bfhi(w.y); v[4] = bflo(w.z); v[5] = bfhi(w.z); v[6] = bflo(w.w); v[7] = bfhi(w.w);
              float ss = 0.f;
#pragma unroll
              for (int i = 0; i < 8; ++i) ss += v[i] * v[i];
              const float r = rsqrtf(wave_sum(ss) * (1.f / KVL) + EPS);
              if (lane < 32) {
#pragma unroll
                  for (int i = 0; i < 8; ++i) v[i] = v[i] * r * gk[i];
                  float* oc = smp ? F.out + O_CKV_S + ((size_t)l * TS + (t - TP)) * KVL : F.out + O_CKV_P + ((size_t)l * TP + t) * KVL;
                  *(f32x4*)(oc + 8 * lane) = (f32x4){v[0], v[1], v[2], v[3]}; *(f32x4*)(oc + 8 * lane + 4) = (f32x4){v[4], v[5], v[6], v[7]};
                  *(u32x4*)(Call + krow * KVL + 8 * lane) = (u32x4){pk2(v[0], v[1]), pk2(v[2], v[3]), pk2(v[4], v[5]), pk2(v[6], v[7])}; } }
            if (lane < 16) { const float x1 = __uint_as_float(rR1[q] << 16), x2 = __uint_as_float(rR2[q] << 16); const float c = rope[pos * 32 + lane], sn = rope[pos * 32 + 16 + lane];
                const float o1 = x1 * c - x2 * sn, o2 = x1 * sn + x2 * c;
                float* ok = smp ? F.out + O_KR_S + ((size_t)l * TS + (t - TP)) * RP : F.out + O_KR_P + ((size_t)l * TP + t) * RP;
                ok[lane] = o1; ok[16 + lane] = o2;
                KR[krow * RP + lane] = (bf16_t)(pk2(o1, o1) & 0xffffu); KR[krow * RP + 16 + lane] = (bf16_t)(pk2(o2, o2) & 0xffffu); }
            }
        }
    }
}
namespace att {
constexpr int KP = 208, VP = 144, KB = 64 * KP, VB = 64 * VP, BUFB = KB + VB;
struct Ptrs { const bf16_t *Qn, *Qr, *Kn, *Vt, *KR; bf16_t* ATT; const float* rope; };
__device__ __forceinline__ float fmax3(float a, float b, float c) { return fmaxf(fmaxf(a, b), c); }
__device__ __forceinline__ void tile_core(const bf16x8 (&kf)[2][6], const bf16x8 (&vf)[2][4], const bf16x8 (&qf)[6], float& m, float& l, f32x16 (&o)[2], int nvalid, int hi) {
    f32x16 p0, p1;
#pragma unroll
    for (int r = 0; r < 16; ++r) { p0[r] = 0.f; p1[r] = 0.f; }
#pragma unroll
    for (int d0 = 0; d0 < 6; ++d0) { p0 = __builtin_amdgcn_mfma_f32_32x32x16_bf16(kf[0][d0], qf[d0], p0, 0, 0, 0); p1 = __builtin_amdgcn_mfma_f32_32x32x16_bf16(kf[1][d0], qf[d0], p1, 0, 0, 0); }
    if (nvalid < 64) {
#pragma unroll
        for (int r = 0; r < 16; ++r) { const int kv = (r & 3) + 8 * (r >> 2) + 4 * hi; if (kv >= nvalid) p0[r] = -1e30f; if (kv + 32 >= nvalid) p1[r] = -1e30f; }
    }
    float rm = fmax3(p0[0], p0[1], p1[0]);
#pragma unroll
    for (int r = 1; r < 16; ++r) rm = fmax3(rm, p0[r], p1[r]);
    rm = fmaxf(rm, __shfl_xor(rm, 32));
    if (__any(rm > m)) { const float mn = fmaxf(m, rm), f = __builtin_amdgcn_exp2f(m - mn); l *= f; m = mn;
#pragma unroll
        for (int r = 0; r < 16; ++r) { o[0][r] *= f; o[1][r] *= f; } }
    float s = 0.f;
#pragma unroll
    for (int r = 0; r < 16; ++r) { p0[r] = __builtin_amdgcn_exp2f(p0[r] - m); p1[r] = __builtin_amdgcn_exp2f(p1[r] - m); s += p0[r] + p1[r]; }
    l += s;
    bf16x8 pa[4];
    { u32x4 w;
      w = (u32x4){pk2(p0[0], p0[1]), pk2(p0[2], p0[3]), pk2(p0[4], p0[5]), pk2(p0[6], p0[7])}; pa[0] = __builtin_bit_cast(bf16x8, w);
      w = (u32x4){pk2(p0[8], p0[9]), pk2(p0[10], p0[11]), pk2(p0[12], p0[13]), pk2(p0[14], p0[15])}; pa[1] = __builtin_bit_cast(bf16x8, w);
      w = (u32x4){pk2(p1[0], p1[1]), pk2(p1[2], p1[3]), pk2(p1[4], p1[5]), pk2(p1[6], p1[7])}; pa[2] = __builtin_bit_cast(bf16x8, w);
      w = (u32x4){pk2(p1[8], p1[9]), pk2(p1[10], p1[11]), pk2(p1[12], p1[13]), pk2(p1[14], p1[15])}; pa[3] = __builtin_bit_cast(bf16x8, w); }
#pragma unroll
    for (int db = 0; db < 2; ++db)
#pragma unroll
        for (int s4 = 0; s4 < 4; ++s4) o[db] = __builtin_amdgcn_mfma_f32_32x32x16_bf16(vf[db][s4], pa[s4], o[db], 0, 0, 0);
}
__device__ __forceinline__ void load_q(bf16x8 (&qf)[6], const bf16_t* qn, const bf16_t* qr, const float* rp, int hi) {
#pragma unroll
    for (int d0 = 0; d0 < 4; ++d0) qf[d0] = *(const bf16x8*)(qn + d0 * 16 + hi * 8);
    const u32x4 a = *(const u32x4*)(qr + hi * 8), b = *(const u32x4*)(qr + 16 + hi * 8);
    const f32x4 c0 = *(const f32x4*)(rp + hi * 8), c1 = *(const f32x4*)(rp + hi * 8 + 4), s0 = *(const f32x4*)(rp + 16 + hi * 8), s1 = *(const f32x4*)(rp + 16 + hi * 8 + 4);
    const float x1[8] = {bflo(a.x), bfhi(a.x), bflo(a.y), bfhi(a.y), bflo(a.z), bfhi(a.z), bflo(a.w), bfhi(a.w)};
    const float x2[8] = {bflo(b.x), bfhi(b.x), bflo(b.y), bfhi(b.y), bflo(b.z), bfhi(b.z), bflo(b.w), bfhi(b.w)};
    const float cs[8] = {c0[0], c0[1], c0[2], c0[3], c1[0], c1[1], c1[2], c1[3]}, sn[8] = {s0[0], s0[1], s0[2], s0[3], s1[0], s1[1], s1[2], s1[3]};
    float o1[8], o2[8];
#pragma unroll
    for (int j = 0; j < 8; ++j) { o1[j] = x1[j] * cs[j] - x2[j] * sn[j]; o2[j] = x1[j] * sn[j] + x2[j] * cs[j]; }
    u32x4 w1 = (u32x4){pk2(o1[0], o1[1]), pk2(o1[2], o1[3]), pk2(o1[4], o1[5]), pk2(o1[6], o1[7])}, w2 = (u32x4){pk2(o2[0], o2[1]), pk2(o2[2], o2[3]), pk2(o2[4], o2[5]), pk2(o2[6], o2[7])};
    qf[4] = __builtin_bit_cast(bf16x8, w1); qf[5] = __builtin_bit_cast(bf16x8, w2);
}
__device__ __forceinline__ void prompt_unit(LAS unsigned char* lds, const Ptrs& P, int qloc0, int qglob0, int kloc0, int kglob0, int h, int qb) {
    int tid_ = threadIdx.x; asm volatile("" : "+v"(tid_));
    const int tid = tid_, lane = tid & 63, r32 = lane & 31, hi = lane >> 5; const int wid = __builtin_amdgcn_readfirstlane(tid >> 6);
    const int NTL = 4 * qb + 4, cq = 4 * qb + (wid >> 1);
    bf16x8 qf[6];
    { const int ql = qloc0 + 32 * wid + r32, pos = qb * 256 + 32 * wid + r32;
      load_q(qf, P.Qn + (size_t)ql * 1024 + h * 64, P.Qr + (size_t)ql * 512 + h * 32, P.rope + pos * 32, hi); }
    const bf16_t* kn_src = P.Kn + (size_t)(kloc0 + (tid >> 3)) * 1024 + h * 64 + (tid & 7) * 8;
    const bf16_t* vt_src = P.Vt + (size_t)(h * 64 + (tid >> 3)) * VT_LD + kloc0 + (tid & 7) * 8;
    const bf16_t* kr_src = P.KR + (size_t)(kglob0 + ((tid & 255) >> 2)) * 32 + (tid & 3) * 8;
    const int k_w = (tid >> 3) * KP + (tid & 7) * 16, r_w = ((tid & 255) >> 2) * KP + 128 + (tid & 3) * 16;
    const int v_w = KB + (tid >> 3) * VP + ((tid & 7) >> 1) * 32 + (tid & 1) * 8;
    u32x4 kreg, vreg, rreg = (u32x4){0u, 0u, 0u, 0u};
    kreg = *(const u32x4*)kn_src; vreg = *(const u32x4*)vt_src; if (tid < 256) rreg = *(const u32x4*)kr_src;
    *(LAS u32x4*)(lds + k_w) = kreg; if (tid < 256) *(LAS u32x4*)(lds + r_w) = rreg;
    *(LAS u32x2*)(lds + v_w) = (u32x2){vreg.x, vreg.y}; *(LAS u32x2*)(lds + v_w + 16) = (u32x2){vreg.z, vreg.w};
    __syncthreads();
    float m = -1e30f, l = 0.f; f32x16 o[2];
#pragma unroll
    for (int r = 0; r < 16; ++r) { o[0][r] = 0.f; o[1][r] = 0.f; }
    for (int j = 0; j < NTL; ++j) {
        const bool more = j + 1 < NTL;
        if (more) { kreg = *(const u32x4*)(kn_src + (size_t)(j + 1) * 64 * 1024); vreg = *(const u32x4*)(vt_src + (j + 1) * 64); if (tid < 256) rreg = *(const u32x4*)(kr_src + (size_t)(j + 1) * 64 * 32); }
        if (j <= cq) {
            const LAS unsigned char* buf = lds + (j & 1) * BUFB;
            bf16x8 kf[2][6], vf[2][4];
#pragma unroll
            for (int kb = 0; kb < 2; ++kb)
#pragma unroll
                for (int d0 = 0; d0 < 6; ++d0) kf[kb][d0] = *(const LAS bf16x8*)(buf + (kb * 32 + r32) * KP + d0 * 32 + hi * 16);
#pragma unroll
            for (int db = 0; db < 2; ++db)
#pragma unroll
                for (int s4 = 0; s4 < 4; ++s4) vf[db][s4] = *(const LAS bf16x8*)(buf + KB + (db * 32 + r32) * VP + s4 * 32 + hi * 16);
            tile_core(kf, vf, qf, m, l, o, 64, hi);
        }
        if (more) { LAS unsigned char* nb = lds + ((j + 1) & 1) * BUFB;
            *(LAS u32x4*)(nb + k_w) = kreg; if (tid < 256) *(LAS u32x4*)(nb + r_w) = rreg;
            *(LAS u32x2*)(nb + v_w) = (u32x2){vreg.x, vreg.y}; *(LAS u32x2*)(nb + v_w + 16) = (u32x2){vreg.z, vreg.w}; }
        __syncthreads();
    }
    l += __shfl_xor(l, 32);
    const float inv = 1.0f / l;
    bf16_t* orow = P.ATT + (size_t)(qglob0 + 32 * wid + r32) * 1024 + h * 64;
#pragma unroll
    for (int db = 0; db < 2; ++db)
#pragma unroll
        for (int g = 0; g < 4; ++g) { u32x2 w; w.x = pk2(o[db][4 * g] * inv, o[db][4 * g + 1] * inv); w.y = pk2(o[db][4 * g + 2] * inv, o[db][4 * g + 3] * inv);
            *(u32x2*)(orow + 32 * db + 8 * g + 4 * hi) = w; }
}
__device__ __forceinline__ void sample_unit(LAS unsigned char* lds, const Ptrs& P, int b, int h) {
    int tid_ = threadIdx.x; asm volatile("" : "+v"(tid_));
    const int tid = tid_, lane = tid & 63, r32 = lane & 31, hi = lane >> 5; const int wid = __builtin_amdgcn_readfirstlane(tid >> 6);
    const int qglob0 = TP + b * DSEQ, qloc0 = qglob0 - G0_ROWS, kglob0 = TP + b * SKEYS, kloc0 = kglob0 - G0_ROWS;
    bf16x8 qf[6];
    load_q(qf, P.Qn + (size_t)(qloc0 + r32) * 1024 + h * 64, P.Qr + (size_t)(qloc0 + r32) * 512 + h * 32, P.rope + (PAST + r32) * 32, hi);
    float m = -1e30f, l = 0.f; f32x16 o[2];
#pragma unroll
    for (int r = 0; r < 16; ++r) { o[0][r] = 0.f; o[1][r] = 0.f; }
    constexpr int NTS = (SKEYS + 63) / 64;
    for (int j = wid; j < NTS; j += NWAVES) {
        const int nvalid = (SKEYS - j * 64) < 64 ? (SKEYS - j * 64) : 64;
        bf16x8 kf[2][6], vf[2][4];
#pragma unroll
        for (int kb = 0; kb < 2; ++kb) { int key = j * 64 + kb * 32 + r32; key = key < SKEYS ? key : SKEYS - 1;
            const bf16_t* kn = P.Kn + (size_t)(kloc0 + key) * 1024 + h * 64 + hi * 8; const bf16_t* kr = P.KR + (size_t)(kglob0 + key) * 32 + hi * 8;
#pragma unroll
            for (int d0 = 0; d0 < 4; ++d0) kf[kb][d0] = *(const bf16x8*)(kn + d0 * 16);
            kf[kb][4] = *(const bf16x8*)(kr); kf[kb][5] = *(const bf16x8*)(kr + 16); }
#pragma unroll
        for (int db = 0; db < 2; ++db) { const bf16_t* vr = P.Vt + (size_t)(h * 64 + db * 32 + r32) * VT_LD + kloc0 + j * 64 + 4 * hi;
#pragma unroll
            for (int s4 = 0; s4 < 4; ++s4) { u32x2 a = (u32x2){0u, 0u}, c = (u32x2){0u, 0u};
                if (16 * s4 + 4 * hi < nvalid) a = *(const u32x2*)(vr + 16 * s4); if (16 * s4 + 8 + 4 * hi < nvalid) c = *(const u32x2*)(vr + 16 * s4 + 8);
                const u32x4 w = (u32x4){a.x, a.y, c.x, c.y}; vf[db][s4] = __builtin_bit_cast(bf16x8, w); } }
        tile_core(kf, vf, qf, m, l, o, nvalid, hi);
    }
    l += __shfl_xor(l, 32);
    LAS float* OL = (LAS float*)lds + wid * (32 * 68); LAS float* ML = (LAS float*)(lds + NWAVES * 32 * 68 * 4);
#pragma unroll
    for (int db = 0; db < 2; ++db)
#pragma unroll
        for (int g = 0; g < 4; ++g) *(LAS f32x4*)(OL + r32 * 68 + 32 * db + 8 * g + 4 * hi) = (f32x4){o[db][4 * g], o[db][4 * g + 1], o[db][4 * g + 2], o[db][4 * g + 3]};
    if (hi == 0) { ML[wid * 64 + r32] = m; ML[wid * 64 + 32 + r32] = l; }
    __syncthreads();
    { const int q = tid >> 4, d = (tid & 15) * 4; float M = -1e30f;
#pragma unroll
      for (int w = 0; w < NWAVES; ++w) M = fmaxf(M, ML[w * 64 + q]);
      float L = 0.f; f32x4 acc = (f32x4){0.f, 0.f, 0.f, 0.f};
#pragma unroll
      for (int w = 0; w < NWAVES; ++w) { const float f = __builtin_amdgcn_exp2f(ML[w * 64 + q] - M); L += f * ML[w * 64 + 32 + q]; acc = acc + *(const LAS f32x4*)((LAS float*)lds + w * (32 * 68) + q * 68 + d) * f; }
      const float inv = 1.0f / L; u32x2 wv; wv.x = pk2(acc[0] * inv, acc[1] * inv); wv.y = pk2(acc[2] * inv, acc[3] * inv);
      *(u32x2*)(P.ATT + (size_t)(qglob0 + q) * 1024 + h * 64 + d) = wv; }
    __syncthreads();
}
__device__ __forceinline__ void attn_phase(LAS unsigned char* lds, const Ptrs& P, int g, int G) {
    const int vb = (G % 8 == 0) ? (int)((blockIdx.x & 7) * (G >> 3) + (blockIdx.x >> 3)) : (int)blockIdx.x;
    for (int pi = vb; pi < 512; pi += G) { const int combo = pi >> 2, s = pi & 3, bl = combo >> 4, h = combo & 15;
        const int brow_glob = (g * 8 + bl) * SEQ, brow_loc = brow_glob - g * G0_ROWS;
#pragma unroll 1
        for (int hf = 0; hf < 2; ++hf) { const int qb = hf ? 7 - s : s; prompt_unit(lds, P, brow_loc + qb * 256, brow_glob + qb * 256, brow_loc, brow_glob, h, qb); } }
    if (g == 1) for (int ui = blockIdx.x; ui < DB * NH; ui += G) sample_unit(lds, P, ui >> 4, ui & 15);
}
}
#define XB_TMO      128
#define XB_XCNT(j)  (256  + 64 * (j))
#define XB_XSUB(j)  (1280 + 64 * (j))
#define XB_XGEN(j)  (2304 + 64 * (j))
#define XB_TOP      3328
#define XB_TOPGEN   3392
#define XCD_BAR_WORDS 3456
#define XB_SPIN_CAP (1u << 18)

__device__ __forceinline__ unsigned xb_ld(unsigned* p)              { return __hip_atomic_load(p, __ATOMIC_RELAXED, __HIP_MEMORY_SCOPE_AGENT); }
__device__ __forceinline__ unsigned xb_add(unsigned* p, unsigned v) { return __hip_atomic_fetch_add(p, v, __ATOMIC_RELAXED, __HIP_MEMORY_SCOPE_AGENT); }
__device__ __forceinline__ unsigned xb_xcc_id() { return (unsigned)__builtin_amdgcn_s_getreg((3 << 11) | 20) & 0xFu; }
#define XB_SPIN(cond, bar) do { unsigned _sp = 0; while (cond) { __builtin_amdgcn_s_sleep(1); \
    if ((++_sp & 255u) == 0u) { if (xb_ld(&(bar)[XB_TMO])) break; if (_sp > XB_SPIN_CAP) { atomicAdd(&(bar)[XB_TMO], 1u); break; } } } } while (0)

struct XcdBarrier {
    unsigned* bar; unsigned x;
    volatile __attribute__((address_space(3))) unsigned* st;
};

__device__ __forceinline__ XcdBarrier xcd_barrier_post(unsigned* bar, volatile __attribute__((address_space(3))) unsigned* st) {
    XcdBarrier b; b.bar = bar; b.x = xb_xcc_id(); b.st = st;
    if (threadIdx.x == 0) (void)xb_add(&bar[XB_XCNT(b.x)], 1u);
    return b;
}
__device__ __forceinline__ void xcd_barrier_complete(unsigned* bar, unsigned x, unsigned& nloc, unsigned& nx) {
    const unsigned G = gridDim.x * gridDim.y * gridDim.z;
    unsigned sum, cnt, mine, sp = 0u;
    for (;;) {
        sum = 0u; cnt = 0u; mine = 0u;
#pragma unroll
        for (unsigned j = 0; j < 16; ++j) { const unsigned c = xb_ld(&bar[XB_XCNT(j)]); sum += c; cnt += (c > 0u) ? 1u : 0u; mine = (j == x) ? c : mine; }
        if (sum == G) break;
        __builtin_amdgcn_s_sleep(1);
        if ((++sp & 255u) == 0u) { if (xb_ld(&bar[XB_TMO])) break; if (sp > XB_SPIN_CAP) { atomicAdd(&bar[XB_TMO], 1u); break; } }
    }
    nloc = mine > 0u ? mine : 1u; nx = cnt > 0u ? cnt : 1u;
}

__device__ __forceinline__ void xcd_barrier(const XcdBarrier& b) {
    asm volatile("s_waitcnt vmcnt(0)" ::: "memory");
    __syncthreads();
    if (threadIdx.x == 0) {
        unsigned* bar = b.bar;
        __builtin_amdgcn_s_waitcnt(0);
        unsigned nloc = b.st[0], nx = b.st[1];
        if (nloc == 0u) { xcd_barrier_complete(bar, b.x, nloc, nx); b.st[0] = nloc; b.st[1] = nx; }
        const unsigned old = xb_add(&bar[XB_XSUB(b.x)], 1u);
        const unsigned gen = old / nloc;
        if (old + 1u == (gen + 1u) * nloc) {
            __builtin_amdgcn_fence(__ATOMIC_RELEASE, "agent");
            asm volatile("s_waitcnt vmcnt(0)" ::: "memory");
            const unsigned og = xb_add(&bar[XB_TOP], 1u);
            const unsigned tg = og / nx;
            if (og + 1u == (tg + 1u) * nx) xb_add(&bar[XB_TOPGEN], 1u);
            else XB_SPIN(xb_ld(&bar[XB_TOPGEN]) == tg, bar);
            __builtin_amdgcn_fence(__ATOMIC_ACQUIRE, "agent");
            xb_add(&bar[XB_XGEN(b.x)], 1u);
            asm volatile("s_waitcnt vmcnt(0)" ::: "memory");
        } else {
            XB_SPIN(xb_ld(&bar[XB_XGEN(b.x)]) == gen, bar);
            __builtin_amdgcn_fence(__ATOMIC_ACQUIRE, "agent");
            asm volatile("s_waitcnt vmcnt(0)" ::: "memory");
        }
    }
    __syncthreads();
}

__device__ __forceinline__ void small_gemm(LAS unsigned char* lds, unsigned char* ws, size_t oA, size_t oB, int N_out, int K, int kind, size_t oO, int ldc, int G) {
    int tid_ = threadIdx.x; asm volatile("" : "+v"(tid_));
    const int tid = tid_, lane = tid & 63, r32 = lane & 31, hi = lane >> 5; const int wid = __builtin_amdgcn_readfirstlane(tid >> 6);
    const int kq = wid & 3, rh = wid >> 2;
    const bool paired = kind == pg8::EK_SWIGLU;
    const int nitems = 4 * (N_out / 64);
    const bf16_t* A = (const bf16_t*)(ws + oA) + (size_t)TP * K; const bf16_t* Bt = (const bf16_t*)(ws + oB);
    const int kslice = K / 4, k0 = kq * kslice;
    LAS float* PA = (LAS float*)lds; LAS float* PB = (LAS float*)(lds + 65536);
    for (int it = blockIdx.x; it < nitems; it += G) {
        const int rb = it & 3, cg = it >> 2;
        int browa, ocol;
        if (paired) { const int tile = cg >> 1, half = cg & 1; browa = tile * 256 + half * 64; ocol = tile * 128 + half * 64; } else { browa = cg * 64; ocol = cg * 64; }
        const bf16_t* ap = A + (size_t)(rb * 64 + rh * 32 + r32) * K + k0 + 8 * hi;
        const bf16_t* bp0 = Bt + (size_t)(browa + r32) * K + k0 + 8 * hi;
        f32x16 ca[2], cb[2];
#pragma unroll
        for (int r = 0; r < 16; ++r) { ca[0][r] = 0.f; ca[1][r] = 0.f; cb[0][r] = 0.f; cb[1][r] = 0.f; }
        if (paired) {
#pragma unroll 2
            for (int k = 0; k < kslice; k += 16) {
                const bf16x8 af = *(const bf16x8*)(ap + k);
                const bf16x8 b0 = *(const bf16x8*)(bp0 + k), b1 = *(const bf16x8*)(bp0 + (size_t)32 * K + k), b2 = *(const bf16x8*)(bp0 + (size_t)128 * K + k), b3 = *(const bf16x8*)(bp0 + (size_t)160 * K + k);
                ca[0] = __builtin_amdgcn_mfma_f32_32x32x16_bf16(af, b0, ca[0], 0, 0, 0); ca[1] = __builtin_amdgcn_mfma_f32_32x32x16_bf16(af, b1, ca[1], 0, 0, 0);
                cb[0] = __builtin_amdgcn_mfma_f32_32x32x16_bf16(af, b2, cb[0], 0, 0, 0); cb[1] = __builtin_amdgcn_mfma_f32_32x32x16_bf16(af, b3, cb[1], 0, 0, 0);
            }
        } else {
#pragma unroll 4
            for (int k = 0; k < kslice; k += 16) {
                const bf16x8 af = *(const bf16x8*)(ap + k);
                const bf16x8 b0 = *(const bf16x8*)(bp0 + k), b1 = *(const bf16x8*)(bp0 + (size_t)32 * K + k);
                ca[0] = __builtin_amdgcn_mfma_f32_32x32x16_bf16(af, b0, ca[0], 0, 0, 0); ca[1] = __builtin_amdgcn_mfma_f32_32x32x16_bf16(af, b1, ca[1], 0, 0, 0);
            }
        }
#pragma unroll
        for (int nb = 0; nb < 2; ++nb)
#pragma unroll
            for (int r = 0; r < 16; ++r) { PA[((kq * 4 + rh * 2 + nb) * 16 + r) * 64 + lane] = ca[nb][r]; if (paired) PB[((kq * 4 + rh * 2 + nb) * 16 + r) * 64 + lane] = cb[nb][r]; }
        __syncthreads();
        { const int blk = tid >> 7, r = (tid >> 3) & 15, h2 = (tid >> 2) & 1, g = tid & 3;
          f32x4 v0 = (f32x4){0.f, 0.f, 0.f, 0.f}, v1 = v0, w0 = v0, w1 = v0;
#pragma unroll
          for (int q = 0; q < 4; ++q) { const int o = ((q * 4 + blk) * 16 + r) * 64 + h2 * 32 + 8 * g;
              v0 = v0 + *(const LAS f32x4*)(PA + o); v1 = v1 + *(const LAS f32x4*)(PA + o + 4);
              if (paired) { w0 = w0 + *(const LAS f32x4*)(PB + o); w1 = w1 + *(const LAS f32x4*)(PB + o + 4); } }
          const int orow = TP + rb * 64 + (blk >> 1) * 32 + (r & 3) + 8 * (r >> 2) + 4 * h2, c = ocol + (blk & 1) * 32 + 8 * g;
          const size_t off = (size_t)orow * ldc + c; bf16_t* O = (bf16_t*)(ws + oO);
          if (kind == pg8::EK_SWIGLU) {
              { const float rr = ((const float*)(ws + WS_RSB))[orow]; v0 = v0 * rr; v1 = v1 * rr; w0 = w0 * rr; w1 = w1 * rr; }
#pragma unroll
              for (int i = 0; i < 4; ++i) { v0[i] = v0[i] * pg8::sigm(v0[i]) * w0[i]; v1[i] = v1[i] * pg8::sigm(v1[i]) * w1[i]; }
          } else if (kind == pg8::EK_GATE) { const u32x4 gg = *(const u32x4*)((const bf16_t*)(ws + WS_R1) + off);
              v0[0] *= bflo(gg.x); v0[1] *= bfhi(gg.x); v0[2] *= bflo(gg.y); v0[3] *= bfhi(gg.y); v1[0] *= bflo(gg.z); v1[1] *= bfhi(gg.z); v1[2] *= bflo(gg.w); v1[3] *= bfhi(gg.w);
          } else if (kind == pg8::EK_COMBINE) { const u32x4 y = *(const u32x4*)((const bf16_t*)(ws + WS_R1) + off); const u32x4 gg = *(const u32x4*)((const bf16_t*)(ws + WS_R2) + off);
              v0[0] = bflo(y.x) + bflo(gg.x) * v0[0]; v0[1] = bfhi(y.x) + bfhi(gg.x) * v0[1]; v0[2] = bflo(y.y) + bflo(gg.y) * v0[2]; v0[3] = bfhi(y.y) + bfhi(gg.y) * v0[3];
              v1[0] = bflo(y.z) + bflo(gg.z) * v1[0]; v1[1] = bfhi(y.z) + bfhi(gg.z) * v1[1]; v1[2] = bflo(y.w) + bflo(gg.w) * v1[2]; v1[3] = bfhi(y.w) + bfhi(gg.w) * v1[3]; }
          *(u32x4*)(O + off) = (u32x4){pk2(v0[0], v0[1]), pk2(v0[2], v0[3]), pk2(v1[0], v1[1]), pk2(v1[2], v1[3])}; }
        __syncthreads();
    }
}

constexpr int NSTEP = 18;
__host__ __device__ constexpr bool step_sync(int l, int s) { return !(s == 3 || s == 4 || s == 5 || s == 8 || s == 9 || (s == 0 && l != 0)); }
__device__ __forceinline__ void run_gemm(Frame& F, int s) {
    unsigned char* ws = F.ws;
    const int grp = (s >= 8) ? 1 : 0;
    size_t oA = WS_R0, oB = WS_W, oO = WS_R1;
    int M = T, N = D, K = D, kind = pg8::EK_PLAIN, ldc = 1024, rot = 0; float scale = 1.f;
    if (s == 1) { oB = WS_W + W_IN * 2; N = DINP; kind = pg8::EK_WIN; oO = WS_BG; }
    else if (s == 3) { oB = WS_W + W_CONV * 2; kind = pg8::EK_GATE; oO = WS_R1; }
    else if (s == 4 || s == 8) { oA = WS_QLN + (size_t)grp * G0_ROWS * QL * 2; oB = WS_W + W_UQ * 2; M = grp ? G1_ROWS : G0_ROWS; N = 1536; K = QL; kind = pg8::EK_Q; oO = WS_QN; scale = QSCALE; rot = grp ? 0 : 128; }
    else if (s == 5 || s == 9) { oA = WS_CALL + (size_t)grp * G0_ROWS * KVL * 2; oB = WS_W + W_UK * 2; M = grp ? G1_KEYS : G0_ROWS; N = 1024; K = KVL; oO = WS_KN; rot = grp ? 112 : 0; }
    else if (s == 6 || s == 10) { oA = WS_W + W_UV * 2; oB = WS_CALL + (size_t)grp * G0_ROWS * KVL * 2; M = 1024; N = grp ? G1_KEYS : G0_ROWS; K = KVL; oO = WS_VT; ldc = VT_LD; rot = grp ? 104 : 0; }
    else if (s == 12) { oB = WS_W + W_ATTN * 2; kind = pg8::EK_COMBINE; oO = WS_R3; }
    else if (s == 13) { oA = WS_R3; oB = WS_W + W_MERGE * 2; oO = WS_R3 + U1; }
    else if (s == 15) { oA = WS_R2; oB = WS_W + W_GU * 2; N = 2 * DFF; kind = pg8::EK_SWIGLU; oO = WS_R3; ldc = DFF; }
    else { oA = WS_R3; oB = WS_W + W_DOWN * 2; K = DFF; oO = WS_R1; }
    const bool split_sample = (s == 3 || s == 12 || s == 13 || s == 15 || s == 16);
    if (split_sample) M = TP;
    const pg8::bf16_t* Ap = (s == 1) ? (const pg8::bf16_t*)(F.out + O_Y) : (const pg8::bf16_t*)(ws + oA);
    const pg8::Gemm g{Ap, (const pg8::bf16_t*)(ws + oB), M, N, K};
    const pg8::EpiX E{kind, ws, oO, ldc, scale, (s == 15) ? WS_RSB : WS_RSA, (s == 1 || s == 15) ? 1 : 0};
    pg8::StaticOrder S; S.init(g.M, g.N, F.G, (int)((blockIdx.x + rot) % F.G));
    pg8::gemm_phase<pg8::EpiX, pg8::StaticOrder, true, true>(F.lds, g, S, E);
    if (split_sample) small_gemm(F.lds, ws, oA, oB, kind == pg8::EK_SWIGLU ? N / 2 : N, K, kind, oO, ldc, F.G);
}

__global__ void __launch_bounds__(NWAVES * 64, 2) fwd_mega(Args args) {
    extern __shared__ __attribute__((aligned(16))) unsigned char lds_raw[];
    cg::grid_group grid = cg::this_grid();
    Frame F;
    F.lds = (LAS unsigned char*)lds_raw; F.tid = threadIdx.x; F.lane = F.tid & 63; F.wave = __builtin_amdgcn_readfirstlane(F.tid >> 6); F.G = gridDim.x;
    F.in = args.in;
    F.out = args.out; F.ws = args.ws;
    volatile LAS unsigned* bst = (volatile LAS unsigned*)(F.lds + 131072);
    if (F.tid < 64) bst[F.tid] = 0u;
    __syncthreads();
    XcdBarrier bar = xcd_barrier_post((unsigned*)(args.ws) + 1024, bst + 8);
    for (int vst = args.st_lo * 2; vst < args.st_hi * 2; ++vst) {
        const int st = vst >> 1, rep = vst & 1;
        const int l = st / NSTEP, s = st % NSTEP;
        { int t_ = threadIdx.x; asm volatile("" : "+v"(t_)); F.tid = t_; F.lane = t_ & 63; F.wave = __builtin_amdgcn_readfirstlane(t_ >> 6); }
#ifndef PROBE_GEMM
#define PROBE_GEMM 0
#endif
#ifndef PROBE_ATT
#define PROBE_ATT 0
#endif
        const bool is_g = (s == 1 || s == 4 || s == 5 || s == 6 || s == 8 || s == 9 || s == 10 || s == 12 || s == 13 || s == 15 || s == 16);
        const int reps = ((PROBE_GEMM && is_g) || (PROBE_ATT && (s == 7 || s == 11))) ? 2 : 1;
        if (rep >= reps) continue;
        if (l == 0 && (s == 0 || s == 17)) convert_weights(F, s == 0 ? 0 : 1);
        if (s == 0) { if (l == 0) { build_rope(F); phase_norm_in(F); } }
        else if (s == 2) phase_c(F, l);
        else if (s == 7 || s == 11) {
            att::Ptrs P; P.Qn = (const bf16_t*)(F.ws + WS_QN); P.Qr = (const bf16_t*)(F.ws + WS_QR); P.Kn = (const bf16_t*)(F.ws + WS_KN); P.Vt = (const bf16_t*)(F.ws + WS_VT);
            P.KR = (const bf16_t*)(F.ws + WS_KR); P.ATT = (bf16_t*)(F.ws + WS_R0); P.rope = (const float*)(F.ws + WS_ROPE);
            att::attn_phase(F.lds, P, s == 7 ? 0 : 1, F.G);
        }
        else if (s == 14) phase_h(F, l);
        else if (s == 17) phase_k(F, l);
        else run_gemm(F, s);
        if (rep + 1 == reps && step_sync(l, s) && st + 1 < args.st_hi) { if (args.st_lo < 0) grid.sync(); else xcd_barrier(bar); }
    }
}

#ifndef MK_MULTI
#define MK_MULTI 0
#endif
extern "C" void kernel_launch(void* const* d_in, const int* in_sizes, int n_in, void* d_out, int out_size, void* d_ws, size_t ws_size, hipStream_t stream) {
    static int grid_blocks = 0;
    if (grid_blocks == 0) {
        if (n_in != 20 || out_size != (int)O_END || ws_size < WS_END) { fprintf(stderr, "kernel_launch: unexpected shapes n_in %d out %d ws %zu (need %zu)\n", n_in, out_size, ws_size, (size_t)WS_END); grid_blocks = -1; return; }
        int dev = 0, cus = 0, per_cu = 0;
        (void)hipGetDevice(&dev); (void)hipDeviceGetAttribute(&cus, hipDeviceAttributeMultiprocessorCount, dev);
        (void)hipFuncSetAttribute((const void*)fwd_mega, hipFuncAttributeMaxDynamicSharedMemorySize, LDS_BYTES);
        (void)hipOccupancyMaxActiveBlocksPerMultiprocessor(&per_cu, (const void*)fwd_mega, NWAVES * 64, LDS_BYTES);
        if (per_cu < 1) per_cu = 1;
        if (cus <= 0) cus = 256;
        grid_blocks = cus * per_cu;
    }
    if (grid_blocks < 0) return;
    Args a{};
    for (int i = 0; i < 20; ++i) a.in[i] = (const float*)d_in[i];
    a.out = (float*)d_out; a.ws = (unsigned char*)d_ws;
    (void)hipMemsetAsync(d_ws, 0, 65536, stream);
#if MK_MULTI
    int lo = 0;
    for (int st = 0; st < 2 * NSTEP; ++st) {
        if (step_sync(st / NSTEP, st % NSTEP) || st + 1 == 2 * NSTEP) { a.st_lo = lo; a.st_hi = st + 1; hipLaunchKernelGGL(fwd_mega, dim3(grid_blocks), dim3(NWAVES * 64), LDS_BYTES, stream, a); lo = st + 1; }
    }
#else
    a.st_lo = 0; a.st_hi = 2 * NSTEP;
    void* params[] = {&a};
    hipError_t e = hipLaunchCooperativeKernel((const void*)fwd_mega, dim3(grid_blocks), dim3(NWAVES * 64), params, LDS_BYTES, stream);
    if (e != hipSuccess) fprintf(stderr, "cooperative launch failed: %s (grid %d)\n", hipGetErrorString(e), grid_blocks);
#endif
}
```

```cpp
#include <hip/hip_runtime.h>
#include <hip/hip_cooperative_groups.h>
#include <cstdio>
#include <cstdint>
namespace cg = cooperative_groups;
constexpr int NWAVES = 8;
constexpr int D = 1024, TP = 32768, TS = 256, T = TP + TS, SEQ = 2048, NB = 16, DB = 8, DSEQ = 32, PAST = 2048, SKEYS = PAST + DSEQ, KT = TP + DB * SKEYS;
constexpr int DIN = 5792, DINP = 5888, QL = 384, KVL = 256, RP = 32, DFF = 2816, NH = 16, LATP = 768;
constexpr int G0_ROWS = 16384, G1_ROWS = T - G0_ROWS, G1_KEYS = KT - G0_ROWS, VT_LD = 33024;
constexpr float EPS = 1e-6f;
constexpr float QSCALE = 0.10206207261596577f * 1.4426950408889634f;
static_assert(T % 256 == 0 && G1_ROWS % 256 == 0 && G1_KEYS % 256 == 0 && KT % 256 == 0 && G1_KEYS == VT_LD, "tiles");
constexpr size_t O_Y = 0, O_CONV_P = (size_t)T * D, O_CKV_P = O_CONV_P + 2 * NB * 2 * D, O_KR_P = O_CKV_P + (size_t)2 * TP * KVL, O_CONV_S = O_KR_P + (size_t)2 * TP * RP,
                 O_CKV_S = O_CONV_S + 2 * DB * 2 * D, O_KR_S = O_CKV_S + (size_t)2 * TS * KVL, O_END = O_KR_S + (size_t)2 * TS * RP;
static_assert(O_END == 52936704, "d_out size");
constexpr size_t MiB = 1u << 20, U1 = (size_t)T * D * 2;
constexpr size_t WS_RSA = 256 * 1024, WS_RSB = 512 * 1024;
constexpr size_t WS_ROPE = 1 * MiB, WS_W = 2 * MiB, WS_R0 = 40 * MiB, WS_R1 = WS_R0 + U1, WS_R2 = WS_R1 + U1, WS_R3 = WS_R2 + U1, WS_R6 = WS_R3 + 178 * MiB;
constexpr size_t WS_QLN = WS_R6, WS_CALL = WS_QLN + (size_t)T * QL * 2, WS_KR = WS_CALL + (size_t)KT * KVL * 2, WS_END = WS_KR + (size_t)KT * RP * 2;
constexpr size_t W_IN = 0, W_UQ = W_IN + (size_t)DINP * D, W_UK = W_UQ + (size_t)1536 * QL, W_UV = W_UK + (size_t)1024 * KVL, W_CONV = W_UV + (size_t)1024 * KVL,
                 W_ATTN = W_CONV + (size_t)D * D, W_MERGE = W_ATTN + (size_t)D * D, W_GU = W_MERGE + (size_t)D * D, W_DOWN = W_GU + (size_t)2 * DFF * D, W_END = W_DOWN + (size_t)D * DFF;
static_assert(WS_W + W_END * 2 <= WS_R0, "weights fit");
constexpr size_t WS_BG = WS_R3, WS_U = WS_R3 + U1, WS_LAT = WS_R3 + 2 * U1;
constexpr size_t WS_QN = WS_R3, WS_QR = WS_QN + (size_t)G1_ROWS * 1024 * 2, WS_KN = WS_QR + (size_t)G1_ROWS * 512 * 2, WS_VT = WS_KN + (size_t)G1_KEYS * 1024 * 2, WS_GEND = WS_VT + (size_t)1024 * VT_LD * 2;
static_assert(WS_GEND <= WS_R6 && WS_LAT + (size_t)T * LATP * 2 <= WS_R6 && WS_R3 + (size_t)T * DFF * 2 <= WS_R6, "R3 region");
static_assert(WS_END <= 536870912, "d_ws budget (512 MiB)");
constexpr int LDS_BYTES = 131072 + 1024;


namespace pg8 {
#define PG8_LAS __attribute__((address_space(3)))
typedef unsigned short bf16_t;
typedef short bf16x8 __attribute__((ext_vector_type(8)));
typedef float f32x4 __attribute__((ext_vector_type(4)));
typedef unsigned u32x4 __attribute__((ext_vector_type(4)));
constexpr int BM = 256, BK = 64, HALF = 128, HTB = HALF * BK * 2  , STAGE_BYTES = 8 * HTB, NXCD = 8, WGM = 8;

__host__ __device__ __forceinline__ int lds_byte(int r, int c) { const int st = (r >> 4) * 2 + (c >> 5), rr = r & 15, cc = c & 31, ob = rr * 64 + cc * 2; return st * 1024 + (ob ^ (((ob >> 9) & 1) << 5)); }
__host__ __device__ __forceinline__ void stage_rc(int b, int& R, int& C) { const int st = b / 1024, sb = b % 1024, swz = sb ^ (((sb >> 9) & 1) << 5); R = (st >> 1) * 16 + swz / 64; C = (st & 1) * 32 + (swz % 64) / 2; }
__host__ __device__ __forceinline__ int perm32(int rho) { const int n = rho >> 4, i = rho & 15; return 8 * (i >> 2) + 4 * n + (i & 3); }

struct Unit { int pm, pn; };
struct Gemm { const bf16_t* A; const bf16_t* Bt; int M, N, K; };

struct StaticOrder {
    int nM, nN, nwg, G, c;
    __host__ __device__ void init(int M, int N, int G_, int c_) { nM = M / BM; nN = N / BM; nwg = nM * nN; G = G_; c = c_; }
    __host__ __device__ bool next(int i, Unit& u) const {
        const long L = (long)i * G + c; if (L >= nwg) return false;
        int wgid = (int)L; { const int q = nwg / NXCD, r = nwg % NXCD, xcd = wgid % NXCD, off = wgid / NXCD; wgid = (xcd < r ? xcd * (q + 1) : r * (q + 1) + (xcd - r) * q) + off; }
        const int nig = WGM * nN, gid = wgid / nig, fm = gid * WGM, gsz = (nM - fm) < WGM ? (nM - fm) : WGM;
        u.pm = fm + ((wgid % nig) % gsz); u.pn = (wgid % nig) / gsz; return true;
    }
    __device__ __forceinline__ void a_ready(const Unit&) const {}
    __device__ __forceinline__ void done(const Unit&) const {}
};

__device__ __forceinline__ unsigned cvt_pk_bf16(float lo, float hi) { unsigned r; asm volatile("v_cvt_pk_bf16_f32 %0, %1, %2" : "=v"(r) : "v"(lo), "v"(hi)); return r; }
typedef float f32x2 __attribute__((ext_vector_type(2)));
typedef unsigned u32x4e __attribute__((ext_vector_type(4)));
enum { EK_PLAIN = 0, EK_PAIRMUL = 1, EK_SWIGLU = 2, EK_SIGMOID = 3, EK_GATE = 4, EK_COMBINE = 5, EK_WIN = 6, EK_Q = 7 };
__device__ __forceinline__ float sigm(float x) { return __builtin_amdgcn_rcpf(1.0f + __builtin_amdgcn_exp2f(-1.4426950408889634f * x)); }
__device__ __forceinline__ float bflo(unsigned w) { return __uint_as_float(w << 16); }
__device__ __forceinline__ float bfhi(unsigned w) { return __uint_as_float(w & 0xffff0000u); }
struct EpiX {
    static constexpr bool PERM = true, AFTER_DRAIN = false;
    int kind; unsigned char* ws; size_t oO; int ldc; float scale; size_t oRS; int use_rs;
    __device__ __forceinline__ void operator()(const f32x4 (&acc)[2][2][4][2], const Unit& u, int wr, int wc, int fr, int fq) const {
        int k = kind; size_t ob = oO; int ld = ldc; int colt = u.pn * BM; const float sc = scale;
        if (k == EK_WIN) {
            const int pn = u.pn;
            if (pn < 4) { k = EK_PLAIN; }
            else if (pn < 12) { k = EK_PAIRMUL; ob = WS_U; colt = (pn - 4) * 128; }
            else if (pn < 16) { k = EK_SIGMOID; ob = WS_R1; colt = (pn - 12) * 256; }
            else if (pn < 20) { k = EK_SIGMOID; ob = WS_R2; colt = (pn - 16) * 256; }
            else { k = EK_PLAIN; ob = WS_LAT; colt = (pn - 20) * 256; ld = 768; }
        } else if (k == EK_Q) {
            k = EK_PLAIN; if (u.pn >= 4) { ob = WS_QR; colt = (u.pn - 4) * 256; ld = 512; }
        } else if (k == EK_PAIRMUL || k == EK_SWIGLU) colt = u.pn * 128;
        const int row0 = u.pm * BM + wr * 64 + fr;
        const int col0 = colt + wc * 32 + 8 * fq;
        bf16_t* base = (bf16_t*)(ws + ob); const bf16_t* aux1 = (const bf16_t*)(ws + WS_R1); const bf16_t* aux2 = (const bf16_t*)(ws + WS_R2);
        const float* rsp = (const float*)(ws + oRS);
        if (k == EK_PAIRMUL || k == EK_SWIGLU) {
#pragma unroll
            for (int ai = 0; ai < 2; ++ai)
#pragma unroll
                for (int m = 0; m < 4; ++m) {
                    bf16_t* rowp = base + (size_t)(row0 + ai * HALF + m * 16) * ld + col0;
                    const float rr = use_rs ? rsp[row0 + ai * HALF + m * 16] : 1.f;
                    f32x4 a0 = acc[ai][0][m][0] * rr, a1 = acc[ai][0][m][1] * rr; const f32x4 b0 = acc[ai][1][m][0] * rr, b1 = acc[ai][1][m][1] * rr;
                    if (k == EK_SWIGLU) {
#pragma unroll
                        for (int i = 0; i < 4; ++i) { a0[i] = a0[i] * sigm(a0[i]); a1[i] = a1[i] * sigm(a1[i]); }
                    }
                    const f32x4 v0 = a0 * b0, v1 = a1 * b1;
                    u32x4e w; w.x = cvt_pk_bf16(v0[0], v0[1]); w.y = cvt_pk_bf16(v0[2], v0[3]); w.z = cvt_pk_bf16(v1[0], v1[1]); w.w = cvt_pk_bf16(v1[2], v1[3]);
                    *(u32x4e*)rowp = w;
                }
        } else {
#pragma unroll
            for (int ai = 0; ai < 2; ++ai)
#pragma unroll
                for (int m = 0; m < 4; ++m) {
                    const size_t roff = (size_t)(row0 + ai * HALF + m * 16) * ld + col0;
                    const float rr = use_rs ? rsp[row0 + ai * HALF + m * 16] : 1.f;
#pragma unroll
                    for (int bj = 0; bj < 2; ++bj) {
                        f32x4 v0 = acc[ai][bj][m][0], v1 = acc[ai][bj][m][1];
                        const size_t off = roff + bj * HALF;
                        if (k == EK_PLAIN) { v0 = v0 * (sc * rr); v1 = v1 * (sc * rr); }
                        else if (k == EK_SIGMOID) {
#pragma unroll
                            for (int i = 0; i < 4; ++i) { v0[i] = sigm(v0[i] * rr); v1[i] = sigm(v1[i] * rr); }
                        } else if (k == EK_GATE) {
                            const u32x4e g = *(const u32x4e*)(aux1 + off);
                            v0[0] *= bflo(g.x); v0[1] *= bfhi(g.x); v0[2] *= bflo(g.y); v0[3] *= bfhi(g.y);
                            v1[0] *= bflo(g.z); v1[1] *= bfhi(g.z); v1[2] *= bflo(g.w); v1[3] *= bfhi(g.w);
                        } else {
                            const u32x4e y = *(const u32x4e*)(aux1 + off); const u32x4e g = *(const u32x4e*)(aux2 + off);
                            v0[0] = bflo(y.x) + bflo(g.x) * v0[0]; v0[1] = bfhi(y.x) + bfhi(g.x) * v0[1]; v0[2] = bflo(y.y) + bflo(g.y) * v0[2]; v0[3] = bfhi(y.y) + bfhi(g.y) * v0[3];
                            v1[0] = bflo(y.z) + bflo(g.z) * v1[0]; v1[1] = bfhi(y.z) + bfhi(g.z) * v1[1]; v1[2] = bflo(y.w) + bflo(g.w) * v1[2]; v1[3] = bfhi(y.w) + bfhi(g.w) * v1[3];
                        }
                        u32x4e w; w.x = cvt_pk_bf16(v0[0], v0[1]); w.y = cvt_pk_bf16(v0[2], v0[3]); w.z = cvt_pk_bf16(v1[0], v1[1]); w.w = cvt_pk_bf16(v1[2], v1[3]);
                        *(u32x4e*)(base + off) = w;
                    }
                }
        }
    }
};
template <class Epi, class Sched, bool ALIGN_EPI = false, bool SP2 = false>
__device__ __forceinline__ void gemm_phase(PG8_LAS unsigned char* lds, const Gemm g, const Sched& S, const Epi& E) {
    int tid_ = threadIdx.x; asm volatile("" : "+v"(tid_));
    const int tid = tid_, wid = __builtin_amdgcn_readfirstlane(tid >> 6), lane = tid & 63, wr = wid >> 2, wc = wid & 3, fr = lane & 15, fq = lane >> 4;
    const int K = g.K, nt = K / BK;
    unsigned voffA[2], voffB[2];
#pragma unroll
    for (int i = 0; i < 2; ++i) { int R, C; stage_rc(tid * 16 + i * 8192, R, C); const int Rb = Epi::PERM ? ((R & ~31) + perm32(R & 31)) : R;
        voffA[i] = (unsigned)(R * K + C) * 2u; voffB[i] = (unsigned)(Rb * K + C) * 2u; }
    const size_t kstep = (size_t)(BK * 2);
    const size_t hstep = (size_t)HALF * K * 2;
    const size_t tstep = 2 * hstep;
    const unsigned ldsw = (unsigned)wid * 1024u;
    const int aoff = lds_byte(wr * 64 + fr, fq * 8), boff = lds_byte(wc * 32 + fr, fq * 8);
#define PG8_SA(b, h) (((b) * 2 + (h)) * HTB)
#define PG8_SB(b, h) ((4 + (b) * 2 + (h)) * HTB)
#define PG8_STAGE(bufoff, gbase, voff) do { _Pragma("unroll") for (int _i = 0; _i < 2; ++_i) \
        __builtin_amdgcn_global_load_lds((const unsigned*)((const char*)(gbase) + (voff)[_i]), (PG8_LAS unsigned*)(lds + (bufoff) + ldsw + _i * 8192), 16, 0, 0); } while (0)
#define PG8_LDA(dst, b, h) do { _Pragma("unroll") for (int m = 0; m < 4; ++m) _Pragma("unroll") for (int k = 0; k < 2; ++k) dst[m][k] = *(const PG8_LAS bf16x8*)(lds + PG8_SA(b, h) + aoff + m * 2048 + k * 1024); } while (0)
#define PG8_LDB(dst, b, h) do { _Pragma("unroll") for (int n = 0; n < 2; ++n) _Pragma("unroll") for (int k = 0; k < 2; ++k) dst[n][k] = *(const PG8_LAS bf16x8*)(lds + PG8_SB(b, h) + boff + n * 2048 + k * 1024); } while (0)
#define PG8_MMA(ai, bj, At, Bt) do { __builtin_amdgcn_s_setprio(1); _Pragma("unroll") for (int m = 0; m < 4; ++m) _Pragma("unroll") for (int n = 0; n < 2; ++n) _Pragma("unroll") for (int k = 0; k < 2; ++k) \
        acc[ai][bj][m][n] = __builtin_amdgcn_mfma_f32_16x16x32_bf16(Bt[n][k], At[m][k], acc[ai][bj][m][n], 0, 0, 0); __builtin_amdgcn_s_setprio(0); } while (0)
#define PG8_WAIT_V(n) asm volatile("s_waitcnt vmcnt(" #n ")" ::: "memory")
#define PG8_WAIT_L(n) asm volatile("s_waitcnt lgkmcnt(" #n ")" ::: "memory")
#define PG8_BAR __builtin_amdgcn_s_barrier()
#define PG8_SCHED __builtin_amdgcn_sched_barrier(0)
    Unit cur, nxt; int ui = 0;
    if (!S.next(0, cur)) return;
    f32x4 acc[2][2][4][2];
#pragma unroll
    for (int a = 0; a < 2; ++a)
#pragma unroll
        for (int b = 0; b < 2; ++b)
#pragma unroll
            for (int m = 0; m < 4; ++m)
#pragma unroll
                for (int n = 0; n < 2; ++n) acc[a][b][m][n] = (f32x4){0.f, 0.f, 0.f, 0.f};
    bf16x8 At[4][2], B0[2][2], B1[2][2];
    const char* cA = (const char*)g.A + (size_t)cur.pm * tstep; const char* cB = (const char*)g.Bt + (size_t)cur.pn * tstep;
    S.a_ready(cur);
    if constexpr (SP2) {
        PG8_STAGE(PG8_SB(0, 0), cB, voffB); PG8_STAGE(PG8_SB(0, 1), cB + hstep, voffB); PG8_STAGE(PG8_SA(0, 0), cA, voffA); PG8_STAGE(PG8_SA(0, 1), cA + hstep, voffA);
        if (wr == 1) PG8_BAR;
        PG8_WAIT_V(2); PG8_BAR;
        PG8_STAGE(PG8_SB(1, 0), cB + kstep, voffB); PG8_STAGE(PG8_SA(1, 0), cA + kstep, voffA); PG8_STAGE(PG8_SB(1, 1), cB + hstep + kstep, voffB);
        PG8_WAIT_V(6); PG8_BAR;
    } else {
        PG8_STAGE(PG8_SB(0, 0), cB, voffB); PG8_STAGE(PG8_SA(0, 0), cA, voffA); PG8_STAGE(PG8_SB(0, 1), cB + hstep, voffB); PG8_STAGE(PG8_SA(0, 1), cA + hstep, voffA);
        if (wr == 1) PG8_BAR;
        PG8_WAIT_V(4); PG8_BAR;
        PG8_STAGE(PG8_SB(1, 0), cB + kstep, voffB); PG8_STAGE(PG8_SA(1, 0), cA + kstep, voffA); PG8_STAGE(PG8_SB(1, 1), cB + hstep + kstep, voffB);
        PG8_WAIT_V(6); PG8_BAR;
    }
    for (;;) {
        const bool has_next = S.next(ui + 1, nxt);
        const char* nA = has_next ? (const char*)g.A + (size_t)nxt.pm * tstep : cA; const char* nB = has_next ? (const char*)g.Bt + (size_t)nxt.pn * tstep : cB;
        for (int t = 0; t < nt; t += 2) {
            const bool last = (t == nt - 2);
            const char* a1 = cA + (size_t)(t + 1) * kstep;
            const char* a2 = last ? nA : cA + (size_t)(t + 2) * kstep; const char* b2 = last ? nB : cB + (size_t)(t + 2) * kstep;
            const char* a3 = a2 + kstep; const char* b3 = b2 + kstep;
            if (last && has_next) S.a_ready(nxt);
            if constexpr (SP2) {
            PG8_LDB(B0, 0, 0); PG8_LDB(B1, 0, 1); PG8_SCHED; PG8_LDA(At, 0, 0); PG8_STAGE(PG8_SA(1, 1), a1 + hstep, voffA);
            PG8_WAIT_V(8); PG8_WAIT_L(0); PG8_BAR; PG8_MMA(0, 0, At, B0); PG8_MMA(0, 1, At, B1); PG8_BAR; PG8_SCHED;
            PG8_LDA(At, 0, 1); PG8_STAGE(PG8_SB(0, 0), b2, voffB); PG8_STAGE(PG8_SB(0, 1), b2 + hstep, voffB); PG8_STAGE(PG8_SA(0, 0), a2, voffA);
            PG8_WAIT_V(8); PG8_WAIT_L(0); PG8_BAR; PG8_MMA(1, 0, At, B0); PG8_MMA(1, 1, At, B1); PG8_BAR; PG8_SCHED;
            PG8_LDB(B0, 1, 0); PG8_LDB(B1, 1, 1); PG8_SCHED; PG8_LDA(At, 1, 0); PG8_STAGE(PG8_SA(0, 1), a2 + hstep, voffA);
            PG8_WAIT_V(8); PG8_WAIT_L(0); PG8_BAR; PG8_MMA(0, 0, At, B0); PG8_MMA(0, 1, At, B1); PG8_BAR; PG8_SCHED;
            PG8_LDA(At, 1, 1); PG8_STAGE(PG8_SB(1, 0), b3, voffB); PG8_STAGE(PG8_SB(1, 1), b3 + hstep, voffB); PG8_STAGE(PG8_SA(1, 0), a3, voffA);
            PG8_WAIT_V(8); PG8_WAIT_L(0); PG8_BAR; PG8_MMA(1, 0, At, B0); PG8_MMA(1, 1, At, B1); PG8_BAR; PG8_SCHED;
            } else {
            PG8_LDB(B0, 0, 0); PG8_SCHED; PG8_LDA(At, 0, 0); PG8_STAGE(PG8_SA(1, 1), a1 + hstep, voffA);
            PG8_WAIT_L(8); PG8_BAR; PG8_WAIT_L(0); PG8_MMA(0, 0, At, B0); PG8_BAR; PG8_SCHED;
            PG8_LDB(B1, 0, 1); PG8_STAGE(PG8_SB(0, 0), b2, voffB);
            PG8_BAR; PG8_WAIT_L(0); PG8_MMA(0, 1, At, B1); PG8_BAR;
            PG8_LDA(At, 0, 1); PG8_STAGE(PG8_SA(0, 0), a2, voffA);
            PG8_BAR; PG8_WAIT_L(0); PG8_MMA(1, 0, At, B0); PG8_BAR; PG8_SCHED;
            PG8_STAGE(PG8_SB(0, 1), b2 + hstep, voffB);
            PG8_WAIT_V(6); PG8_BAR; PG8_MMA(1, 1, At, B1); PG8_BAR;
            PG8_LDB(B0, 1, 0); PG8_SCHED; PG8_LDA(At, 1, 0); PG8_STAGE(PG8_SA(0, 1), a2 + hstep, voffA);
            PG8_WAIT_L(8); PG8_BAR; PG8_WAIT_L(0); PG8_MMA(0, 0, At, B0); PG8_BAR; PG8_SCHED;
            PG8_LDB(B1, 1, 1); PG8_STAGE(PG8_SB(1, 0), b3, voffB);
            PG8_BAR; PG8_WAIT_L(0); PG8_MMA(0, 1, At, B1); PG8_BAR;
            PG8_LDA(At, 1, 1); PG8_STAGE(PG8_SA(1, 0), a3, voffA);
            PG8_BAR; PG8_WAIT_L(0); PG8_MMA(1, 0, At, B0); PG8_BAR; PG8_SCHED;
            PG8_STAGE(PG8_SB(1, 1), b3 + hstep, voffB);
            PG8_WAIT_V(6); PG8_BAR; PG8_MMA(1, 1, At, B1); PG8_BAR;
            }
        }
        if constexpr (ALIGN_EPI) { if (wr == 0) PG8_BAR; }
        if constexpr (!Epi::AFTER_DRAIN) { E(acc, cur, wr, wc, fr, fq); S.done(cur); }
        if (!has_next) break;
#pragma unroll
        for (int a = 0; a < 2; ++a)
#pragma unroll
            for (int b = 0; b < 2; ++b)
#pragma unroll
                for (int m = 0; m < 4; ++m)
#pragma unroll
                    for (int n = 0; n < 2; ++n) acc[a][b][m][n] = (f32x4){0.f, 0.f, 0.f, 0.f};
        cur = nxt; cA = nA; cB = nB; ++ui;
        if constexpr (ALIGN_EPI) { if (wr == 1) PG8_BAR; }
    }
    PG8_WAIT_V(0);
    if constexpr (!ALIGN_EPI) { if (wr == 0) PG8_BAR; }
    PG8_BAR;
    if constexpr (Epi::AFTER_DRAIN) { E.fused(acc, cur, wr, wc, fr, fq, lds, wid, lane); S.done(cur); }
#undef PG8_SA
#undef PG8_SB
#undef PG8_STAGE
#undef PG8_LDA
#undef PG8_LDB
#undef PG8_MMA
#undef PG8_WAIT_V
#undef PG8_WAIT_L
#undef PG8_BAR
#undef PG8_SCHED
}
}

#define LAS __attribute__((address_space(3)))
typedef unsigned short bf16_t;
typedef short bf16x8 __attribute__((ext_vector_type(8)));
typedef float f32x4 __attribute__((ext_vector_type(4)));
typedef float f32x16 __attribute__((ext_vector_type(16)));
typedef unsigned u32x4 __attribute__((ext_vector_type(4)));
typedef unsigned u32x2 __attribute__((ext_vector_type(2)));
struct Args { const float* in[20]; float* out; unsigned char* ws; int st_lo, st_hi; };

struct Frame {
    LAS unsigned char* lds; int tid, lane, wave, G;
    const float* const* in; float* out; unsigned char* ws;
};
__device__ __forceinline__ float wave_sum(float v) {
#pragma unroll
    for (int o = 1; o < 64; o <<= 1) v += __shfl_xor(v, o);
    return v;
}
__device__ __forceinline__ unsigned pk2(float lo, float hi) { return pg8::cvt_pk_bf16(lo, hi); }
__device__ __forceinline__ float bflo(unsigned w) { return __uint_as_float(w << 16); }
__device__ __forceinline__ float bfhi(unsigned w) { return __uint_as_float(w & 0xffff0000u); }
__device__ __forceinline__ float bf2f(bf16_t b) { return __uint_as_float(((unsigned)b) << 16); }

__device__ __forceinline__ void tr_load(float (&v)[32], const float* W, int N, int k0, int n0, int lane, const float* gain) {
#pragma unroll
    for (int i = 0; i < 32; ++i) { const int kk = 2 * i + (lane >> 5); v[i] = W[(size_t)(k0 + kk) * N + n0 + (lane & 31)] * (gain ? gain[k0 + kk] : 1.f); }
}
__device__ __forceinline__ void tr_finish(const float (&v)[32], int K, bf16_t* dst_row0  , int k0, LAS float* scr, int lane) {
#pragma unroll
    for (int i = 0; i < 32; ++i) { const int kk = 2 * i + (lane >> 5); scr[kk * 33 + (lane & 31)] = v[i]; }
    asm volatile("s_waitcnt lgkmcnt(0)" ::: "memory");
    const int c = lane & 7;
#pragma unroll
    for (int j = 0; j < 4; ++j) { const int n = (lane >> 3) + 8 * j; const LAS float* s = scr + (8 * c) * 33 + n;
        u32x4 o; o.x = pk2(s[0 * 33], s[1 * 33]); o.y = pk2(s[2 * 33], s[3 * 33]); o.z = pk2(s[4 * 33], s[5 * 33]); o.w = pk2(s[6 * 33], s[7 * 33]);
        *(u32x4*)(dst_row0 + (size_t)n * K + k0 + 8 * c) = o; }
    asm volatile("s_waitcnt lgkmcnt(0)" ::: "memory");
}
__device__ __forceinline__ size_t wdst(int mat, int n0) {
    switch (mat) {
    case 0: {
        int r;
        if (n0 < 1024) r = n0;
        else if (n0 < 2048) { const int j = n0 - 1024; r = 1024 + (j >> 7) * 256 + (j & 127); }
        else if (n0 < 3072) { const int j = n0 - 2048; r = 1024 + (j >> 7) * 256 + 128 + (j & 127); }
        else if (n0 < 3744) r = 5120 + (n0 - 3072);
        else r = 3072 + (n0 - 3744);
        return W_IN + (size_t)r * D; }
    case 1: { const int g = n0 >> 5, h = g / 3, part = g % 3; const int r = part < 2 ? h * 64 + part * 32 : 1024 + h * 32; return W_UQ + (size_t)r * QL; }
    case 2: { const int h = n0 >> 7, e = n0 & 127; return e < 64 ? W_UK + (size_t)(h * 64 + e) * KVL : W_UV + (size_t)(h * 64 + e - 64) * KVL; }
    case 3: return W_CONV + (size_t)n0 * D;
    case 4: return W_ATTN + (size_t)n0 * D;
    case 5: return W_MERGE + (size_t)n0 * D;
    case 6: { int r; if (n0 < DFF) r = (n0 >> 7) * 256 + (n0 & 127); else { const int j = n0 - DFF; r = (j >> 7) * 256 + 128 + (j & 127); } return W_GU + (size_t)r * D; }
    default: return W_DOWN + (size_t)n0 * DFF;
    }
}
__device__ __forceinline__ void convert_weights(Frame& F, int l) {
    LAS float* scr = (LAS float*)(F.lds + F.wave * 16384);
    bf16_t* Wb = (bf16_t*)(F.ws + WS_W);
    const int gw = blockIdx.x * NWAVES + F.wave, NGW = F.G * NWAVES;
    constexpr int I0 = 16 * (DIN / 32), I1 = 6 * 48, I2 = 4 * 64, I3 = 16 * 32, I6 = 16 * (2 * DFF / 32), I7 = 44 * 32;
    constexpr int NIT = I0 + I1 + I2 + 3 * I3 + I6 + I7;
#define CW_DECODE(it_, K_, N_, src_, gain_, dst_, k0_, n0_) do { int r = (it_), mat; gain_ = nullptr; \
        if (r < I0) { mat = 0; K_ = D; N_ = DIN; src_ = F.in[5] + (size_t)l * D * DIN; gain_ = F.in[6] + l * D; } \
        else if ((r -= I0) < I1) { mat = 1; K_ = QL; N_ = 1536; src_ = F.in[10] + (size_t)l * QL * 1536; } \
        else if ((r -= I1) < I2) { mat = 2; K_ = KVL; N_ = 2048; src_ = F.in[11] + (size_t)l * KVL * 2048; } \
        else if ((r -= I2) < I3) { mat = 3; K_ = D; N_ = D; src_ = F.in[13] + (size_t)l * D * D; } \
        else if ((r -= I3) < I3) { mat = 4; K_ = D; N_ = D; src_ = F.in[14] + (size_t)l * D * D; } \
        else if ((r -= I3) < I3) { mat = 5; K_ = D; N_ = D; src_ = F.in[15] + (size_t)l * D * D; } \
        else if ((r -= I3) < I6) { mat = 6; K_ = D; N_ = 2 * DFF; src_ = F.in[18] + (size_t)l * D * 2 * DFF; gain_ = F.in[16] + l * D; } \
        else { r -= I6; mat = 7; K_ = DFF; N_ = D; src_ = F.in[19] + (size_t)l * DFF * D; } \
        const int nblk = N_ / 32, kb = r / nblk, nb = r % nblk; k0_ = kb * 64; n0_ = nb * 32; dst_ = Wb + wdst(mat, nb * 32); } while (0)
    {
        float va[32], vb[32];
        int it = gw, Ka = 0, Na = 0, k0a = 0, n0a = 0, Kb = 0, Nb = 0, k0b = 0, n0b = 0; const float* sa = nullptr; const float* ga = nullptr; bf16_t* da = nullptr; const float* sb = nullptr; const float* gb = nullptr; bf16_t* db = nullptr;
        if (it < NIT) { CW_DECODE(it, Ka, Na, sa, ga, da, k0a, n0a); tr_load(va, sa, Na, k0a, n0a, F.lane, ga); }
        while (it < NIT) {
            const int itb = it + NGW;
            if (itb < NIT) { CW_DECODE(itb, Kb, Nb, sb, gb, db, k0b, n0b); tr_load(vb, sb, Nb, k0b, n0b, F.lane, gb); }
            tr_finish(va, Ka, da, k0a, scr, F.lane);
            if (itb >= NIT) break;
            const int itc = itb + NGW;
            if (itc < NIT) { CW_DECODE(itc, Ka, Na, sa, ga, da, k0a, n0a); tr_load(va, sa, Na, k0a, n0a, F.lane, ga); }
            tr_finish(vb, Kb, db, k0b, scr, F.lane);
            it = itc;
        }
    }
#undef CW_DECODE
    for (int i = (blockIdx.x * 512 + F.tid); i < (DINP - DIN) * D / 8; i += F.G * 512) *(u32x4*)(Wb + W_IN + (size_t)DIN * D + (size_t)i * 8) = (u32x4){0u, 0u, 0u, 0u};
}
__device__ __forceinline__ void build_rope(Frame& F) {
    float* rope = (float*)(F.ws + WS_ROPE);
    for (int i = blockIdx.x * 512 + F.tid; i < SKEYS * 16; i += F.G * 512) {
        const int pos = i >> 4, f = i & 15;
        const int a = f & 3; const double q = a == 0 ? 1.0 : (a == 1 ? 0.5623413251903491 : (a == 2 ? 0.31622776601683794 : 0.1778279410038923));
        const int bq = f >> 2; const double p10 = bq == 0 ? 1.0 : (bq == 1 ? 0.1 : (bq == 2 ? 0.01 : 0.001));
        const double rev = (double)pos * (q * p10) * 0.15915494309189535;
        const float fr = (float)(rev - __builtin_rint(rev));
        rope[pos * 32 + f] = __builtin_amdgcn_cosf(fr); rope[pos * 32 + 16 + f] = __builtin_amdgcn_sinf(fr);
    }
}
__device__ __forceinline__ const float* xrow_in(Frame& F, int m) { return m < TP ? F.in[0] + (size_t)m * D : F.in[1] + (size_t)(m - TP) * D; }
__device__ __forceinline__ void store_norm_bf16(bf16_t* orow, const f32x4 (&v)[4], float rstd, const float* g, int lane) {
#pragma unroll
    for (int j = 0; j < 4; ++j) { const f32x4 gg = *(const f32x4*)(g + 4 * lane + 256 * j);
        u32x2 w; w.x = pk2(v[j][0] * rstd * gg[0], v[j][1] * rstd * gg[1]); w.y = pk2(v[j][2] * rstd * gg[2], v[j][3] * rstd * gg[3]);
        *(u32x2*)(orow + 4 * lane + 256 * j) = w; }
}
__device__ __forceinline__ float sumsq16(const f32x4 (&v)[4]) { float s = 0.f;
#pragma unroll
    for (int j = 0; j < 4; ++j) s += (v[j][0] * v[j][0] + v[j][1] * v[j][1]) + (v[j][2] * v[j][2] + v[j][3] * v[j][3]);
    return wave_sum(s); }
__device__ __forceinline__ void store_bf16_row(bf16_t* orow, const f32x4 (&v)[4], int lane) {
#pragma unroll
    for (int j = 0; j < 4; ++j) { u32x2 w; w.x = pk2(v[j][0], v[j][1]); w.y = pk2(v[j][2], v[j][3]); *(u32x2*)(orow + 4 * lane + 256 * j) = w; }
}
__device__ __forceinline__ void load_bf16_row(f32x4 (&v)[4], const bf16_t* irow, int lane) {
#pragma unroll
    for (int j = 0; j < 4; ++j) { const u32x2 w = *(const u32x2*)(irow + 4 * lane + 256 * j); v[j] = (f32x4){bflo(w.x), bfhi(w.x), bflo(w.y), bfhi(w.y)}; }
}
constexpr int RB = 4;
__device__ __forceinline__ void phase_norm_in(Frame& F) {
    bf16_t* XA = (bf16_t*)(F.out + O_Y); float* RSA = (float*)(F.ws + WS_RSA);
    const int gw = blockIdx.x * NWAVES + F.wave, NGW = F.G * NWAVES;
    for (int m0 = gw; m0 < T; m0 += RB * NGW) { f32x4 v[RB][4];
#pragma unroll
        for (int q = 0; q < RB; ++q) { const int m = m0 + q * NGW; if (m < T) { const float* xr = xrow_in(F, m);
#pragma unroll
            for (int j = 0; j < 4; ++j) v[q][j] = *(const f32x4*)(xr + 4 * F.lane + 256 * j); } }
#pragma unroll
        for (int q = 0; q < RB; ++q) { const int m = m0 + q * NGW; if (m < T) {
            const float rstd = rsqrtf(sumsq16(v[q]) * (1.f / D) + EPS);
            store_bf16_row(XA + (size_t)m * D, v[q], F.lane); if (F.lane == 0) RSA[m] = rstd; } } }
}
__device__ __forceinline__ void phase_h(Frame& F, int l) {
    const bf16_t* XA = (const bf16_t*)(F.out + O_Y); bf16_t* XB = (bf16_t*)(F.ws + WS_R2); float* RSB = (float*)(F.ws + WS_RSB);
    const bf16_t* Mo = (const bf16_t*)(F.ws + WS_R3 + U1);
    const float* gp = F.in[7] + l * D;
    f32x4 gg[4];
#pragma unroll
    for (int j = 0; j < 4; ++j) gg[j] = *(const f32x4*)(gp + 4 * F.lane + 256 * j);
    const int gw = blockIdx.x * NWAVES + F.wave, NGW = F.G * NWAVES;
    for (int m0 = gw; m0 < T; m0 += RB * NGW) { f32x4 x[RB][4], mm[RB][4];
#pragma unroll
        for (int q = 0; q < RB; ++q) { const int m = m0 + q * NGW; if (m < T) { load_bf16_row(x[q], XA + (size_t)m * D, F.lane); load_bf16_row(mm[q], Mo + (size_t)m * D, F.lane); } }
#pragma unroll
        for (int q = 0; q < RB; ++q) { const int m = m0 + q * NGW; if (m < T) {
            const float rm = rsqrtf(sumsq16(mm[q]) * (1.f / D) + EPS);
#pragma unroll
            for (int j = 0; j < 4; ++j) x[q][j] = x[q][j] + mm[q][j] * rm * gg[j];
            const float rstd = rsqrtf(sumsq16(x[q]) * (1.f / D) + EPS);
            store_bf16_row(XB + (size_t)m * D, x[q], F.lane); if (F.lane == 0) RSB[m] = rstd; } } }
}
__device__ __forceinline__ void phase_k(Frame& F, int l) {
    bf16_t* XA = (bf16_t*)(F.out + O_Y); const bf16_t* XB = (const bf16_t*)(F.ws + WS_R2); float* RSA = (float*)(F.ws + WS_RSA);
    const bf16_t* Fo = (const bf16_t*)(F.ws + WS_R1); float* Y = F.out + O_Y;
    const float* gp = F.in[17] + l * D;
    f32x4 gg[4];
#pragma unroll
    for (int j = 0; j < 4; ++j) gg[j] = *(const f32x4*)(gp + 4 * F.lane + 256 * j);
    const int gw = blockIdx.x * NWAVES + F.wave, NGW = F.G * NWAVES;
    for (int m0 = gw; m0 < T; m0 += RB * NGW) { f32x4 x[RB][4], mm[RB][4];
#pragma unroll
        for (int q = 0; q < RB; ++q) { const int m = m0 + q * NGW; if (m < T) { load_bf16_row(x[q], XB + (size_t)m * D, F.lane); load_bf16_row(mm[q], Fo + (size_t)m * D, F.lane); } }
#pragma unroll
        for (int q = 0; q < RB; ++q) { const int m = m0 + q * NGW; if (m < T) {
            const float rm = rsqrtf(sumsq16(mm[q]) * (1.f / D) + EPS);
#pragma unroll
            for (int j = 0; j < 4; ++j) x[q][j] = x[q][j] + mm[q][j] * rm * gg[j];
            if (l == 0) { const float rstd = rsqrtf(sumsq16(x[q]) * (1.f / D) + EPS); store_bf16_row(XA + (size_t)m * D, x[q], F.lane); if (F.lane == 0) RSA[m] = rstd; }
            else {
#pragma unroll
                for (int j = 0; j < 4; ++j) *(f32x4*)(Y + (size_t)m * D + 4 * F.lane + 256 * j) = x[q][j]; } } } }
}
__device__ __forceinline__ void ld16bf(float (&d)[16], const bf16_t* p) {
    const u32x4 a = *(const u32x4*)p, b = *(const u32x4*)(p + 8);
    d[0] = bflo(a.x); d[1] = bfhi(a.x); d[2] = bflo(a.y); d[3] = bfhi(a.y); d[4] = bflo(a.z); d[5] = bfhi(a.z); d[6] = bflo(a.w); d[7] = bfhi(a.w);
    d[8] = bflo(b.x); d[9] = bfhi(b.x); d[10] = bflo(b.y); d[11] = bfhi(b.y); d[12] = bflo(b.z); d[13] = bfhi(b.z); d[14] = bflo(b.w); d[15] = bfhi(b.w);
}
__device__ __forceinline__ void cvt16(float (&d)[16], const u32x4 a, const u32x4 b) {
    d[0] = bflo(a.x); d[1] = bfhi(a.x); d[2] = bflo(a.y); d[3] = bfhi(a.y); d[4] = bflo(a.z); d[5] = bfhi(a.z); d[6] = bflo(a.w); d[7] = bfhi(a.w);
    d[8] = bflo(b.x); d[9] = bfhi(b.x); d[10] = bflo(b.y); d[11] = bfhi(b.y); d[12] = bflo(b.z); d[13] = bfhi(b.z); d[14] = bflo(b.w); d[15] = bfhi(b.w);
}
__device__ __forceinline__ void ld16f(float (&d)[16], const float* p) {
#pragma unroll
    for (int j = 0; j < 4; ++j) { const f32x4 a = *(const f32x4*)(p + 4 * j); d[4 * j] = a[0]; d[4 * j + 1] = a[1]; d[4 * j + 2] = a[2]; d[4 * j + 3] = a[3]; }
}
__device__ __forceinline__ void phase_c(Frame& F, int l) {
    const bf16_t* Bg = (const bf16_t*)(F.ws + WS_BG); const bf16_t* U = (const bf16_t*)(F.ws + WS_U); const bf16_t* LAT = (const bf16_t*)(F.ws + WS_LAT);
    bf16_t* YAin = (bf16_t*)(F.ws + WS_R0); bf16_t* QLn = (bf16_t*)(F.ws + WS_QLN); bf16_t* Call = (bf16_t*)(F.ws + WS_CALL); bf16_t* KR = (bf16_t*)(F.ws + WS_KR);
    const float* rope = (const float*)(F.ws + WS_ROPE);
    const int lane = F.lane;
    { const float* cc = F.in[3] + (size_t)l * DB * PAST * KVL; const float* ck = F.in[4] + (size_t)l * DB * PAST * RP;
      for (int i = blockIdx.x * 512 + F.tid; i < DB * PAST * KVL / 8; i += F.G * 512) { const int e = i * 8, b = e / (PAST * KVL), r = e % (PAST * KVL);
          const f32x4 a = *(const f32x4*)(cc + e), c = *(const f32x4*)(cc + e + 4);
          *(u32x4*)(Call + (size_t)(TP + b * SKEYS) * KVL + r) = (u32x4){pk2(a[0], a[1]), pk2(a[2], a[3]), pk2(c[0], c[1]), pk2(c[2], c[3])}; }
      for (int i = blockIdx.x * 512 + F.tid; i < DB * PAST * RP / 8; i += F.G * 512) { const int e = i * 8, b = e / (PAST * RP), r = e % (PAST * RP);
          const f32x4 a = *(const f32x4*)(ck + e), c = *(const f32x4*)(ck + e + 4);
          *(u32x4*)(KR + (size_t)(TP + b * SKEYS) * RP + r) = (u32x4){pk2(a[0], a[1]), pk2(a[2], a[3]), pk2(c[0], c[1]), pk2(c[2], c[3])}; } }
    float cw0[16], cw1[16], cw2[16];
    ld16f(cw0, F.in[12] + (size_t)l * 3 * D + 16 * lane); ld16f(cw1, F.in[12] + (size_t)l * 3 * D + D + 16 * lane); ld16f(cw2, F.in[12] + (size_t)l * 3 * D + 2 * D + 16 * lane);
    float gq[8], gk[8];
#pragma unroll
    for (int i = 0; i < 8; ++i) { gq[i] = lane < 48 ? F.in[8][l * QL + 8 * lane + i] : 0.f; gk[i] = lane < 32 ? F.in[9][l * KVL + 8 * lane + i] : 0.f; }
    const int gw = blockIdx.x * NWAVES + F.wave, NGW = F.G * NWAVES;
    for (int run = gw; run < T / 8; run += NGW) {
        const int t0 = run * 8; const bool smp = t0 >= TP;
        const int b = smp ? (t0 - TP) / DSEQ : t0 / SEQ, s0 = smp ? (t0 - TP) % DSEQ : t0 % SEQ, slen = smp ? DSEQ : SEQ;
        float up1[16], up2[16];
        if (s0 == 0) {
            if (smp) { const float* hs = F.in[2] + ((size_t)(l * DB + b) * 2) * D + 16 * lane; ld16f(up2, hs); ld16f(up1, hs + D); }
            else {
#pragma unroll
                for (int i = 0; i < 16; ++i) { up1[i] = 0.f; up2[i] = 0.f; } }
        } else { ld16bf(up1, U + (size_t)(t0 - 1) * D + 16 * lane); ld16bf(up2, U + (size_t)(t0 - 2) * D + 16 * lane); }
#pragma unroll 1
        for (int i4 = 0; i4 < 8; i4 += 2) {
            u32x4 rU[2][2], rB[2][2], rQ[2], rC[2]; unsigned rR1[2], rR2[2];
#pragma unroll
            for (int q = 0; q < 2; ++q) { const int t = t0 + i4 + q; const bf16_t* lat = LAT + (size_t)t * LATP;
                rU[q][0] = *(const u32x4*)(U + (size_t)t * D + 16 * lane); rU[q][1] = *(const u32x4*)(U + (size_t)t * D + 16 * lane + 8);
                rB[q][0] = *(const u32x4*)(Bg + (size_t)t * D + 16 * lane); rB[q][1] = *(const u32x4*)(Bg + (size_t)t * D + 16 * lane + 8);
                rQ[q] = (u32x4){0u, 0u, 0u, 0u}; rC[q] = rQ[q]; rR1[q] = 0u; rR2[q] = 0u;
                if (lane < 48) rQ[q] = *(const u32x4*)(lat + 8 * lane);
                if (lane < 32) rC[q] = *(const u32x4*)(lat + QL + 8 * lane);
                if (lane < 16) { rR1[q] = lat[QL + KVL + lane]; rR2[q] = lat[QL + KVL + 16 + lane]; } }
#pragma unroll
            for (int q = 0; q < 2; ++q) {
            const int t = t0 + i4 + q, s = s0 + i4 + q;
            float uc[16], bg[16], y[16];
            cvt16(uc, rU[q][0], rU[q][1]); cvt16(bg, rB[q][0], rB[q][1]);
#pragma unroll
            for (int i = 0; i < 16; ++i) y[i] = bg[i] * (cw0[i] * up2[i] + cw1[i] * up1[i] + cw2[i] * uc[i]);
            *(u32x4*)(YAin + (size_t)t * D + 16 * lane) = (u32x4){pk2(y[0], y[1]), pk2(y[2], y[3]), pk2(y[4], y[5]), pk2(y[6], y[7])};
            *(u32x4*)(YAin + (size_t)t * D + 16 * lane + 8) = (u32x4){pk2(y[8], y[9]), pk2(y[10], y[11]), pk2(y[12], y[13]), pk2(y[14], y[15])};
            if (s >= slen - 2) {
                float* oc = smp ? F.out + O_CONV_S + ((size_t)(l * DB + b) * 2 + (s - (slen - 2))) * D : F.out + O_CONV_P + ((size_t)(l * NB + b) * 2 + (s - (slen - 2))) * D;
#pragma unroll
                for (int j = 0; j < 4; ++j) *(f32x4*)(oc + 16 * lane + 4 * j) = (f32x4){uc[4 * j], uc[4 * j + 1], uc[4 * j + 2], uc[4 * j + 3]};
            }
#pragma unroll
            for (int i = 0; i < 16; ++i) { up2[i] = up1[i]; up1[i] = uc[i]; }
            const size_t krow = smp ? (size_t)(TP + b * SKEYS + PAST + s) : (size_t)t;
            const int pos = smp ? PAST + s : s;
            { float v[8]; const u32x4 w = rQ[q];
              v[0] = bflo(w.x); v[1] = bfhi(w.x); v[2] = bflo(w.y); v[3] = bfhi(w.y); v[4] = bflo(w.z); v[5] = bfhi(w.z); v[6] = bflo(w.w); v[7] = bfhi(w.w);
              float ss = 0.f;
#pragma unroll
              for (int i = 0; i < 8; ++i) ss += v[i] * v[i];
              const float r = rsqrtf(wave_sum(ss) * (1.f / QL) + EPS);
              if (lane < 48) *(u32x4*)(QLn + (size_t)t * QL + 8 * lane) = (u32x4){pk2(v[0] * r * gq[0], v[1] * r * gq[1]), pk2(v[2] * r * gq[2], v[3] * r * gq[3]), pk2(v[4] * r * gq[4], v[5] * r * gq[5]), pk2(v[6] * r * gq[6], v[7] * r * gq[7])}; }
            { float v[8]; const u32x4 w = rC[q];
              v[0] = bflo(w.x); v[1] = bfhi(w.x); v[2] = bflo(w.y); v[3] = bfhi(w.y); v[4] = bflo(w.z); v[5] = bfhi(w.z); v[6] = bflo(w.w); v[7] = bfhi(w.w);
              float ss = 0.f;
#pragma unroll
              for (int i = 0; i < 8; ++i) ss += v[i] * v[i];
              const float r = rsqrtf(wave_sum(ss) * (1.f / KVL) + EPS);
              if (lane < 32) {
#pragma unroll
                  for (int i = 0; i < 8; ++i) v[i] = v[i] * r * gk[i];
                  float* oc = smp ? F.out + O_CKV_S + ((size_t)l * TS + (t - TP)) * KVL : F.out + O_CKV_P + ((size_t)l * TP + t) * KVL;
                  *(f32x4*)(oc + 8 * lane) = (f32x4){v[0], v[1], v[2], v[3]}; *(f32x4*)(oc + 8 * lane + 4) = (f32x4){v[4], v[5], v[6], v[7]};
                  *(u32x4*)(Call + krow * KVL + 8 * lane) = (u32x4){pk2(v[0], v[1]), pk2(v[2], v[3]), pk2(v[4], v[5]), pk2(v[6], v[7])}; } }
            if (lane < 16) { const float x1 = __uint_as_float(rR1[q] << 16), x2 = __uint_as_float(rR2[q] << 16); const float c = rope[pos * 32 + lane], sn = rope[pos * 32 + 16 + lane];
                const float o1 = x1 * c - x2 * sn, o2 = x1 * sn + x2 * c;
                float* ok = smp ? F.out + O_KR_S + ((size_t)l * TS + (t - TP)) * RP : F.out + O_KR_P + ((size_t)l * TP + t) * RP;
                ok[lane] = o1; ok[16 + lane] = o2;
                KR[krow * RP + lane] = (bf16_t)(pk2(o1, o1) & 0xffffu); KR[krow * RP + 16 + lane] = (bf16_t)(pk2(o2, o2) & 0xffffu); }
            }
        }
    }
}
namespace att {
constexpr int KP = 208, VP = 144, KB = 64 * KP, VB = 64 * VP, BUFB = KB + VB;
struct Ptrs { const bf16_t *Qn, *Qr, *Kn, *Vt, *KR; bf16_t* ATT; const float* rope; };
__device__ __forceinline__ float fmax3(float a, float b, float c) { return fmaxf(fmaxf(a, b), c); }
__device__ __forceinline__ void tile_core(const bf16x8 (&kf)[2][6], const bf16x8 (&vf)[2][4], const bf16x8 (&qf)[6], float& m, float& l, f32x16 (&o)[2], int nvalid, int hi) {
    f32x16 p0, p1;
#pragma unroll
    for (int r = 0; r < 16; ++r) { p0[r] = 0.f; p1[r] = 0.f; }
#pragma unroll
    for (int d0 = 0; d0 < 6; ++d0) { p0 = __builtin_amdgcn_mfma_f32_32x32x16_bf16(kf[0][d0], qf[d0], p0, 0, 0, 0); p1 = __builtin_amdgcn_mfma_f32_32x32x16_bf16(kf[1][d0], qf[d0], p1, 0, 0, 0); }
    if (nvalid < 64) {
#pragma unroll
        for (int r = 0; r < 16; ++r) { const int kv = (r & 3) + 8 * (r >> 2) + 4 * hi; if (kv >= nvalid) p0[r] = -1e30f; if (kv + 32 >= nvalid) p1[r] = -1e30f; }
    }
    float rm = fmax3(p0[0], p0[1], p1[0]);
#pragma unroll
    for (int r = 1; r < 16; ++r) rm = fmax3(rm, p0[r], p1[r]);
    rm = fmaxf(rm, __shfl_xor(rm, 32));
    if (__any(rm > m)) { const float mn = fmaxf(m, rm), f = __builtin_amdgcn_exp2f(m - mn); l *= f; m = mn;
#pragma unroll
        for (int r = 0; r < 16; ++r) { o[0][r] *= f; o[1][r] *= f; } }
    float s = 0.f;
#pragma unroll
    for (int r = 0; r < 16; ++r) { p0[r] = __builtin_amdgcn_exp2f(p0[r] - m); p1[r] = __builtin_amdgcn_exp2f(p1[r] - m); s += p0[r] + p1[r]; }
    l += s;
    bf16x8 pa[4];
    { u32x4 w;
      w = (u32x4){pk2(p0[0], p0[1]), pk2(p0[2], p0[3]), pk2(p0[4], p0[5]), pk2(p0[6], p0[7])}; pa[0] = __builtin_bit_cast(bf16x8, w);
      w = (u32x4){pk2(p0[8], p0[9]), pk2(p0[10], p0[11]), pk2(p0[12], p0[13]), pk2(p0[14], p0[15])}; pa[1] = __builtin_bit_cast(bf16x8, w);
      w = (u32x4){pk2(p1[0], p1[1]), pk2(p1[2], p1[3]), pk2(p1[4], p1[5]), pk2(p1[6], p1[7])}; pa[2] = __builtin_bit_cast(bf16x8, w);
      w = (u32x4){pk2(p1[8], p1[9]), pk2(p1[10], p1[11]), pk2(p1[12], p1[13]), pk2(p1[14], p1[15])}; pa[3] = __builtin_bit_cast(bf16x8, w); }
#pragma unroll
    for (int db = 0; db < 2; ++db)
#pragma unroll
        for (int s4 = 0; s4 < 4; ++s4) o[db] = __builtin_amdgcn_mfma_f32_32x32x16_bf16(vf[db][s4], pa[s4], o[db], 0, 0, 0);
}
__device__ __forceinline__ void load_q(bf16x8 (&qf)[6], const bf16_t* qn, const bf16_t* qr, const float* rp, int hi) {
#pragma unroll
    for (int d0 = 0; d0 < 4; ++d0) qf[d0] = *(const bf16x8*)(qn + d0 * 16 + hi * 8);
    const u32x4 a = *(const u32x4*)(qr + hi * 8), b = *(const u32x4*)(qr + 16 + hi * 8);
    const f32x4 c0 = *(const f32x4*)(rp + hi * 8), c1 = *(const f32x4*)(rp + hi * 8 + 4), s0 = *(const f32x4*)(rp + 16 + hi * 8), s1 = *(const f32x4*)(rp + 16 + hi * 8 + 4);
    const float x1[8] = {bflo(a.x), bfhi(a.x), bflo(a.y), bfhi(a.y), bflo(a.z), bfhi(a.z), bflo(a.w), bfhi(a.w)};
    const float x2[8] = {bflo(b.x), bfhi(b.x), bflo(b.y), bfhi(b.y), bflo(b.z), bfhi(b.z), bflo(b.w), bfhi(b.w)};
    const float cs[8] = {c0[0], c0[1], c0[2], c0[3], c1[0], c1[1], c1[2], c1[3]}, sn[8] = {s0[0], s0[1], s0[2], s0[3], s1[0], s1[1], s1[2], s1[3]};
    float o1[8], o2[8];
#pragma unroll
    for (int j = 0; j < 8; ++j) { o1[j] = x1[j] * cs[j] - x2[j] * sn[j]; o2[j] = x1[j] * sn[j] + x2[j] * cs[j]; }
    u32x4 w1 = (u32x4){pk2(o1[0], o1[1]), pk2(o1[2], o1[3]), pk2(o1[4], o1[5]), pk2(o1[6], o1[7])}, w2 = (u32x4){pk2(o2[0], o2[1]), pk2(o2[2], o2[3]), pk2(o2[4], o2[5]), pk2(o2[6], o2[7])};
    qf[4] = __builtin_bit_cast(bf16x8, w1); qf[5] = __builtin_bit_cast(bf16x8, w2);
}
__device__ __forceinline__ void prompt_unit(LAS unsigned char* lds, const Ptrs& P, int qloc0, int qglob0, int kloc0, int kglob0, int h, int qb) {
    int tid_ = threadIdx.x; asm volatile("" : "+v"(tid_));
    const int tid = tid_, lane = tid & 63, r32 = lane & 31, hi = lane >> 5; const int wid = __builtin_amdgcn_readfirstlane(tid >> 6);
    const int NTL = 4 * qb + 4, cq = 4 * qb + (wid >> 1);
    bf16x8 qf[6];
    { const int ql = qloc0 + 32 * wid + r32, pos = qb * 256 + 32 * wid + r32;
      load_q(qf, P.Qn + (size_t)ql * 1024 + h * 64, P.Qr + (size_t)ql * 512 + h * 32, P.rope + pos * 32, hi); }
    const bf16_t* kn_src = P.Kn + (size_t)(kloc0 + (tid >> 3)) * 1024 + h * 64 + (tid & 7) * 8;
    const bf16_t* vt_src = P.Vt + (size_t)(h * 64 + (tid >> 3)) * VT_LD + kloc0 + (tid & 7) * 8;
    const bf16_t* kr_src = P.KR + (size_t)(kglob0 + ((tid & 255) >> 2)) * 32 + (tid & 3) * 8;
    const int k_w = (tid >> 3) * KP + (tid & 7) * 16, r_w = ((tid & 255) >> 2) * KP + 128 + (tid & 3) * 16;
    const int v_w = KB + (tid >> 3) * VP + ((tid & 7) >> 1) * 32 + (tid & 1) * 8;
    u32x4 kreg, vreg, rreg = (u32x4){0u, 0u, 0u, 0u};
    kreg = *(const u32x4*)kn_src; vreg = *(const u32x4*)vt_src; if (tid < 256) rreg = *(const u32x4*)kr_src;
    *(LAS u32x4*)(lds + k_w) = kreg; if (tid < 256) *(LAS u32x4*)(lds + r_w) = rreg;
    *(LAS u32x2*)(lds + v_w) = (u32x2){vreg.x, vreg.y}; *(LAS u32x2*)(lds + v_w + 16) = (u32x2){vreg.z, vreg.w};
    __syncthreads();
    float m = -1e30f, l = 0.f; f32x16 o[2];
#pragma unroll
    for (int r = 0; r < 16; ++r) { o[0][r] = 0.f; o[1][r] = 0.f; }
    for (int j = 0; j < NTL; ++j) {
        const bool more = j + 1 < NTL;
        if (more) { kreg = *(const u32x4*)(kn_src + (size_t)(j + 1) * 64 * 1024); vreg = *(const u32x4*)(vt_src + (j + 1) * 64); if (tid < 256) rreg = *(const u32x4*)(kr_src + (size_t)(j + 1) * 64 * 32); }
        if (j <= cq) {
            const LAS unsigned char* buf = lds + (j & 1) * BUFB;
            bf16x8 kf[2][6], vf[2][4];
#pragma unroll
            for (int kb = 0; kb < 2; ++kb)
#pragma unroll
                for (int d0 = 0; d0 < 6; ++d0) kf[kb][d0] = *(const LAS bf16x8*)(buf + (kb * 32 + r32) * KP + d0 * 32 + hi * 16);
#pragma unroll
            for (int db = 0; db < 2; ++db)
#pragma unroll
                for (int s4 = 0; s4 < 4; ++s4) vf[db][s4] = *(const LAS bf16x8*)(buf + KB + (db * 32 + r32) * VP + s4 * 32 + hi * 16);
            tile_core(kf, vf, qf, m, l, o, 64, hi);
        }
        if (more) { LAS unsigned char* nb = lds + ((j + 1) & 1) * BUFB;
            *(LAS u32x4*)(nb + k_w) = kreg; if (tid < 256) *(LAS u32x4*)(nb + r_w) = rreg;
            *(LAS u32x2*)(nb + v_w) = (u32x2){vreg.x, vreg.y}; *(LAS u32x2*)(nb + v_w + 16) = (u32x2){vreg.z, vreg.w}; }
        __syncthreads();
    }
    l += __shfl_xor(l, 32);
    const float inv = 1.0f / l;
    bf16_t* orow = P.ATT + (size_t)(qglob0 + 32 * wid + r32) * 1024 + h * 64;
#pragma unroll
    for (int db = 0; db < 2; ++db)
#pragma unroll
        for (int g = 0; g < 4; ++g) { u32x2 w; w.x = pk2(o[db][4 * g] * inv, o[db][4 * g + 1] * inv); w.y = pk2(o[db][4 * g + 2] * inv, o[db][4 * g + 3] * inv);
            *(u32x2*)(orow + 32 * db + 8 * g + 4 * hi) = w; }
}
__device__ __forceinline__ void sample_unit(LAS unsigned char* lds, const Ptrs& P, int b, int h) {
    int tid_ = threadIdx.x; asm volatile("" : "+v"(tid_));
    const int tid = tid_, lane = tid & 63, r32 = lane & 31, hi = lane >> 5; const int wid = __builtin_amdgcn_readfirstlane(tid >> 6);
    const int qglob0 = TP + b * DSEQ, qloc0 = qglob0 - G0_ROWS, kglob0 = TP + b * SKEYS, kloc0 = kglob0 - G0_ROWS;
    bf16x8 qf[6];
    load_q(qf, P.Qn + (size_t)(qloc0 + r32) * 1024 + h * 64, P.Qr + (size_t)(qloc0 + r32) * 512 + h * 32, P.rope + (PAST + r32) * 32, hi);
    float m = -1e30f, l = 0.f; f32x16 o[2];
#pragma unroll
    for (int r = 0; r < 16; ++r) { o[0][r] = 0.f; o[1][r] = 0.f; }
    constexpr int NTS = (SKEYS + 63) / 64;
    for (int j = wid; j < NTS; j += NWAVES) {
        const int nvalid = (SKEYS - j * 64) < 64 ? (SKEYS - j * 64) : 64;
        bf16x8 kf[2][6], vf[2][4];
#pragma unroll
        for (int kb = 0; kb < 2; ++kb) { int key = j * 64 + kb * 32 + r32; key = key < SKEYS ? key : SKEYS - 1;
            const bf16_t* kn = P.Kn + (size_t)(kloc0 + key) * 1024 + h * 64 + hi * 8; const bf16_t* kr = P.KR + (size_t)(kglob0 + key) * 32 + hi * 8;
#pragma unroll
            for (int d0 = 0; d0 < 4; ++d0) kf[kb][d0] = *(const bf16x8*)(kn + d0 * 16);
            kf[kb][4] = *(const bf16x8*)(kr); kf[kb][5] = *(const bf16x8*)(kr + 16); }
#pragma unroll
        for (int db = 0; db < 2; ++db) { const bf16_t* vr = P.Vt + (size_t)(h * 64 + db * 32 + r32) * VT_LD + kloc0 + j * 64 + 4 * hi;
#pragma unroll
            for (int s4 = 0; s4 < 4; ++s4) { u32x2 a = (u32x2){0u, 0u}, c = (u32x2){0u, 0u};
                if (16 * s4 + 4 * hi < nvalid) a = *(const u32x2*)(vr + 16 * s4); if (16 * s4 + 8 + 4 * hi < nvalid) c = *(const u32x2*)(vr + 16 * s4 + 8);
                const u32x4 w = (u32x4){a.x, a.y, c.x, c.y}; vf[db][s4] = __builtin_bit_cast(bf16x8, w); } }
        tile_core(kf, vf, qf, m, l, o, nvalid, hi);
    }
    l += __shfl_xor(l, 32);
    LAS float* OL = (LAS float*)lds + wid * (32 * 68); LAS float* ML = (LAS float*)(lds + NWAVES * 32 * 68 * 4);
#pragma unroll
    for (int db = 0; db < 2; ++db)
#pragma unroll
        for (int g = 0; g < 4; ++g) *(LAS f32x4*)(OL + r32 * 68 + 32 * db + 8 * g + 4 * hi) = (f32x4){o[db][4 * g], o[db][4 * g + 1], o[db][4 * g + 2], o[db][4 * g + 3]};
    if (hi == 0) { ML[wid * 64 + r32] = m; ML[wid * 64 + 32 + r32] = l; }
    __syncthreads();
    { const int q = tid >> 4, d = (tid & 15) * 4; float M = -1e30f;
#pragma unroll
      for (int w = 0; w < NWAVES; ++w) M = fmaxf(M, ML[w * 64 + q]);
      float L = 0.f; f32x4 acc = (f32x4){0.f, 0.f, 0.f, 0.f};
#pragma unroll
      for (int w = 0; w < NWAVES; ++w) { const float f = __builtin_amdgcn_exp2f(ML[w * 64 + q] - M); L += f * ML[w * 64 + 32 + q]; acc = acc + *(const LAS f32x4*)((LAS float*)lds + w * (32 * 68) + q * 68 + d) * f; }
      const float inv = 1.0f / L; u32x2 wv; wv.x = pk2(acc[0] * inv, acc[1] * inv); wv.y = pk2(acc[2] * inv, acc[3] * inv);
      *(u32x2*)(P.ATT + (size_t)(qglob0 + q) * 1024 + h * 64 + d) = wv; }
    __syncthreads();
}
__device__ __forceinline__ void attn_phase(LAS unsigned char* lds, const Ptrs& P, int g, int G) {
    const int vb = (G % 8 == 0) ? (int)((blockIdx.x & 7) * (G >> 3) + (blockIdx.x >> 3)) : (int)blockIdx.x;
    for (int pi = vb; pi < 512; pi += G) { const int combo = pi >> 2, s = pi & 3, bl = combo >> 4, h = combo & 15;
        const int brow_glob = (g * 8 + bl) * SEQ, brow_loc = brow_glob - g * G0_ROWS;
#pragma unroll 1
        for (int hf = 0; hf < 2; ++hf) { const int qb = hf ? 7 - s : s; prompt_unit(lds, P, brow_loc + qb * 256, brow_glob + qb * 256, brow_loc, brow_glob, h, qb); } }
    if (g == 1) for (int ui = blockIdx.x; ui < DB * NH; ui += G) sample_unit(lds, P, ui >> 4, ui & 15);
}
}
#define XB_TMO      128
#define XB_XCNT(j)  (256  + 64 * (j))
#define XB_XSUB(j)  (1280 + 64 * (j))
#define XB_XGEN(j)  (2304 + 64 * (j))
#define XB_TOP      3328
#define XB_TOPGEN   3392
#define XCD_BAR_WORDS 3456
#define XB_SPIN_CAP (1u << 18)

__device__ __forceinline__ unsigned xb_ld(unsigned* p)              { return __hip_atomic_load(p, __ATOMIC_RELAXED, __HIP_MEMORY_SCOPE_AGENT); }
__device__ __forceinline__ unsigned xb_add(unsigned* p, unsigned v) { return __hip_atomic_fetch_add(p, v, __ATOMIC_RELAXED, __HIP_MEMORY_SCOPE_AGENT); }
__device__ __forceinline__ unsigned xb_xcc_id() { return (unsigned)__builtin_amdgcn_s_getreg((3 << 11) | 20) & 0xFu; }
#define XB_SPIN(cond, bar) do { unsigned _sp = 0; while (cond) { __builtin_amdgcn_s_sleep(1); \
    if ((++_sp & 255u) == 0u) { if (xb_ld(&(bar)[XB_TMO])) break; if (_sp > XB_SPIN_CAP) { atomicAdd(&(bar)[XB_TMO], 1u); break; } } } } while (0)

struct XcdBarrier {
    unsigned* bar; unsigned x;
    volatile __attribute__((address_space(3))) unsigned* st;
};

__device__ __forceinline__ XcdBarrier xcd_barrier_post(unsigned* bar, volatile __attribute__((address_space(3))) unsigned* st) {
    XcdBarrier b; b.bar = bar; b.x = xb_xcc_id(); b.st = st;
    if (threadIdx.x == 0) (void)xb_add(&bar[XB_XCNT(b.x)], 1u);
    return b;
}
__device__ __forceinline__ void xcd_barrier_complete(unsigned* bar, unsigned x, unsigned& nloc, unsigned& nx) {
    const unsigned G = gridDim.x * gridDim.y * gridDim.z;
    unsigned sum, cnt, mine, sp = 0u;
    for (;;) {
        sum = 0u; cnt = 0u; mine = 0u;
#pragma unroll
        for (unsigned j = 0; j < 16; ++j) { const unsigned c = xb_ld(&bar[XB_XCNT(j)]); sum += c; cnt += (c > 0u) ? 1u : 0u; mine = (j == x) ? c : mine; }
        if (sum == G) break;
        __builtin_amdgcn_s_sleep(1);
        if ((++sp & 255u) == 0u) { if (xb_ld(&bar[XB_TMO])) break; if (sp > XB_SPIN_CAP) { atomicAdd(&bar[XB_TMO], 1u); break; } }
    }
    nloc = mine > 0u ? mine : 1u; nx = cnt > 0u ? cnt : 1u;
}

__device__ __forceinline__ void xcd_barrier(const XcdBarrier& b) {
    asm volatile("s_waitcnt vmcnt(0)" ::: "memory");
    __syncthreads();
    if (threadIdx.x == 0) {
        unsigned* bar = b.bar;
        __builtin_amdgcn_s_waitcnt(0);
        unsigned nloc = b.st[0], nx = b.st[1];
        if (nloc == 0u) { xcd_barrier_complete(bar, b.x, nloc, nx); b.st[0] = nloc; b.st[1] = nx; }
        const unsigned old = xb_add(&bar[XB_XSUB(b.x)], 1u);
        const unsigned gen = old / nloc;
        if (old + 1u == (gen + 1u) * nloc) {
            __builtin_amdgcn_fence(__ATOMIC_RELEASE, "agent");
            asm volatile("s_waitcnt vmcnt(0)" ::: "memory");
            const unsigned og = xb_add(&bar[XB_TOP], 1u);
            const unsigned tg = og / nx;
            if (og + 1u == (tg + 1u) * nx) xb_add(&bar[XB_TOPGEN], 1u);
            else XB_SPIN(xb_ld(&bar[XB_TOPGEN]) == tg, bar);
            __builtin_amdgcn_fence(__ATOMIC_ACQUIRE, "agent");
            xb_add(&bar[XB_XGEN(b.x)], 1u);
            asm volatile("s_waitcnt vmcnt(0)" ::: "memory");
        } else {
            XB_SPIN(xb_ld(&bar[XB_XGEN(b.x)]) == gen, bar);
            __builtin_amdgcn_fence(__ATOMIC_ACQUIRE, "agent");
            asm volatile("s_waitcnt vmcnt(0)" ::: "memory");
        }
    }
    __syncthreads();
}

__device__ __forceinline__ void small_gemm(LAS unsigned char* lds, unsigned char* ws, size_t oA, size_t oB, int N_out, int K, int kind, size_t oO, int ldc, int G) {
    int tid_ = threadIdx.x; asm volatile("" : "+v"(tid_));
    const int tid = tid_, lane = tid & 63, r32 = lane & 31, hi = lane >> 5; const int kq = __builtin_amdgcn_readfirstlane(tid >> 6);
    const bool paired = kind == pg8::EK_SWIGLU;
    const int nitems = 8 * (N_out / 32);
    const bf16_t* A = (const bf16_t*)(ws + oA) + (size_t)TP * K; const bf16_t* Bt = (const bf16_t*)(ws + oB);
    const int kslice = K / 8, k0 = kq * kslice;
    LAS float* PA = (LAS float*)lds; LAS float* PB = (LAS float*)(lds + 32768);
    for (int it = blockIdx.x; it < nitems; it += G) {
        const int rb = it & 7, cg = it >> 3;
        int browa, ocol;
        if (paired) { const int tile = cg >> 2, q4 = cg & 3; browa = tile * 256 + q4 * 32; ocol = tile * 128 + q4 * 32; } else { browa = cg * 32; ocol = cg * 32; }
        const bf16_t* ap = A + (size_t)(rb * 32 + r32) * K + k0 + 8 * hi;
        const bf16_t* bp = Bt + (size_t)(browa + r32) * K + k0 + 8 * hi;
        f32x16 ca, cb;
#pragma unroll
        for (int r = 0; r < 16; ++r) { ca[r] = 0.f; cb[r] = 0.f; }
        if (paired) {
#pragma unroll 4
            for (int k = 0; k < kslice; k += 32) {
                const bf16x8 a0 = *(const bf16x8*)(ap + k), a1 = *(const bf16x8*)(ap + k + 16);
                const bf16x8 b0 = *(const bf16x8*)(bp + k), b1 = *(const bf16x8*)(bp + k + 16), c0 = *(const bf16x8*)(bp + (size_t)128 * K + k), c1 = *(const bf16x8*)(bp + (size_t)128 * K + k + 16);
                ca = __builtin_amdgcn_mfma_f32_32x32x16_bf16(a0, b0, ca, 0, 0, 0); ca = __builtin_amdgcn_mfma_f32_32x32x16_bf16(a1, b1, ca, 0, 0, 0);
                cb = __builtin_amdgcn_mfma_f32_32x32x16_bf16(a0, c0, cb, 0, 0, 0); cb = __builtin_amdgcn_mfma_f32_32x32x16_bf16(a1, c1, cb, 0, 0, 0);
            }
        } else {
#pragma unroll 4
            for (int k = 0; k < kslice; k += 32) {
                const bf16x8 a0 = *(const bf16x8*)(ap + k), a1 = *(const bf16x8*)(ap + k + 16);
                const bf16x8 b0 = *(const bf16x8*)(bp + k), b1 = *(const bf16x8*)(bp + k + 16);
                ca = __builtin_amdgcn_mfma_f32_32x32x16_bf16(a0, b0, ca, 0, 0, 0); ca = __builtin_amdgcn_mfma_f32_32x32x16_bf16(a1, b1, ca, 0, 0, 0);
            }
        }
#pragma unroll
        for (int r = 0; r < 16; ++r) { PA[(kq * 16 + r) * 64 + lane] = ca[r]; if (paired) PB[(kq * 16 + r) * 64 + lane] = cb[r]; }
        __syncthreads();
        if (tid < 128) { const int r = tid >> 3, h2 = (tid >> 2) & 1, g = tid & 3;
          f32x4 v0 = (f32x4){0.f, 0.f, 0.f, 0.f}, v1 = v0, w0 = v0, w1 = v0;
#pragma unroll
          for (int q = 0; q < 8; ++q) { const int o = (q * 16 + r) * 64 + h2 * 32 + 8 * g;
              v0 = v0 + *(const LAS f32x4*)(PA + o); v1 = v1 + *(const LAS f32x4*)(PA + o + 4);
              if (paired) { w0 = w0 + *(const LAS f32x4*)(PB + o); w1 = w1 + *(const LAS f32x4*)(PB + o + 4); } }
          const int orow = TP + rb * 32 + (r & 3) + 8 * (r >> 2) + 4 * h2, c = ocol + 8 * g;
          const size_t off = (size_t)orow * ldc + c; bf16_t* O = (bf16_t*)(ws + oO);
          if (kind == pg8::EK_SWIGLU) {
              { const float rr = ((const float*)(ws + WS_RSB))[orow]; v0 = v0 * rr; v1 = v1 * rr; w0 = w0 * rr; w1 = w1 * rr; }
#pragma unroll
              for (int i = 0; i < 4; ++i) { v0[i] = v0[i] * pg8::sigm(v0[i]) * w0[i]; v1[i] = v1[i] * pg8::sigm(v1[i]) * w1[i]; }
          } else if (kind == pg8::EK_GATE) { const u32x4 gg = *(const u32x4*)((const bf16_t*)(ws + WS_R1) + off);
              v0[0] *= bflo(gg.x); v0[1] *= bfhi(gg.x); v0[2] *= bflo(gg.y); v0[3] *= bfhi(gg.y); v1[0] *= bflo(gg.z); v1[1] *= bfhi(gg.z); v1[2] *= bflo(gg.w); v1[3] *= bfhi(gg.w);
          } else if (kind == pg8::EK_COMBINE) { const u32x4 y = *(const u32x4*)((const bf16_t*)(ws + WS_R1) + off); const u32x4 gg = *(const u32x4*)((const bf16_t*)(ws + WS_R2) + off);
              v0[0] = bflo(y.x) + bflo(gg.x) * v0[0]; v0[1] = bfhi(y.x) + bfhi(gg.x) * v0[1]; v0[2] = bflo(y.y) + bflo(gg.y) * v0[2]; v0[3] = bfhi(y.y) + bfhi(gg.y) * v0[3];
              v1[0] = bflo(y.z) + bflo(gg.z) * v1[0]; v1[1] = bfhi(y.z) + bfhi(gg.z) * v1[1]; v1[2] = bflo(y.w) + bflo(gg.w) * v1[2]; v1[3] = bfhi(y.w) + bfhi(gg.w) * v1[3]; }
          *(u32x4*)(O + off) = (u32x4){pk2(v0[0], v0[1]), pk2(v0[2], v0[3]), pk2(v1[0], v1[1]), pk2(v1[2], v1[3])}; }
        __syncthreads();
    }
}

constexpr int NSTEP = 18;
__host__ __device__ constexpr bool step_sync(int l, int s) { return !(s == 3 || s == 4 || s == 5 || s == 8 || s == 9 || (s == 0 && l != 0)); }
__device__ __forceinline__ void run_gemm(Frame& F, int s) {
    unsigned char* ws = F.ws;
    const int grp = (s >= 8) ? 1 : 0;
    size_t oA = WS_R0, oB = WS_W, oO = WS_R1;
    int M = T, N = D, K = D, kind = pg8::EK_PLAIN, ldc = 1024, rot = 0; float scale = 1.f;
    if (s == 1) { oB = WS_W + W_IN * 2; N = DINP; kind = pg8::EK_WIN; oO = WS_BG; }
    else if (s == 3) { oB = WS_W + W_CONV * 2; kind = pg8::EK_GATE; oO = WS_R1; }
    else if (s == 4 || s == 8) { oA = WS_QLN + (size_t)grp * G0_ROWS * QL * 2; oB = WS_W + W_UQ * 2; M = grp ? G1_ROWS : G0_ROWS; N = 1536; K = QL; kind = pg8::EK_Q; oO = WS_QN; scale = QSCALE; rot = grp ? 0 : 128; }
    else if (s == 5 || s == 9) { oA = WS_CALL + (size_t)grp * G0_ROWS * KVL * 2; oB = WS_W + W_UK * 2; M = grp ? G1_KEYS : G0_ROWS; N = 1024; K = KVL; oO = WS_KN; rot = grp ? 112 : 0; }
    else if (s == 6 || s == 10) { oA = WS_W + W_UV * 2; oB = WS_CALL + (size_t)grp * G0_ROWS * KVL * 2; M = 1024; N = grp ? G1_KEYS : G0_ROWS; K = KVL; oO = WS_VT; ldc = VT_LD; rot = grp ? 104 : 0; }
    else if (s == 12) { oB = WS_W + W_ATTN * 2; kind = pg8::EK_COMBINE; oO = WS_R3; }
    else if (s == 13) { oA = WS_R3; oB = WS_W + W_MERGE * 2; oO = WS_R3 + U1; }
    else if (s == 15) { oA = WS_R2; oB = WS_W + W_GU * 2; N = 2 * DFF; kind = pg8::EK_SWIGLU; oO = WS_R3; ldc = DFF; }
    else { oA = WS_R3; oB = WS_W + W_DOWN * 2; K = DFF; oO = WS_R1; }
    const bool split_sample = (s == 3 || s == 12 || s == 13 || s == 15 || s == 16);
    if (split_sample) M = TP;
    const pg8::bf16_t* Ap = (s == 1) ? (const pg8::bf16_t*)(F.out + O_Y) : (const pg8::bf16_t*)(ws + oA);
    const pg8::Gemm g{Ap, (const pg8::bf16_t*)(ws + oB), M, N, K};
    const pg8::EpiX E{kind, ws, oO, ldc, scale, (s == 15) ? WS_RSB : WS_RSA, (s == 1 || s == 15) ? 1 : 0};
    pg8::StaticOrder S; S.init(g.M, g.N, F.G, (int)((blockIdx.x + rot) % F.G));
    pg8::gemm_phase<pg8::EpiX, pg8::StaticOrder, true, true>(F.lds, g, S, E);
    if (split_sample) small_gemm(F.lds, ws, oA, oB, kind == pg8::EK_SWIGLU ? N / 2 : N, K, kind, oO, ldc, F.G);
}

__global__ void __launch_bounds__(NWAVES * 64, 2) fwd_mega(Args args) {
    extern __shared__ __attribute__((aligned(16))) unsigned char lds_raw[];
    cg::grid_group grid = cg::this_grid();
    Frame F;
    F.lds = (LAS unsigned char*)lds_raw; F.tid = threadIdx.x; F.lane = F.tid & 63; F.wave = __builtin_amdgcn_readfirstlane(F.tid >> 6); F.G = gridDim.x;
    F.in = args.in;
    F.out = args.out; F.ws = args.ws;
    volatile LAS unsigned* bst = (volatile LAS unsigned*)(F.lds + 131072);
    if (F.tid < 64) bst[F.tid] = 0u;
    __syncthreads();
    XcdBarrier bar = xcd_barrier_post((unsigned*)(args.ws) + 1024, bst + 8);
    for (int vst = args.st_lo * 2; vst < args.st_hi * 2; ++vst) {
        const int st = vst >> 1, rep = vst & 1;
        const int l = st / NSTEP, s = st % NSTEP;
        { int t_ = threadIdx.x; asm volatile("" : "+v"(t_)); F.tid = t_; F.lane = t_ & 63; F.wave = __builtin_amdgcn_readfirstlane(t_ >> 6); }
#ifndef PROBE_GEMM
#define PROBE_GEMM 0
#endif
#ifndef PROBE_ATT
#define PROBE_ATT 0
#endif
        const bool is_g = (s == 1 || s == 4 || s == 5 || s == 6 || s == 8 || s == 9 || s == 10 || s == 12 || s == 13 || s == 15 || s == 16);
        const int reps = ((PROBE_GEMM && is_g) || (PROBE_ATT && (s == 7 || s == 11))) ? 2 : 1;
        if (rep >= reps) continue;
        if (l == 0 && (s == 0 || s == 17)) convert_weights(F, s == 0 ? 0 : 1);
        if (s == 0) { if (l == 0) { build_rope(F); phase_norm_in(F); } }
        else if (s == 2) phase_c(F, l);
        else if (s == 7 || s == 11) {
            att::Ptrs P; P.Qn = (const bf16_t*)(F.ws + WS_QN); P.Qr = (const bf16_t*)(F.ws + WS_QR); P.Kn = (const bf16_t*)(F.ws + WS_KN); P.Vt = (const bf16_t*)(F.ws + WS_VT);
            P.KR = (const bf16_t*)(F.ws + WS_KR); P.ATT = (bf16_t*)(F.ws + WS_R0); P.rope = (const float*)(F.ws + WS_ROPE);
            att::attn_phase(F.lds, P, s == 7 ? 0 : 1, F.G);
        }
        else if (s == 14) phase_h(F, l);
        else if (s == 17) phase_k(F, l);
        else run_gemm(F, s);
        if (rep + 1 == reps && step_sync(l, s) && st + 1 < args.st_hi) { if (args.st_lo < 0) grid.sync(); else xcd_barrier(bar); }
    }
}

#ifndef MK_MULTI
#define MK_MULTI 0
#endif
extern "C" void kernel_launch(void* const* d_in, const int* in_sizes, int n_in, void* d_out, int out_size, void* d_ws, size_t ws_size, hipStream_t stream) {
    static int grid_blocks = 0;
    if (grid_blocks == 0) {
        if (n_in != 20 || out_size != (int)O_END || ws_size < WS_END) { fprintf(stderr, "kernel_launch: unexpected shapes n_in %d out %d ws %zu (need %zu)\n", n_in, out_size, ws_size, (size_t)WS_END); grid_blocks = -1; return; }
        int dev = 0, cus = 0, per_cu = 0;
        (void)hipGetDevice(&dev); (void)hipDeviceGetAttribute(&cus, hipDeviceAttributeMultiprocessorCount, dev);
        (void)hipFuncSetAttribute((const void*)fwd_mega, hipFuncAttributeMaxDynamicSharedMemorySize, LDS_BYTES);
        (void)hipOccupancyMaxActiveBlocksPerMultiprocessor(&per_cu, (const void*)fwd_mega, NWAVES * 64, LDS_BYTES);
        if (per_cu < 1) per_cu = 1;
        if (cus <= 0) cus = 256;
        grid_blocks = cus * per_cu;
    }
    if (grid_blocks < 0) return;
    Args a{};
    for (int i = 0; i < 20; ++i) a.in[i] = (const float*)d_in[i];
    a.out = (float*)d_out; a.ws = (unsigned char*)d_ws;
    (void)hipMemsetAsync(d_ws, 0, 65536, stream);
#if MK_MULTI
    int lo = 0;
    for (int st = 0; st < 2 * NSTEP; ++st) {
        if (step_sync(st / NSTEP, st % NSTEP) || st + 1 == 2 * NSTEP) { a.st_lo = lo; a.st_hi = st + 1; hipLaunchKernelGGL(fwd_mega, dim3(grid_blocks), dim3(NWAVES * 64), LDS_BYTES, stream, a); lo = st + 1; }
    }
#else
    a.st_lo = 0; a.st_hi = 2 * NSTEP;
    void* params[] = {&a};
    hipError_t e = hipLaunchCooperativeKernel((const void*)fwd_mega, dim3(grid_blocks), dim3(NWAVES * 64), params, LDS_BYTES, stream);
    if (e != hipSuccess) fprintf(stderr, "cooperative launch failed: %s (grid %d)\n", hipGetErrorString(e), grid_blocks);
#endif
}
```

```cpp
#include <hip/hip_runtime.h>
#include <hip/hip_cooperative_groups.h>
#include <cstdio>
#include <cstdint>
namespace cg = cooperative_groups;
constexpr int NWAVES = 8;
constexpr int D = 1024, TP = 32768, TS = 256, T = TP + TS, SEQ = 2048, NB = 16, DB = 8, DSEQ = 32, PAST = 2048, SKEYS = PAST + DSEQ, KT = TP + DB * SKEYS;
constexpr int DIN = 5792, DINP = 5888, QL = 384, KVL = 256, RP = 32, DFF = 2816, NH = 16, LATP = 768;
constexpr int G0_ROWS = 16384, G1_ROWS = T - G0_ROWS, G1_KEYS = KT - G0_ROWS, VT_LD = 33024;
constexpr float EPS = 1e-6f;
constexpr float QSCALE = 0.10206207261596577f * 1.4426950408889634f;
static_assert(T % 256 == 0 && G1_ROWS % 256 == 0 && G1_KEYS % 256 == 0 && KT % 256 == 0 && G1_KEYS == VT_LD, "tiles");
constexpr size_t O_Y = 0, O_CONV_P = (size_t)T * D, O_CKV_P = O_CONV_P + 2 * NB * 2 * D, O_KR_P = O_CKV_P + (size_t)2 * TP * KVL, O_CONV_S = O_KR_P + (size_t)2 * TP * RP,
                 O_CKV_S = O_CONV_S + 2 * DB * 2 * D, O_KR_S = O_CKV_S + (size_t)2 * TS * KVL, O_END = O_KR_S + (size_t)2 * TS * RP;
static_assert(O_END == 52936704, "d_out size");
constexpr size_t MiB = 1u << 20, U1 = (size_t)T * D * 2;
constexpr size_t WS_RSA = 256 * 1024, WS_RSB = 512 * 1024;
constexpr size_t WS_ROPE = 1 * MiB, WS_W = 2 * MiB, WS_R0 = 40 * MiB, WS_R1 = WS_R0 + U1, WS_R2 = WS_R1 + U1, WS_R3 = WS_R2 + U1, WS_R6 = WS_R3 + 178 * MiB;
constexpr size_t WS_QLN = WS_R6, WS_CALL = WS_QLN + (size_t)T * QL * 2, WS_KR = WS_CALL + (size_t)KT * KVL * 2, WS_END = WS_KR + (size_t)KT * RP * 2;
constexpr size_t W_IN = 0, W_UQ = W_IN + (size_t)DINP * D, W_UK = W_UQ + (size_t)1536 * QL, W_UV = W_UK + (size_t)1024 * KVL, W_CONV = W_UV + (size_t)1024 * KVL,
                 W_ATTN = W_CONV + (size_t)D * D, W_MERGE = W_ATTN + (size_t)D * D, W_GU = W_MERGE + (size_t)D * D, W_DOWN = W_GU + (size_t)2 * DFF * D, W_END = W_DOWN + (size_t)D * DFF;
static_assert(WS_W + W_END * 2 <= WS_R0, "weights fit");
constexpr size_t WS_BG = WS_R3, WS_U = WS_R3 + U1, WS_LAT = WS_R3 + 2 * U1;
constexpr size_t WS_QN = WS_R3, WS_QR = WS_QN + (size_t)G1_ROWS * 1024 * 2, WS_KN = WS_QR + (size_t)G1_ROWS * 512 * 2, WS_VT = WS_KN + (size_t)G1_KEYS * 1024 * 2, WS_GEND = WS_VT + (size_t)1024 * VT_LD * 2;
static_assert(WS_GEND <= WS_R6 && WS_LAT + (size_t)T * LATP * 2 <= WS_R6 && WS_R3 + (size_t)T * DFF * 2 <= WS_R6, "R3 region");
static_assert(WS_END <= 536870912, "d_ws budget (512 MiB)");
constexpr int LDS_BYTES = 131072 + 1024;


namespace pg8 {
#define PG8_LAS __attribute__((address_space(3)))
typedef unsigned short bf16_t;
typedef short bf16x8 __attribute__((ext_vector_type(8)));
typedef float f32x4 __attribute__((ext_vector_type(4)));
typedef unsigned u32x4 __attribute__((ext_vector_type(4)));
constexpr int BM = 256, BK = 64, HALF = 128, HTB = HALF * BK * 2  , STAGE_BYTES = 8 * HTB, NXCD = 8, WGM = 8;

__host__ __device__ __forceinline__ int lds_byte(int r, int c) { const int st = (r >> 4) * 2 + (c >> 5), rr = r & 15, cc = c & 31, ob = rr * 64 + cc * 2; return st * 1024 + (ob ^ (((ob >> 9) & 1) << 5)); }
__host__ __device__ __forceinline__ void stage_rc(int b, int& R, int& C) { const int st = b / 1024, sb = b % 1024, swz = sb ^ (((sb >> 9) & 1) << 5); R = (st >> 1) * 16 + swz / 64; C = (st & 1) * 32 + (swz % 64) / 2; }
__host__ __device__ __forceinline__ int perm32(int rho) { const int n = rho >> 4, i = rho & 15; return 8 * (i >> 2) + 4 * n + (i & 3); }

struct Unit { int pm, pn; };
struct Gemm { const bf16_t* A; const bf16_t* Bt; int M, N, K; };

struct StaticOrder {
    int nM, nN, nwg, G, c;
    __host__ __device__ void init(int M, int N, int G_, int c_) { nM = M / BM; nN = N / BM; nwg = nM * nN; G = G_; c = c_; }
    __host__ __device__ bool next(int i, Unit& u) const {
        const long L = (long)i * G + c; if (L >= nwg) return false;
        int wgid = (int)L; { const int q = nwg / NXCD, r = nwg % NXCD, xcd = wgid % NXCD, off = wgid / NXCD; wgid = (xcd < r ? xcd * (q + 1) : r * (q + 1) + (xcd - r) * q) + off; }
        const int nig = WGM * nN, gid = wgid / nig, fm = gid * WGM, gsz = (nM - fm) < WGM ? (nM - fm) : WGM;
        u.pm = fm + ((wgid % nig) % gsz); u.pn = (wgid % nig) / gsz; return true;
    }
    __device__ __forceinline__ void a_ready(const Unit&) const {}
    __device__ __forceinline__ void done(const Unit&) const {}
};

__device__ __forceinline__ unsigned cvt_pk_bf16(float lo, float hi) { unsigned r; asm volatile("v_cvt_pk_bf16_f32 %0, %1, %2" : "=v"(r) : "v"(lo), "v"(hi)); return r; }
typedef float f32x2 __attribute__((ext_vector_type(2)));
typedef unsigned u32x4e __attribute__((ext_vector_type(4)));
enum { EK_PLAIN = 0, EK_PAIRMUL = 1, EK_SWIGLU = 2, EK_SIGMOID = 3, EK_GATE = 4, EK_COMBINE = 5, EK_WIN = 6, EK_Q = 7 };
__device__ __forceinline__ float sigm(float x) { return __builtin_amdgcn_rcpf(1.0f + __builtin_amdgcn_exp2f(-1.4426950408889634f * x)); }
__device__ __forceinline__ float bflo(unsigned w) { return __uint_as_float(w << 16); }
__device__ __forceinline__ float bfhi(unsigned w) { return __uint_as_float(w & 0xffff0000u); }
struct EpiX {
    static constexpr bool PERM = true, AFTER_DRAIN = false;
    int kind; unsigned char* ws; size_t oO; int ldc; float scale; size_t oRS; int use_rs;
    __device__ __forceinline__ void operator()(const f32x4 (&acc)[2][2][4][2], const Unit& u, int wr, int wc, int fr, int fq) const {
        int k = kind; size_t ob = oO; int ld = ldc; int colt = u.pn * BM; const float sc = scale;
        if (k == EK_WIN) {
            const int pn = u.pn;
            if (pn < 4) { k = EK_PLAIN; }
            else if (pn < 12) { k = EK_PAIRMUL; ob = WS_U; colt = (pn - 4) * 128; }
            else if (pn < 16) { k = EK_SIGMOID; ob = WS_R1; colt = (pn - 12) * 256; }
            else if (pn < 20) { k = EK_SIGMOID; ob = WS_R2; colt = (pn - 16) * 256; }
            else { k = EK_PLAIN; ob = WS_LAT; colt = (pn - 20) * 256; ld = 768; }
        } else if (k == EK_Q) {
            k = EK_PLAIN; if (u.pn >= 4) { ob = WS_QR; colt = (u.pn - 4) * 256; ld = 512; }
        } else if (k == EK_PAIRMUL || k == EK_SWIGLU) colt = u.pn * 128;
        const int row0 = u.pm * BM + wr * 64 + fr;
        const int col0 = colt + wc * 32 + 8 * fq;
        bf16_t* base = (bf16_t*)(ws + ob); const bf16_t* aux1 = (const bf16_t*)(ws + WS_R1); const bf16_t* aux2 = (const bf16_t*)(ws + WS_R2);
        const float* rsp = (const float*)(ws + oRS);
        if (k == EK_PAIRMUL || k == EK_SWIGLU) {
#pragma unroll
            for (int ai = 0; ai < 2; ++ai)
#pragma unroll
                for (int m = 0; m < 4; ++m) {
                    bf16_t* rowp = base + (size_t)(row0 + ai * HALF + m * 16) * ld + col0;
                    const float rr = use_rs ? rsp[row0 + ai * HALF + m * 16] : 1.f;
                    f32x4 a0 = acc[ai][0][m][0] * rr, a1 = acc[ai][0][m][1] * rr; const f32x4 b0 = acc[ai][1][m][0] * rr, b1 = acc[ai][1][m][1] * rr;
                    if (k == EK_SWIGLU) {
#pragma unroll
                        for (int i = 0; i < 4; ++i) { a0[i] = a0[i] * sigm(a0[i]); a1[i] = a1[i] * sigm(a1[i]); }
                    }
                    const f32x4 v0 = a0 * b0, v1 = a1 * b1;
                    u32x4e w; w.x = cvt_pk_bf16(v0[0], v0[1]); w.y = cvt_pk_bf16(v0[2], v0[3]); w.z = cvt_pk_bf16(v1[0], v1[1]); w.w = cvt_pk_bf16(v1[2], v1[3]);
                    *(u32x4e*)rowp = w;
                }
        } else {
#pragma unroll
            for (int ai = 0; ai < 2; ++ai)
#pragma unroll
                for (int m = 0; m < 4; ++m) {
                    const size_t roff = (size_t)(row0 + ai * HALF + m * 16) * ld + col0;
                    const float rr = use_rs ? rsp[row0 + ai * HALF + m * 16] : 1.f;
#pragma unroll
                    for (int bj = 0; bj < 2; ++bj) {
                        f32x4 v0 = acc[ai][bj][m][0], v1 = acc[ai][bj][m][1];
                        const size_t off = roff + bj * HALF;
                        if (k == EK_PLAIN) { v0 = v0 * (sc * rr); v1 = v1 * (sc * rr); }
                        else if (k == EK_SIGMOID) {
#pragma unroll
                            for (int i = 0; i < 4; ++i) { v0[i] = sigm(v0[i] * rr); v1[i] = sigm(v1[i] * rr); }
                        } else if (k == EK_GATE) {
                            const u32x4e g = *(const u32x4e*)(aux1 + off);
                            v0[0] *= bflo(g.x); v0[1] *= bfhi(g.x); v0[2] *= bflo(g.y); v0[3] *= bfhi(g.y);
                            v1[0] *= bflo(g.z); v1[1] *= bfhi(g.z); v1[2] *= bflo(g.w); v1[3] *= bfhi(g.w);
                        } else {
                            const u32x4e y = *(const u32x4e*)(aux1 + off); const u32x4e g = *(const u32x4e*)(aux2 + off);
                            v0[0] = bflo(y.x) + bflo(g.x) * v0[0]; v0[1] = bfhi(y.x) + bfhi(g.x) * v0[1]; v0[2] = bflo(y.y) + bflo(g.y) * v0[2]; v0[3] = bfhi(y.y) + bfhi(g.y) * v0[3];
                            v1[0] = bflo(y.z) + bflo(g.z) * v1[0]; v1[1] = bfhi(y.z) + bfhi(g.z) * v1[1]; v1[2] = bflo(y.w) + bflo(g.w) * v1[2]; v1[3] = bfhi(y.w) + bfhi(g.w) * v1[3];
                        }
                        u32x4e w; w.x = cvt_pk_bf16(v0[0], v0[1]); w.y = cvt_pk_bf16(v0[2], v0[3]); w.z = cvt_pk_bf16(v1[0], v1[1]); w.w = cvt_pk_bf16(v1[2], v1[3]);
                        *(u32x4e*)(base + off) = w;
                    }
                }
        }
    }
};
template <class Epi, class Sched, bool ALIGN_EPI = false, bool SP2 = false>
__device__ __forceinline__ void gemm_phase(PG8_LAS unsigned char* lds, const Gemm g, const Sched& S, const Epi& E) {
    int tid_ = threadIdx.x; asm volatile("" : "+v"(tid_));
    const int tid = tid_, wid = __builtin_amdgcn_readfirstlane(tid >> 6), lane = tid & 63, wr = wid >> 2, wc = wid & 3, fr = lane & 15, fq = lane >> 4;
    const int K = g.K, nt = K / BK;
    unsigned voffA[2], voffB[2];
#pragma unroll
    for (int i = 0; i < 2; ++i) { int R, C; stage_rc(tid * 16 + i * 8192, R, C); const int Rb = Epi::PERM ? ((R & ~31) + perm32(R & 31)) : R;
        voffA[i] = (unsigned)(R * K + C) * 2u; voffB[i] = (unsigned)(Rb * K + C) * 2u; }
    const size_t kstep = (size_t)(BK * 2);
    const size_t hstep = (size_t)HALF * K * 2;
    const size_t tstep = 2 * hstep;
    const unsigned ldsw = (unsigned)wid * 1024u;
    const int aoff = lds_byte(wr * 64 + fr, fq * 8), boff = lds_byte(wc * 32 + fr, fq * 8);
#define PG8_SA(b, h) (((b) * 2 + (h)) * HTB)
#define PG8_SB(b, h) ((4 + (b) * 2 + (h)) * HTB)
#define PG8_STAGE(bufoff, gbase, voff) do { _Pragma("unroll") for (int _i = 0; _i < 2; ++_i) \
        __builtin_amdgcn_global_load_lds((const unsigned*)((const char*)(gbase) + (voff)[_i]), (PG8_LAS unsigned*)(lds + (bufoff) + ldsw + _i * 8192), 16, 0, 0); } while (0)
#define PG8_LDA(dst, b, h) do { _Pragma("unroll") for (int m = 0; m < 4; ++m) _Pragma("unroll") for (int k = 0; k < 2; ++k) dst[m][k] = *(const PG8_LAS bf16x8*)(lds + PG8_SA(b, h) + aoff + m * 2048 + k * 1024); } while (0)
#define PG8_LDB(dst, b, h) do { _Pragma("unroll") for (int n = 0; n < 2; ++n) _Pragma("unroll") for (int k = 0; k < 2; ++k) dst[n][k] = *(const PG8_LAS bf16x8*)(lds + PG8_SB(b, h) + boff + n * 2048 + k * 1024); } while (0)
#define PG8_MMA(ai, bj, At, Bt) do { __builtin_amdgcn_s_setprio(1); _Pragma("unroll") for (int m = 0; m < 4; ++m) _Pragma("unroll") for (int n = 0; n < 2; ++n) _Pragma("unroll") for (int k = 0; k < 2; ++k) \
        acc[ai][bj][m][n] = __builtin_amdgcn_mfma_f32_16x16x32_bf16(Bt[n][k], At[m][k], acc[ai][bj][m][n], 0, 0, 0); __builtin_amdgcn_s_setprio(0); } while (0)
#define PG8_WAIT_V(n) asm volatile("s_waitcnt vmcnt(" #n ")" ::: "memory")
#define PG8_WAIT_L(n) asm volatile("s_waitcnt lgkmcnt(" #n ")" ::: "memory")
#define PG8_BAR __builtin_amdgcn_s_barrier()
#define PG8_SCHED __builtin_amdgcn_sched_barrier(0)
    Unit cur, nxt; int ui = 0;
    if (!S.next(0, cur)) return;
    f32x4 acc[2][2][4][2];
#pragma unroll
    for (int a = 0; a < 2; ++a)
#pragma unroll
        for (int b = 0; b < 2; ++b)
#pragma unroll
            for (int m = 0; m < 4; ++m)
#pragma unroll
                for (int n = 0; n < 2; ++n) acc[a][b][m][n] = (f32x4){0.f, 0.f, 0.f, 0.f};
    bf16x8 At[4][2], B0[2][2], B1[2][2];
    const char* cA = (const char*)g.A + (size_t)cur.pm * tstep; const char* cB = (const char*)g.Bt + (size_t)cur.pn * tstep;
    S.a_ready(cur);
    if constexpr (SP2) {
        PG8_STAGE(PG8_SB(0, 0), cB, voffB); PG8_STAGE(PG8_SB(0, 1), cB + hstep, voffB); PG8_STAGE(PG8_SA(0, 0), cA, voffA); PG8_STAGE(PG8_SA(0, 1), cA + hstep, voffA);
        if (wr == 1) PG8_BAR;
        PG8_WAIT_V(2); PG8_BAR;
        PG8_STAGE(PG8_SB(1, 0), cB + kstep, voffB); PG8_STAGE(PG8_SA(1, 0), cA + kstep, voffA); PG8_STAGE(PG8_SB(1, 1), cB + hstep + kstep, voffB);
        PG8_WAIT_V(6); PG8_BAR;
    } else {
        PG8_STAGE(PG8_SB(0, 0), cB, voffB); PG8_STAGE(PG8_SA(0, 0), cA, voffA); PG8_STAGE(PG8_SB(0, 1), cB + hstep, voffB); PG8_STAGE(PG8_SA(0, 1), cA + hstep, voffA);
        if (wr == 1) PG8_BAR;
        PG8_WAIT_V(4); PG8_BAR;
        PG8_STAGE(PG8_SB(1, 0), cB + kstep, voffB); PG8_STAGE(PG8_SA(1, 0), cA + kstep, voffA); PG8_STAGE(PG8_SB(1, 1), cB + hstep + kstep, voffB);
        PG8_WAIT_V(6); PG8_BAR;
    }
    for (;;) {
        const bool has_next = S.next(ui + 1, nxt);
        const char* nA = has_next ? (const char*)g.A + (size_t)nxt.pm * tstep : cA; const char* nB = has_next ? (const char*)g.Bt + (size_t)nxt.pn * tstep : cB;
        for (int t = 0; t < nt; t += 2) {
            const bool last = (t == nt - 2);
            const char* a1 = cA + (size_t)(t + 1) * kstep;
            const char* a2 = last ? nA : cA + (size_t)(t + 2) * kstep; const char* b2 = last ? nB : cB + (size_t)(t + 2) * kstep;
            const char* a3 = a2 + kstep; const char* b3 = b2 + kstep;
            if (last && has_next) S.a_ready(nxt);
            if constexpr (SP2) {
            PG8_LDB(B0, 0, 0); PG8_LDB(B1, 0, 1); PG8_SCHED; PG8_LDA(At, 0, 0); PG8_STAGE(PG8_SA(1, 1), a1 + hstep, voffA);
            PG8_WAIT_V(8); PG8_WAIT_L(0); PG8_BAR; PG8_MMA(0, 0, At, B0); PG8_MMA(0, 1, At, B1); PG8_BAR; PG8_SCHED;
            PG8_LDA(At, 0, 1); PG8_STAGE(PG8_SB(0, 0), b2, voffB); PG8_STAGE(PG8_SB(0, 1), b2 + hstep, voffB); PG8_STAGE(PG8_SA(0, 0), a2, voffA);
            PG8_WAIT_V(8); PG8_WAIT_L(0); PG8_BAR; PG8_MMA(1, 0, At, B0); PG8_MMA(1, 1, At, B1); PG8_BAR; PG8_SCHED;
            PG8_LDB(B0, 1, 0); PG8_LDB(B1, 1, 1); PG8_SCHED; PG8_LDA(At, 1, 0); PG8_STAGE(PG8_SA(0, 1), a2 + hstep, voffA);
            PG8_WAIT_V(8); PG8_WAIT_L(0); PG8_BAR; PG8_MMA(0, 0, At, B0); PG8_MMA(0, 1, At, B1); PG8_BAR; PG8_SCHED;
            PG8_LDA(At, 1, 1); PG8_STAGE(PG8_SB(1, 0), b3, voffB); PG8_STAGE(PG8_SB(1, 1), b3 + hstep, voffB); PG8_STAGE(PG8_SA(1, 0), a3, voffA);
            PG8_WAIT_V(8); PG8_WAIT_L(0); PG8_BAR; PG8_MMA(1, 0, At, B0); PG8_MMA(1, 1, At, B1); PG8_BAR; PG8_SCHED;
            } else {
            PG8_LDB(B0, 0, 0); PG8_SCHED; PG8_LDA(At, 0, 0); PG8_STAGE(PG8_SA(1, 1), a1 + hstep, voffA);
            PG8_WAIT_L(8); PG8_BAR; PG8_WAIT_L(0); PG8_MMA(0, 0, At, B0); PG8_BAR; PG8_SCHED;
            PG8_LDB(B1, 0, 1); PG8_STAGE(PG8_SB(0, 0), b2, voffB);
            PG8_BAR; PG8_WAIT_L(0); PG8_MMA(0, 1, At, B1); PG8_BAR;
            PG8_LDA(At, 0, 1); PG8_STAGE(PG8_SA(0, 0), a2, voffA);
            PG8_BAR; PG8_WAIT_L(0); PG8_MMA(1, 0, At, B0); PG8_BAR; PG8_SCHED;
            PG8_STAGE(PG8_SB(0, 1), b2 + hstep, voffB);
            PG8_WAIT_V(6); PG8_BAR; PG8_MMA(1, 1, At, B1); PG8_BAR;
            PG8_LDB(B0, 1, 0); PG8_SCHED; PG8_LDA(At, 1, 0); PG8_STAGE(PG8_SA(0, 1), a2 + hstep, voffA);
            PG8_WAIT_L(8); PG8_BAR; PG8_WAIT_L(0); PG8_MMA(0, 0, At, B0); PG8_BAR; PG8_SCHED;
            PG8_LDB(B1, 1, 1); PG8_STAGE(PG8_SB(1, 0), b3, voffB);
            PG8_BAR; PG8_WAIT_L(0); PG8_MMA(0, 1, At, B1); PG8_BAR;
            PG8_LDA(At, 1, 1); PG8_STAGE(PG8_SA(1, 0), a3, voffA);
            PG8_BAR; PG8_WAIT_L(0); PG8_MMA(1, 0, At, B0); PG8_BAR; PG8_SCHED;
            PG8_STAGE(PG8_SB(1, 1), b3 + hstep, voffB);
            PG8_WAIT_V(6); PG8_BAR; PG8_MMA(1, 1, At, B1); PG8_BAR;
            }
        }
        if constexpr (ALIGN_EPI) { if (wr == 0) PG8_BAR; }
        if constexpr (!Epi::AFTER_DRAIN) { E(acc, cur, wr, wc, fr, fq); S.done(cur); }
        if (!has_next) break;
#pragma unroll
        for (int a = 0; a < 2; ++a)
#pragma unroll
            for (int b = 0; b < 2; ++b)
#pragma unroll
                for (int m = 0; m < 4; ++m)
#pragma unroll
                    for (int n = 0; n < 2; ++n) acc[a][b][m][n] = (f32x4){0.f, 0.f, 0.f, 0.f};
        cur = nxt; cA = nA; cB = nB; ++ui;
        if constexpr (ALIGN_EPI) { if (wr == 1) PG8_BAR; }
    }
    PG8_WAIT_V(0);
    if constexpr (!ALIGN_EPI) { if (wr == 0) PG8_BAR; }
    PG8_BAR;
    if constexpr (Epi::AFTER_DRAIN) { E.fused(acc, cur, wr, wc, fr, fq, lds, wid, lane); S.done(cur); }
#undef PG8_SA
#undef PG8_SB
#undef PG8_STAGE
#undef PG8_LDA
#undef PG8_LDB
#undef PG8_MMA
#undef PG8_WAIT_V
#undef PG8_WAIT_L
#undef PG8_BAR
#undef PG8_SCHED
}
}

#define LAS __attribute__((address_space(3)))
typedef unsigned short bf16_t;
typedef short bf16x8 __attribute__((ext_vector_type(8)));
typedef float f32x4 __attribute__((ext_vector_type(4)));
typedef float f32x16 __attribute__((ext_vector_type(16)));
typedef unsigned u32x4 __attribute__((ext_vector_type(4)));
typedef unsigned u32x2 __attribute__((ext_vector_type(2)));
struct Args { const float* in[20]; float* out; unsigned char* ws; int st_lo, st_hi; };

struct Frame {
    LAS unsigned char* lds; int tid, lane, wave, G;
    const float* const* in; float* out; unsigned char* ws;
};
__device__ __forceinline__ float wave_sum(float v) {
#pragma unroll
    for (int o = 1; o < 64; o <<= 1) v += __shfl_xor(v, o);
    return v;
}
__device__ __forceinline__ unsigned pk2(float lo, float hi) { return pg8::cvt_pk_bf16(lo, hi); }
__device__ __forceinline__ float bflo(unsigned w) { return __uint_as_float(w << 16); }
__device__ __forceinline__ float bfhi(unsigned w) { return __uint_as_float(w & 0xffff0000u); }
__device__ __forceinline__ float bf2f(bf16_t b) { return __uint_as_float(((unsigned)b) << 16); }

__device__ __forceinline__ void tr_load(float (&v)[32], const float* W, int N, int k0, int n0, int lane, const float* gain) {
#pragma unroll
    for (int i = 0; i < 32; ++i) { const int kk = 2 * i + (lane >> 5); v[i] = W[(size_t)(k0 + kk) * N + n0 + (lane & 31)] * (gain ? gain[k0 + kk] : 1.f); }
}
__device__ __forceinline__ void tr_finish(const float (&v)[32], int K, bf16_t* dst_row0  , int k0, LAS float* scr, int lane) {
#pragma unroll
    for (int i = 0; i < 32; ++i) { const int kk = 2 * i + (lane >> 5); scr[kk * 33 + (lane & 31)] = v[i]; }
    asm volatile("s_waitcnt lgkmcnt(0)" ::: "memory");
    const int c = lane & 7;
#pragma unroll
    for (int j = 0; j < 4; ++j) { const int n = (lane >> 3) + 8 * j; const LAS float* s = scr + (8 * c) * 33 + n;
        u32x4 o; o.x = pk2(s[0 * 33], s[1 * 33]); o.y = pk2(s[2 * 33], s[3 * 33]); o.z = pk2(s[4 * 33], s[5 * 33]); o.w = pk2(s[6 * 33], s[7 * 33]);
        *(u32x4*)(dst_row0 + (size_t)n * K + k0 + 8 * c) = o; }
    asm volatile("s_waitcnt lgkmcnt(0)" ::: "memory");
}
__device__ __forceinline__ size_t wdst(int mat, int n0) {
    switch (mat) {
    case 0: {
        int r;
        if (n0 < 1024) r = n0;
        else if (n0 < 2048) { const int j = n0 - 1024; r = 1024 + (j >> 7) * 256 + (j & 127); }
        else if (n0 < 3072) { const int j = n0 - 2048; r = 1024 + (j >> 7) * 256 + 128 + (j & 127); }
        else if (n0 < 3744) r = 5120 + (n0 - 3072);
        else r = 3072 + (n0 - 3744);
        return W_IN + (size_t)r * D; }
    case 1: { const int g = n0 >> 5, h = g / 3, part = g % 3; const int r = part < 2 ? h * 64 + part * 32 : 1024 + h * 32; return W_UQ + (size_t)r * QL; }
    case 2: { const int h = n0 >> 7, e = n0 & 127; return e < 64 ? W_UK + (size_t)(h * 64 + e) * KVL : W_UV + (size_t)(h * 64 + e - 64) * KVL; }
    case 3: return W_CONV + (size_t)n0 * D;
    case 4: return W_ATTN + (size_t)n0 * D;
    case 5: return W_MERGE + (size_t)n0 * D;
    case 6: { int r; if (n0 < DFF) r = (n0 >> 7) * 256 + (n0 & 127); else { const int j = n0 - DFF; r = (j >> 7) * 256 + 128 + (j & 127); } return W_GU + (size_t)r * D; }
    default: return W_DOWN + (size_t)n0 * DFF;
    }
}
__device__ __forceinline__ void convert_weights(Frame& F, int l) {
    LAS float* scr = (LAS float*)(F.lds + F.wave * 16384);
    bf16_t* Wb = (bf16_t*)(F.ws + WS_W);
    const int gw = blockIdx.x * NWAVES + F.wave, NGW = F.G * NWAVES;
    constexpr int I0 = 16 * (DIN / 32), I1 = 6 * 48, I2 = 4 * 64, I3 = 16 * 32, I6 = 16 * (2 * DFF / 32), I7 = 44 * 32;
    constexpr int NIT = I0 + I1 + I2 + 3 * I3 + I6 + I7;
#define CW_DECODE(it_, K_, N_, src_, gain_, dst_, k0_, n0_) do { int r = (it_), mat; gain_ = nullptr; \
        if (r < I0) { mat = 0; K_ = D; N_ = DIN; src_ = F.in[5] + (size_t)l * D * DIN; gain_ = F.in[6] + l * D; } \
        else if ((r -= I0) < I1) { mat = 1; K_ = QL; N_ = 1536; src_ = F.in[10] + (size_t)l * QL * 1536; } \
        else if ((r -= I1) < I2) { mat = 2; K_ = KVL; N_ = 2048; src_ = F.in[11] + (size_t)l * KVL * 2048; } \
        else if ((r -= I2) < I3) { mat = 3; K_ = D; N_ = D; src_ = F.in[13] + (size_t)l * D * D; } \
        else if ((r -= I3) < I3) { mat = 4; K_ = D; N_ = D; src_ = F.in[14] + (size_t)l * D * D; } \
        else if ((r -= I3) < I3) { mat = 5; K_ = D; N_ = D; src_ = F.in[15] + (size_t)l * D * D; } \
        else if ((r -= I3) < I6) { mat = 6; K_ = D; N_ = 2 * DFF; src_ = F.in[18] + (size_t)l * D * 2 * DFF; gain_ = F.in[16] + l * D; } \
        else { r -= I6; mat = 7; K_ = DFF; N_ = D; src_ = F.in[19] + (size_t)l * DFF * D; } \
        const int nblk = N_ / 32, kb = r / nblk, nb = r % nblk; k0_ = kb * 64; n0_ = nb * 32; dst_ = Wb + wdst(mat, nb * 32); } while (0)
    {
        float va[32], vb[32];
        int it = gw, Ka = 0, Na = 0, k0a = 0, n0a = 0, Kb = 0, Nb = 0, k0b = 0, n0b = 0; const float* sa = nullptr; const float* ga = nullptr; bf16_t* da = nullptr; const float* sb = nullptr; const float* gb = nullptr; bf16_t* db = nullptr;
        if (it < NIT) { CW_DECODE(it, Ka, Na, sa, ga, da, k0a, n0a); tr_load(va, sa, Na, k0a, n0a, F.lane, ga); }
        while (it < NIT) {
            const int itb = it + NGW;
            if (itb < NIT) { CW_DECODE(itb, Kb, Nb, sb, gb, db, k0b, n0b); tr_load(vb, sb, Nb, k0b, n0b, F.lane, gb); }
            tr_finish(va, Ka, da, k0a, scr, F.lane);
            if (itb >= NIT) break;
            const int itc = itb + NGW;
            if (itc < NIT) { CW_DECODE(itc, Ka, Na, sa, ga, da, k0a, n0a); tr_load(va, sa, Na, k0a, n0a, F.lane, ga); }
            tr_finish(vb, Kb, db, k0b, scr, F.lane);
            it = itc;
        }
    }
#undef CW_DECODE
    for (int i = (blockIdx.x * 512 + F.tid); i < (DINP - DIN) * D / 8; i += F.G * 512) *(u32x4*)(Wb + W_IN + (size_t)DIN * D + (size_t)i * 8) = (u32x4){0u, 0u, 0u, 0u};
}
__device__ __forceinline__ void build_rope(Frame& F) {
    float* rope = (float*)(F.ws + WS_ROPE);
    for (int i = blockIdx.x * 512 + F.tid; i < SKEYS * 16; i += F.G * 512) {
        const int pos = i >> 4, f = i & 15;
        const int a = f & 3; const double q = a == 0 ? 1.0 : (a == 1 ? 0.5623413251903491 : (a == 2 ? 0.31622776601683794 : 0.1778279410038923));
        const int bq = f >> 2; const double p10 = bq == 0 ? 1.0 : (bq == 1 ? 0.1 : (bq == 2 ? 0.01 : 0.001));
        const double rev = (double)pos * (q * p10) * 0.15915494309189535;
        const float fr = (float)(rev - __builtin_rint(rev));
        rope[pos * 32 + f] = __builtin_amdgcn_cosf(fr); rope[pos * 32 + 16 + f] = __builtin_amdgcn_sinf(fr);
    }
}
__device__ __forceinline__ const float* xrow_in(Frame& F, int m) { return m < TP ? F.in[0] + (size_t)m * D : F.in[1] + (size_t)(m - TP) * D; }
__device__ __forceinline__ void store_norm_bf16(bf16_t* orow, const f32x4 (&v)[4], float rstd, const float* g, int lane) {
#pragma unroll
    for (int j = 0; j < 4; ++j) { const f32x4 gg = *(const f32x4*)(g + 4 * lane + 256 * j);
        u32x2 w; w.x = pk2(v[j][0] * rstd * gg[0], v[j][1] * rstd * gg[1]); w.y = pk2(v[j][2] * rstd * gg[2], v[j][3] * rstd * gg[3]);
        *(u32x2*)(orow + 4 * lane + 256 * j) = w; }
}
__device__ __forceinline__ float sumsq16(const f32x4 (&v)[4]) { float s = 0.f;
#pragma unroll
    for (int j = 0; j < 4; ++j) s += (v[j][0] * v[j][0] + v[j][1] * v[j][1]) + (v[j][2] * v[j][2] + v[j][3] * v[j][3]);
    return wave_sum(s); }
__device__ __forceinline__ void store_bf16_row(bf16_t* orow, const f32x4 (&v)[4], int lane) {
#pragma unroll
    for (int j = 0; j < 4; ++j) { u32x2 w; w.x = pk2(v[j][0], v[j][1]); w.y = pk2(v[j][2], v[j][3]); *(u32x2*)(orow + 4 * lane + 256 * j) = w; }
}
__device__ __forceinline__ void load_bf16_row(f32x4 (&v)[4], const bf16_t* irow, int lane) {
#pragma unroll
    for (int j = 0; j < 4; ++j) { const u32x2 w = *(const u32x2*)(irow + 4 * lane + 256 * j); v[j] = (f32x4){bflo(w.x), bfhi(w.x), bflo(w.y), bfhi(w.y)}; }
}
constexpr int RB = 4;
__device__ __forceinline__ void phase_norm_in(Frame& F) {
    bf16_t* XA = (bf16_t*)(F.out + O_Y); float* RSA = (float*)(F.ws + WS_RSA);
    const int gw = blockIdx.x * NWAVES + F.wave, NGW = F.G * NWAVES;
    for (int m0 = gw; m0 < T; m0 += RB * NGW) { f32x4 v[RB][4];
#pragma unroll
        for (int q = 0; q < RB; ++q) { const int m = m0 + q * NGW; if (m < T) { const float* xr = xrow_in(F, m);
#pragma unroll
            for (int j = 0; j < 4; ++j) v[q][j] = *(const f32x4*)(xr + 4 * F.lane + 256 * j); } }
#pragma unroll
        for (int q = 0; q < RB; ++q) { const int m = m0 + q * NGW; if (m < T) {
            const float rstd = rsqrtf(sumsq16(v[q]) * (1.f / D) + EPS);
            store_bf16_row(XA + (size_t)m * D, v[q], F.lane); if (F.lane == 0) RSA[m] = rstd; } } }
}
__device__ __forceinline__ void phase_h(Frame& F, int l) {
    const bf16_t* XA = (const bf16_t*)(F.out + O_Y); bf16_t* XB = (bf16_t*)(F.ws + WS_R2); float* RSB = (float*)(F.ws + WS_RSB);
    const bf16_t* Mo = (const bf16_t*)(F.ws + WS_R3 + U1);
    const float* gp = F.in[7] + l * D;
    f32x4 gg[4];
#pragma unroll
    for (int j = 0; j < 4; ++j) gg[j] = *(const f32x4*)(gp + 4 * F.lane + 256 * j);
    const int gw = blockIdx.x * NWAVES + F.wave, NGW = F.G * NWAVES;
    for (int m0 = gw; m0 < T; m0 += RB * NGW) { f32x4 x[RB][4], mm[RB][4];
#pragma unroll
        for (int q = 0; q < RB; ++q) { const int m = m0 + q * NGW; if (m < T) { load_bf16_row(x[q], XA + (size_t)m * D, F.lane); load_bf16_row(mm[q], Mo + (size_t)m * D, F.lane); } }
#pragma unroll
        for (int q = 0; q < RB; ++q) { const int m = m0 + q * NGW; if (m < T) {
            const float rm = rsqrtf(sumsq16(mm[q]) * (1.f / D) + EPS);
#pragma unroll
            for (int j = 0; j < 4; ++j) x[q][j] = x[q][j] + mm[q][j] * rm * gg[j];
            const float rstd = rsqrtf(sumsq16(x[q]) * (1.f / D) + EPS);
            store_bf16_row(XB + (size_t)m * D, x[q], F.lane); if (F.lane == 0) RSB[m] = rstd; } } }
}
__device__ __forceinline__ void phase_k(Frame& F, int l) {
    bf16_t* XA = (bf16_t*)(F.out + O_Y); const bf16_t* XB = (const bf16_t*)(F.ws + WS_R2); float* RSA = (float*)(F.ws + WS_RSA);
    const bf16_t* Fo = (const bf16_t*)(F.ws + WS_R1); float* Y = F.out + O_Y;
    const float* gp = F.in[17] + l * D;
    f32x4 gg[4];
#pragma unroll
    for (int j = 0; j < 4; ++j) gg[j] = *(const f32x4*)(gp + 4 * F.lane + 256 * j);
    const int gw = blockIdx.x * NWAVES + F.wave, NGW = F.G * NWAVES;
    for (int m0 = gw; m0 < T; m0 += RB * NGW) { f32x4 x[RB][4], mm[RB][4];
#pragma unroll
        for (int q = 0; q < RB; ++q) { const int m = m0 + q * NGW; if (m < T) { load_bf16_row(x[q], XB + (size_t)m * D, F.lane); load_bf16_row(mm[q], Fo + (size_t)m * D, F.lane); } }
#pragma unroll
        for (int q = 0; q < RB; ++q) { const int m = m0 + q * NGW; if (m < T) {
            const float rm = rsqrtf(sumsq16(mm[q]) * (1.f / D) + EPS);
#pragma unroll
            for (int j = 0; j < 4; ++j) x[q][j] = x[q][j] + mm[q][j] * rm * gg[j];
            if (l == 0) { const float rstd = rsqrtf(sumsq16(x[q]) * (1.f / D) + EPS); store_bf16_row(XA + (size_t)m * D, x[q], F.lane); if (F.lane == 0) RSA[m] = rstd; }
            else {
#pragma unroll
                for (int j = 0; j < 4; ++j) *(f32x4*)(Y + (size_t)m * D + 4 * F.lane + 256 * j) = x[q][j]; } } } }
}
__device__ __forceinline__ void ld16bf(float (&d)[16], const bf16_t* p) {
    const u32x4 a = *(const u32x4*)p, b = *(const u32x4*)(p + 8);
    d[0] = bflo(a.x); d[1] = bfhi(a.x); d[2] = bflo(a.y); d[3] = bfhi(a.y); d[4] = bflo(a.z); d[5] = bfhi(a.z); d[6] = bflo(a.w); d[7] = bfhi(a.w);
    d[8] = bflo(b.x); d[9] = bfhi(b.x); d[10] = bflo(b.y); d[11] = bfhi(b.y); d[12] = bflo(b.z); d[13] = bfhi(b.z); d[14] = bflo(b.w); d[15] = bfhi(b.w);
}
__device__ __forceinline__ void cvt16(float (&d)[16], const u32x4 a, const u32x4 b) {
    d[0] = bflo(a.x); d[1] = bfhi(a.x); d[2] = bflo(a.y); d[3] = bfhi(a.y); d[4] = bflo(a.z); d[5] = bfhi(a.z); d[6] = bflo(a.w); d[7] = bfhi(a.w);
    d[8] = bflo(b.x); d[9] = bfhi(b.x); d[10] = bflo(b.y); d[11] = bfhi(b.y); d[12] = bflo(b.z); d[13] = bfhi(b.z); d[14] = bflo(b.w); d[15] = bfhi(b.w);
}
__device__ __forceinline__ void ld16f(float (&d)[16], const float* p) {
#pragma unroll
    for (int j = 0; j < 4; ++j) { const f32x4 a = *(const f32x4*)(p + 4 * j); d[4 * j] = a[0]; d[4 * j + 1] = a[1]; d[4 * j + 2] = a[2]; d[4 * j + 3] = a[3]; }
}
__device__ __forceinline__ void phase_c(Frame& F, int l) {
    const bf16_t* Bg = (const bf16_t*)(F.ws + WS_BG); const bf16_t* U = (const bf16_t*)(F.ws + WS_U); const bf16_t* LAT = (const bf16_t*)(F.ws + WS_LAT);
    bf16_t* YAin = (bf16_t*)(F.ws + WS_R0); bf16_t* QLn = (bf16_t*)(F.ws + WS_QLN); bf16_t* Call = (bf16_t*)(F.ws + WS_CALL); bf16_t* KR = (bf16_t*)(F.ws + WS_KR);
    const float* rope = (const float*)(F.ws + WS_ROPE);
    const int lane = F.lane;
    { const float* cc = F.in[3] + (size_t)l * DB * PAST * KVL; const float* ck = F.in[4] + (size_t)l * DB * PAST * RP;
      for (int i = blockIdx.x * 512 + F.tid; i < DB * PAST * KVL / 8; i += F.G * 512) { const int e = i * 8, b = e / (PAST * KVL), r = e % (PAST * KVL);
          const f32x4 a = *(const f32x4*)(cc + e), c = *(const f32x4*)(cc + e + 4);
          *(u32x4*)(Call + (size_t)(TP + b * SKEYS) * KVL + r) = (u32x4){pk2(a[0], a[1]), pk2(a[2], a[3]), pk2(c[0], c[1]), pk2(c[2], c[3])}; }
      for (int i = blockIdx.x * 512 + F.tid; i < DB * PAST * RP / 8; i += F.G * 512) { const int e = i * 8, b = e / (PAST * RP), r = e % (PAST * RP);
          const f32x4 a = *(const f32x4*)(ck + e), c = *(const f32x4*)(ck + e + 4);
          *(u32x4*)(KR + (size_t)(TP + b * SKEYS) * RP + r) = (u32x4){pk2(a[0], a[1]), pk2(a[2], a[3]), pk2(c[0], c[1]), pk2(c[2], c[3])}; } }
    float cw0[16], cw1[16], cw2[16];
    ld16f(cw0, F.in[12] + (size_t)l * 3 * D + 16 * lane); ld16f(cw1, F.in[12] + (size_t)l * 3 * D + D + 16 * lane); ld16f(cw2, F.in[12] + (size_t)l * 3 * D + 2 * D + 16 * lane);
    float gq[8], gk[8];
#pragma unroll
    for (int i = 0; i < 8; ++i) { gq[i] = lane < 48 ? F.in[8][l * QL + 8 * lane + i] : 0.f; gk[i] = lane < 32 ? F.in[9][l * KVL + 8 * lane + i] : 0.f; }
    const int gw = blockIdx.x * NWAVES + F.wave, NGW = F.G * NWAVES;
    for (int run = gw; run < T / 8; run += NGW) {
        const int t0 = run * 8; const bool smp = t0 >= TP;
        const int b = smp ? (t0 - TP) / DSEQ : t0 / SEQ, s0 = smp ? (t0 - TP) % DSEQ : t0 % SEQ, slen = smp ? DSEQ : SEQ;
        float up1[16], up2[16];
        if (s0 == 0) {
            if (smp) { const float* hs = F.in[2] + ((size_t)(l * DB + b) * 2) * D + 16 * lane; ld16f(up2, hs); ld16f(up1, hs + D); }
            else {
#pragma unroll
                for (int i = 0; i < 16; ++i) { up1[i] = 0.f; up2[i] = 0.f; } }
        } else { ld16bf(up1, U + (size_t)(t0 - 1) * D + 16 * lane); ld16bf(up2, U + (size_t)(t0 - 2) * D + 16 * lane); }
#pragma unroll 1
        for (int i4 = 0; i4 < 8; i4 += 2) {
            u32x4 rU[2][2], rB[2][2], rQ[2], rC[2]; unsigned rR1[2], rR2[2];
#pragma unroll
            for (int q = 0; q < 2; ++q) { const int t = t0 + i4 + q; const bf16_t* lat = LAT + (size_t)t * LATP;
                rU[q][0] = *(const u32x4*)(U + (size_t)t * D + 16 * lane); rU[q][1] = *(const u32x4*)(U + (size_t)t * D + 16 * lane + 8);
                rB[q][0] = *(const u32x4*)(Bg + (size_t)t * D + 16 * lane); rB[q][1] = *(const u32x4*)(Bg + (size_t)t * D + 16 * lane + 8);
                rQ[q] = (u32x4){0u, 0u, 0u, 0u}; rC[q] = rQ[q]; rR1[q] = 0u; rR2[q] = 0u;
                if (lane < 48) rQ[q] = *(const u32x4*)(lat + 8 * lane);
                if (lane < 32) rC[q] = *(const u32x4*)(lat + QL + 8 * lane);
                if (lane < 16) { rR1[q] = lat[QL + KVL + lane]; rR2[q] = lat[QL + KVL + 16 + lane]; } }
#pragma unroll
            for (int q = 0; q < 2; ++q) {
            const int t = t0 + i4 + q, s = s0 + i4 + q;
            float uc[16], bg[16], y[16];
            cvt16(uc, rU[q][0], rU[q][1]); cvt16(bg, rB[q][0], rB[q][1]);
#pragma unroll
            for (int i = 0; i < 16; ++i) y[i] = bg[i] * (cw0[i] * up2[i] + cw1[i] * up1[i] + cw2[i] * uc[i]);
            *(u32x4*)(YAin + (size_t)t * D + 16 * lane) = (u32x4){pk2(y[0], y[1]), pk2(y[2], y[3]), pk2(y[4], y[5]), pk2(y[6], y[7])};
            *(u32x4*)(YAin + (size_t)t * D + 16 * lane + 8) = (u32x4){pk2(y[8], y[9]), pk2(y[10], y[11]), pk2(y[12], y[13]), pk2(y[14], y[15])};
            if (s >= slen - 2) {
                float* oc = smp ? F.out + O_CONV_S + ((size_t)(l * DB + b) * 2 + (s - (slen - 2))) * D : F.out + O_CONV_P + ((size_t)(l * NB + b) * 2 + (s - (slen - 2))) * D;
#pragma unroll
                for (int j = 0; j < 4; ++j) *(f32x4*)(oc + 16 * lane + 4 * j) = (f32x4){uc[4 * j], uc[4 * j + 1], uc[4 * j + 2], uc[4 * j + 3]};
            }
#pragma unroll
            for (int i = 0; i < 16; ++i) { up2[i] = up1[i]; up1[i] = uc[i]; }
            const size_t krow = smp ? (size_t)(TP + b * SKEYS + PAST + s) : (size_t)t;
            const int pos = smp ? PAST + s : s;
            { float v[8]; const u32x4 w = rQ[q];
              v[0] = bflo(w.x); v[1] = bfhi(w.x); v[2] = bflo(w.y); v[3] = bfhi(w.y); v[4] = bflo(w.z); v[5] = bfhi(w.z); v[6] = bflo(w.w); v[7] = bfhi(w.w);
              float ss = 0.f;
#pragma unroll
              for (int i = 0; i < 8; ++i) ss += v[i] * v[i];
              const float r = rsqrtf(wave_sum(ss) * (1.f / QL) + EPS);
              if (lane < 48) *(u32x4*)(QLn + (size_t)t * QL + 8 * lane) = (u32x4){pk2(v[0] * r * gq[0], v[1] * r * gq[1]), pk2(v[2] * r * gq[2], v[3] * r * gq[3]), pk2(v[4] * r * gq[4], v[5] * r * gq[5]), pk2(v[6] * r * gq[6], v[7] * r * gq[7])}; }
            { float v[8]; const u32x4 w = rC[q];
              v[0] = bflo(w.x); v[1] = bfhi(w.x); v[2] = bflo(w.y); v[3] = bfhi(w.y); v[4] = bflo(w.z); v[5] = bfhi(w.z); v[6] = bflo(w.w); v[7] = bfhi(w.w);
              float ss = 0.f;
#pragma unroll
              for (int i = 0; i < 8; ++i) ss += v[i] * v[i];
              const float r = rsqrtf(wave_sum(ss) * (1.f / KVL) + EPS);
              if (lane < 32) {
#pragma unroll
                  for (int i = 0; i < 8; ++i) v[i] = v[i] * r * gk[i];
                  float* oc = smp ? F.out + O_CKV_S + ((size_t)l * TS + (t - TP)) * KVL : F.out + O_CKV_P + ((size_t)l * TP + t) * KVL;
                  *(f32x4*)(oc + 8 * lane) = (f32x4){v[0], v[1], v[2], v[3]}; *(f32x4*)(oc + 8 * lane + 4) = (f32x4){v[4], v[5], v[6], v[7]};
                  *(u32x4*)(Call + krow * KVL + 8 * lane) = (u32x4){pk2(v[0], v[1]), pk2(v[2], v[3]), pk2(v[4], v[5]), pk2(v[6], v[7])}; } }
            if (lane < 16) { const float x1 = __uint_as_float(rR1[q] << 16), x2 = __uint_as_float(rR2[q] << 16); const float c = rope[pos * 32 + lane], sn = rope[pos * 32 + 16 + lane];
                const float o1 = x1 * c - x2 * sn, o2 = x1 * sn + x2 * c;
                float* ok = smp ? F.out + O_KR_S + ((size_t)l * TS + (t - TP)) * RP : F.out + O_KR_P + ((size_t)l * TP + t) * RP;
                ok[lane] = o1; ok[16 + lane] = o2;
                KR[krow * RP + lane] = (bf16_t)(pk2(o1, o1) & 0xffffu); KR[krow * RP + 16 + lane] = (bf16_t)(pk2(o2, o2) & 0xffffu); }
            }
        }
    }
}
namespace att {
constexpr int KP = 208, VP = 144, KB = 64 * KP, VB = 64 * VP, BUFB = KB + VB;
struct Ptrs { const bf16_t *Qn, *Qr, *Kn, *Vt, *KR; bf16_t* ATT; const float* rope; };
__device__ __forceinline__ float fmax3(float a, float b, float c) { return fmaxf(fmaxf(a, b), c); }
__device__ __forceinline__ void tile_core(const bf16x8 (&kf)[2][6], const bf16x8 (&vf)[2][4], const bf16x8 (&qf)[6], float& m, float& l, f32x16 (&o)[2], int nvalid, int hi) {
    f32x16 p0, p1;
#pragma unroll
    for (int r = 0; r < 16; ++r) { p0[r] = 0.f; p1[r] = 0.f; }
#pragma unroll
    for (int d0 = 0; d0 < 6; ++d0) { p0 = __builtin_amdgcn_mfma_f32_32x32x16_bf16(kf[0][d0], qf[d0], p0, 0, 0, 0); p1 = __builtin_amdgcn_mfma_f32_32x32x16_bf16(kf[1][d0], qf[d0], p1, 0, 0, 0); }
    if (nvalid < 64) {
#pragma unroll
        for (int r = 0; r < 16; ++r) { const int kv = (r & 3) + 8 * (r >> 2) + 4 * hi; if (kv >= nvalid) p0[r] = -1e30f; if (kv + 32 >= nvalid) p1[r] = -1e30f; }
    }
    float rm = fmax3(p0[0], p0[1], p1[0]);
#pragma unroll
    for (int r = 1; r < 16; ++r) rm = fmax3(rm, p0[r], p1[r]);
    rm = fmaxf(rm, __shfl_xor(rm, 32));
    if (__any(rm > m + 8.0f)) { const float mn = fmaxf(m, rm), f = __builtin_amdgcn_exp2f(m - mn); l *= f; m = mn;
#pragma unroll
        for (int r = 0; r < 16; ++r) { o[0][r] *= f; o[1][r] *= f; } }
    float s = 0.f;
#pragma unroll
    for (int r = 0; r < 16; ++r) { p0[r] = __builtin_amdgcn_exp2f(p0[r] - m); p1[r] = __builtin_amdgcn_exp2f(p1[r] - m); s += p0[r] + p1[r]; }
    l += s;
    bf16x8 pa[4];
    { u32x4 w;
      w = (u32x4){pk2(p0[0], p0[1]), pk2(p0[2], p0[3]), pk2(p0[4], p0[5]), pk2(p0[6], p0[7])}; pa[0] = __builtin_bit_cast(bf16x8, w);
      w = (u32x4){pk2(p0[8], p0[9]), pk2(p0[10], p0[11]), pk2(p0[12], p0[13]), pk2(p0[14], p0[15])}; pa[1] = __builtin_bit_cast(bf16x8, w);
      w = (u32x4){pk2(p1[0], p1[1]), pk2(p1[2], p1[3]), pk2(p1[4], p1[5]), pk2(p1[6], p1[7])}; pa[2] = __builtin_bit_cast(bf16x8, w);
      w = (u32x4){pk2(p1[8], p1[9]), pk2(p1[10], p1[11]), pk2(p1[12], p1[13]), pk2(p1[14], p1[15])}; pa[3] = __builtin_bit_cast(bf16x8, w); }
#pragma unroll
    for (int db = 0; db < 2; ++db)
#pragma unroll
        for (int s4 = 0; s4 < 4; ++s4) o[db] = __builtin_amdgcn_mfma_f32_32x32x16_bf16(vf[db][s4], pa[s4], o[db], 0, 0, 0);
}
__device__ __forceinline__ void load_q(bf16x8 (&qf)[6], const bf16_t* qn, const bf16_t* qr, const float* rp, int hi) {
#pragma unroll
    for (int d0 = 0; d0 < 4; ++d0) qf[d0] = *(const bf16x8*)(qn + d0 * 16 + hi * 8);
    const u32x4 a = *(const u32x4*)(qr + hi * 8), b = *(const u32x4*)(qr + 16 + hi * 8);
    const f32x4 c0 = *(const f32x4*)(rp + hi * 8), c1 = *(const f32x4*)(rp + hi * 8 + 4), s0 = *(const f32x4*)(rp + 16 + hi * 8), s1 = *(const f32x4*)(rp + 16 + hi * 8 + 4);
    const float x1[8] = {bflo(a.x), bfhi(a.x), bflo(a.y), bfhi(a.y), bflo(a.z), bfhi(a.z), bflo(a.w), bfhi(a.w)};
    const float x2[8] = {bflo(b.x), bfhi(b.x), bflo(b.y), bfhi(b.y), bflo(b.z), bfhi(b.z), bflo(b.w), bfhi(b.w)};
    const float cs[8] = {c0[0], c0[1], c0[2], c0[3], c1[0], c1[1], c1[2], c1[3]}, sn[8] = {s0[0], s0[1], s0[2], s0[3], s1[0], s1[1], s1[2], s1[3]};
    float o1[8], o2[8];
#pragma unroll
    for (int j = 0; j < 8; ++j) { o1[j] = x1[j] * cs[j] - x2[j] * sn[j]; o2[j] = x1[j] * sn[j] + x2[j] * cs[j]; }
    u32x4 w1 = (u32x4){pk2(o1[0], o1[1]), pk2(o1[2], o1[3]), pk2(o1[4], o1[5]), pk2(o1[6], o1[7])}, w2 = (u32x4){pk2(o2[0], o2[1]), pk2(o2[2], o2[3]), pk2(o2[4], o2[5]), pk2(o2[6], o2[7])};
    qf[4] = __builtin_bit_cast(bf16x8, w1); qf[5] = __builtin_bit_cast(bf16x8, w2);
}
__device__ __forceinline__ void prompt_unit(LAS unsigned char* lds, const Ptrs& P, int qloc0, int qglob0, int kloc0, int kglob0, int h, int qb) {
    int tid_ = threadIdx.x; asm volatile("" : "+v"(tid_));
    const int tid = tid_, lane = tid & 63, r32 = lane & 31, hi = lane >> 5; const int wid = __builtin_amdgcn_readfirstlane(tid >> 6);
    const int NTL = 4 * qb + 4, cq = 4 * qb + (wid >> 1);
    bf16x8 qf[6];
    { const int ql = qloc0 + 32 * wid + r32, pos = qb * 256 + 32 * wid + r32;
      load_q(qf, P.Qn + (size_t)ql * 1024 + h * 64, P.Qr + (size_t)ql * 512 + h * 32, P.rope + pos * 32, hi); }
    const bf16_t* kn_src = P.Kn + (size_t)(kloc0 + (tid >> 3)) * 1024 + h * 64 + (tid & 7) * 8;
    const bf16_t* vt_src = P.Vt + (size_t)(h * 64 + (tid >> 3)) * VT_LD + kloc0 + (tid & 7) * 8;
    const bf16_t* kr_src = P.KR + (size_t)(kglob0 + ((tid & 255) >> 2)) * 32 + (tid & 3) * 8;
    const int k_w = (tid >> 3) * KP + (tid & 7) * 16, r_w = ((tid & 255) >> 2) * KP + 128 + (tid & 3) * 16;
    const int v_w = KB + (tid >> 3) * VP + ((tid & 7) >> 1) * 32 + (tid & 1) * 8;
    u32x4 kreg, vreg, rreg = (u32x4){0u, 0u, 0u, 0u};
    kreg = *(const u32x4*)kn_src; vreg = *(const u32x4*)vt_src; if (tid < 256) rreg = *(const u32x4*)kr_src;
    *(LAS u32x4*)(lds + k_w) = kreg; if (tid < 256) *(LAS u32x4*)(lds + r_w) = rreg;
    *(LAS u32x2*)(lds + v_w) = (u32x2){vreg.x, vreg.y}; *(LAS u32x2*)(lds + v_w + 16) = (u32x2){vreg.z, vreg.w};
    __syncthreads();
    float m = -1e30f, l = 0.f; f32x16 o[2];
#pragma unroll
    for (int r = 0; r < 16; ++r) { o[0][r] = 0.f; o[1][r] = 0.f; }
    for (int j = 0; j < NTL; ++j) {
        const bool more = j + 1 < NTL;
        if (more) { kreg = *(const u32x4*)(kn_src + (size_t)(j + 1) * 64 * 1024); vreg = *(const u32x4*)(vt_src + (j + 1) * 64); if (tid < 256) rreg = *(const u32x4*)(kr_src + (size_t)(j + 1) * 64 * 32); }
        if (j <= cq) {
            const LAS unsigned char* buf = lds + (j & 1) * BUFB;
            bf16x8 kf[2][6], vf[2][4];
#pragma unroll
            for (int kb = 0; kb < 2; ++kb)
#pragma unroll
                for (int d0 = 0; d0 < 6; ++d0) kf[kb][d0] = *(const LAS bf16x8*)(buf + (kb * 32 + r32) * KP + d0 * 32 + hi * 16);
#pragma unroll
            for (int db = 0; db < 2; ++db)
#pragma unroll
                for (int s4 = 0; s4 < 4; ++s4) vf[db][s4] = *(const LAS bf16x8*)(buf + KB + (db * 32 + r32) * VP + s4 * 32 + hi * 16);
            tile_core(kf, vf, qf, m, l, o, 64, hi);
        }
        if (more) { LAS unsigned char* nb = lds + ((j + 1) & 1) * BUFB;
            *(LAS u32x4*)(nb + k_w) = kreg; if (tid < 256) *(LAS u32x4*)(nb + r_w) = rreg;
            *(LAS u32x2*)(nb + v_w) = (u32x2){vreg.x, vreg.y}; *(LAS u32x2*)(nb + v_w + 16) = (u32x2){vreg.z, vreg.w}; }
        __syncthreads();
    }
    l += __shfl_xor(l, 32);
    const float inv = 1.0f / l;
    bf16_t* orow = P.ATT + (size_t)(qglob0 + 32 * wid + r32) * 1024 + h * 64;
#pragma unroll
    for (int db = 0; db < 2; ++db)
#pragma unroll
        for (int g = 0; g < 4; ++g) { u32x2 w; w.x = pk2(o[db][4 * g] * inv, o[db][4 * g + 1] * inv); w.y = pk2(o[db][4 * g + 2] * inv, o[db][4 * g + 3] * inv);
            *(u32x2*)(orow + 32 * db + 8 * g + 4 * hi) = w; }
}
__device__ __forceinline__ void sample_unit(LAS unsigned char* lds, const Ptrs& P, int b, int h) {
    int tid_ = threadIdx.x; asm volatile("" : "+v"(tid_));
    const int tid = tid_, lane = tid & 63, r32 = lane & 31, hi = lane >> 5; const int wid = __builtin_amdgcn_readfirstlane(tid >> 6);
    const int qglob0 = TP + b * DSEQ, qloc0 = qglob0 - G0_ROWS, kglob0 = TP + b * SKEYS, kloc0 = kglob0 - G0_ROWS;
    bf16x8 qf[6];
    load_q(qf, P.Qn + (size_t)(qloc0 + r32) * 1024 + h * 64, P.Qr + (size_t)(qloc0 + r32) * 512 + h * 32, P.rope + (PAST + r32) * 32, hi);
    float m = -1e30f, l = 0.f; f32x16 o[2];
#pragma unroll
    for (int r = 0; r < 16; ++r) { o[0][r] = 0.f; o[1][r] = 0.f; }
    constexpr int NTS = (SKEYS + 63) / 64;
    for (int j = wid; j < NTS; j += NWAVES) {
        const int nvalid = (SKEYS - j * 64) < 64 ? (SKEYS - j * 64) : 64;
        bf16x8 kf[2][6], vf[2][4];
#pragma unroll
        for (int kb = 0; kb < 2; ++kb) { int key = j * 64 + kb * 32 + r32; key = key < SKEYS ? key : SKEYS - 1;
            const bf16_t* kn = P.Kn + (size_t)(kloc0 + key) * 1024 + h * 64 + hi * 8; const bf16_t* kr = P.KR + (size_t)(kglob0 + key) * 32 + hi * 8;
#pragma unroll
            for (int d0 = 0; d0 < 4; ++d0) kf[kb][d0] = *(const bf16x8*)(kn + d0 * 16);
            kf[kb][4] = *(const bf16x8*)(kr); kf[kb][5] = *(const bf16x8*)(kr + 16); }
#pragma unroll
        for (int db = 0; db < 2; ++db) { const bf16_t* vr = P.Vt + (size_t)(h * 64 + db * 32 + r32) * VT_LD + kloc0 + j * 64 + 4 * hi;
#pragma unroll
            for (int s4 = 0; s4 < 4; ++s4) { u32x2 a = (u32x2){0u, 0u}, c = (u32x2){0u, 0u};
                if (16 * s4 + 4 * hi < nvalid) a = *(const u32x2*)(vr + 16 * s4); if (16 * s4 + 8 + 4 * hi < nvalid) c = *(const u32x2*)(vr + 16 * s4 + 8);
                const u32x4 w = (u32x4){a.x, a.y, c.x, c.y}; vf[db][s4] = __builtin_bit_cast(bf16x8, w); } }
        tile_core(kf, vf, qf, m, l, o, nvalid, hi);
    }
    l += __shfl_xor(l, 32);
    LAS float* OL = (LAS float*)lds + wid * (32 * 68); LAS float* ML = (LAS float*)(lds + NWAVES * 32 * 68 * 4);
#pragma unroll
    for (int db = 0; db < 2; ++db)
#pragma unroll
        for (int g = 0; g < 4; ++g) *(LAS f32x4*)(OL + r32 * 68 + 32 * db + 8 * g + 4 * hi) = (f32x4){o[db][4 * g], o[db][4 * g + 1], o[db][4 * g + 2], o[db][4 * g + 3]};
    if (hi == 0) { ML[wid * 64 + r32] = m; ML[wid * 64 + 32 + r32] = l; }
    __syncthreads();
    { const int q = tid >> 4, d = (tid & 15) * 4; float M = -1e30f;
#pragma unroll
      for (int w = 0; w < NWAVES; ++w) M = fmaxf(M, ML[w * 64 + q]);
      float L = 0.f; f32x4 acc = (f32x4){0.f, 0.f, 0.f, 0.f};
#pragma unroll
      for (int w = 0; w < NWAVES; ++w) { const float f = __builtin_amdgcn_exp2f(ML[w * 64 + q] - M); L += f * ML[w * 64 + 32 + q]; acc = acc + *(const LAS f32x4*)((LAS float*)lds + w * (32 * 68) + q * 68 + d) * f; }
      const float inv = 1.0f / L; u32x2 wv; wv.x = pk2(acc[0] * inv, acc[1] * inv); wv.y = pk2(acc[2] * inv, acc[3] * inv);
      *(u32x2*)(P.ATT + (size_t)(qglob0 + q) * 1024 + h * 64 + d) = wv; }
    __syncthreads();
}
__device__ __forceinline__ void attn_phase(LAS unsigned char* lds, const Ptrs& P, int g, int G) {
    const int vb = (G % 8 == 0) ? (int)((blockIdx.x & 7) * (G >> 3) + (blockIdx.x >> 3)) : (int)blockIdx.x;
    for (int pi = vb; pi < 512; pi += G) { const int combo = pi >> 2, s = pi & 3, bl = combo >> 4, h = combo & 15;
        const int brow_glob = (g * 8 + bl) * SEQ, brow_loc = brow_glob - g * G0_ROWS;
#pragma unroll 1
        for (int hf = 0; hf < 2; ++hf) { const int qb = hf ? 7 - s : s; prompt_unit(lds, P, brow_loc + qb * 256, brow_glob + qb * 256, brow_loc, brow_glob, h, qb); } }
    if (g == 1) for (int ui = blockIdx.x; ui < DB * NH; ui += G) sample_unit(lds, P, ui >> 4, ui & 15);
}
}
#define XB_TMO      128
#define XB_XCNT(j)  (256  + 64 * (j))
#define XB_XSUB(j)  (1280 + 64 * (j))
#define XB_XGEN(j)  (2304 + 64 * (j))
#define XB_TOP      3328
#define XB_TOPGEN   3392
#define XCD_BAR_WORDS 3456
#define XB_SPIN_CAP (1u << 18)

__device__ __forceinline__ unsigned xb_ld(unsigned* p)              { return __hip_atomic_load(p, __ATOMIC_RELAXED, __HIP_MEMORY_SCOPE_AGENT); }
__device__ __forceinline__ unsigned xb_add(unsigned* p, unsigned v) { return __hip_atomic_fetch_add(p, v, __ATOMIC_RELAXED, __HIP_MEMORY_SCOPE_AGENT); }
__device__ __forceinline__ unsigned xb_xcc_id() { return (unsigned)__builtin_amdgcn_s_getreg((3 << 11) | 20) & 0xFu; }
#define XB_SPIN(cond, bar) do { unsigned _sp = 0; while (cond) { __builtin_amdgcn_s_sleep(1); \
    if ((++_sp & 255u) == 0u) { if (xb_ld(&(bar)[XB_TMO])) break; if (_sp > XB_SPIN_CAP) { atomicAdd(&(bar)[XB_TMO], 1u); break; } } } } while (0)

struct XcdBarrier {
    unsigned* bar; unsigned x;
    volatile __attribute__((address_space(3))) unsigned* st;
};

__device__ __forceinline__ XcdBarrier xcd_barrier_post(unsigned* bar, volatile __attribute__((address_space(3))) unsigned* st) {
    XcdBarrier b; b.bar = bar; b.x = xb_xcc_id(); b.st = st;
    if (threadIdx.x == 0) (void)xb_add(&bar[XB_XCNT(b.x)], 1u);
    return b;
}
__device__ __forceinline__ void xcd_barrier_complete(unsigned* bar, unsigned x, unsigned& nloc, unsigned& nx) {
    const unsigned G = gridDim.x * gridDim.y * gridDim.z;
    unsigned sum, cnt, mine, sp = 0u;
    for (;;) {
        sum = 0u; cnt = 0u; mine = 0u;
#pragma unroll
        for (unsigned j = 0; j < 16; ++j) { const unsigned c = xb_ld(&bar[XB_XCNT(j)]); sum += c; cnt += (c > 0u) ? 1u : 0u; mine = (j == x) ? c : mine; }
        if (sum == G) break;
        __builtin_amdgcn_s_sleep(1);
        if ((++sp & 255u) == 0u) { if (xb_ld(&bar[XB_TMO])) break; if (sp > XB_SPIN_CAP) { atomicAdd(&bar[XB_TMO], 1u); break; } }
    }
    nloc = mine > 0u ? mine : 1u; nx = cnt > 0u ? cnt : 1u;
}

__device__ __forceinline__ void xcd_barrier(const XcdBarrier& b) {
    asm volatile("s_waitcnt vmcnt(0)" ::: "memory");
    __syncthreads();
    if (threadIdx.x == 0) {
        unsigned* bar = b.bar;
        __builtin_amdgcn_s_waitcnt(0);
        unsigned nloc = b.st[0], nx = b.st[1];
        if (nloc == 0u) { xcd_barrier_complete(bar, b.x, nloc, nx); b.st[0] = nloc; b.st[1] = nx; }
        const unsigned old = xb_add(&bar[XB_XSUB(b.x)], 1u);
        const unsigned gen = old / nloc;
        if (old + 1u == (gen + 1u) * nloc) {
            __builtin_amdgcn_fence(__ATOMIC_RELEASE, "agent");
            asm volatile("s_waitcnt vmcnt(0)" ::: "memory");
            const unsigned og = xb_add(&bar[XB_TOP], 1u);
            const unsigned tg = og / nx;
            if (og + 1u == (tg + 1u) * nx) xb_add(&bar[XB_TOPGEN], 1u);
            else XB_SPIN(xb_ld(&bar[XB_TOPGEN]) == tg, bar);
            __builtin_amdgcn_fence(__ATOMIC_ACQUIRE, "agent");
            xb_add(&bar[XB_XGEN(b.x)], 1u);
            asm volatile("s_waitcnt vmcnt(0)" ::: "memory");
        } else {
            XB_SPIN(xb_ld(&bar[XB_XGEN(b.x)]) == gen, bar);
            __builtin_amdgcn_fence(__ATOMIC_ACQUIRE, "agent");
            asm volatile("s_waitcnt vmcnt(0)" ::: "memory");
        }
    }
    __syncthreads();
}

__device__ __forceinline__ void small_gemm(LAS unsigned char* lds, unsigned char* ws, size_t oA, size_t oB, int N_out, int K, int kind, size_t oO, int ldc, int G) {
    int tid_ = threadIdx.x; asm volatile("" : "+v"(tid_));
    const int tid = tid_, lane = tid & 63, r32 = lane & 31, hi = lane >> 5; const int kq = __builtin_amdgcn_readfirstlane(tid >> 6);
    const bool paired = kind == pg8::EK_SWIGLU;
    const int nitems = 8 * (N_out / 32);
    const bf16_t* A = (const bf16_t*)(ws + oA) + (size_t)TP * K; const bf16_t* Bt = (const bf16_t*)(ws + oB);
    const int kslice = K / 8, k0 = kq * kslice;
    LAS float* PA = (LAS float*)lds; LAS float* PB = (LAS float*)(lds + 32768);
    for (int it = blockIdx.x; it < nitems; it += G) {
        const int rb = it & 7, cg = it >> 3;
        int browa, ocol;
        if (paired) { const int tile = cg >> 2, q4 = cg & 3; browa = tile * 256 + q4 * 32; ocol = tile * 128 + q4 * 32; } else { browa = cg * 32; ocol = cg * 32; }
        const bf16_t* ap = A + (size_t)(rb * 32 + r32) * K + k0 + 8 * hi;
        const bf16_t* bp = Bt + (size_t)(browa + r32) * K + k0 + 8 * hi;
        f32x16 ca, cb;
#pragma unroll
        for (int r = 0; r < 16; ++r) { ca[r] = 0.f; cb[r] = 0.f; }
        if (paired) {
#pragma unroll 4
            for (int k = 0; k < kslice; k += 32) {
                const bf16x8 a0 = *(const bf16x8*)(ap + k), a1 = *(const bf16x8*)(ap + k + 16);
                const bf16x8 b0 = *(const bf16x8*)(bp + k), b1 = *(const bf16x8*)(bp + k + 16), c0 = *(const bf16x8*)(bp + (size_t)128 * K + k), c1 = *(const bf16x8*)(bp + (size_t)128 * K + k + 16);
                ca = __builtin_amdgcn_mfma_f32_32x32x16_bf16(a0, b0, ca, 0, 0, 0); ca = __builtin_amdgcn_mfma_f32_32x32x16_bf16(a1, b1, ca, 0, 0, 0);
                cb = __builtin_amdgcn_mfma_f32_32x32x16_bf16(a0, c0, cb, 0, 0, 0); cb = __builtin_amdgcn_mfma_f32_32x32x16_bf16(a1, c1, cb, 0, 0, 0);
            }
        } else {
#pragma unroll 4
            for (int k = 0; k < kslice; k += 32) {
                const bf16x8 a0 = *(const bf16x8*)(ap + k), a1 = *(const bf16x8*)(ap + k + 16);
                const bf16x8 b0 = *(const bf16x8*)(bp + k), b1 = *(const bf16x8*)(bp + k + 16);
                ca = __builtin_amdgcn_mfma_f32_32x32x16_bf16(a0, b0, ca, 0, 0, 0); ca = __builtin_amdgcn_mfma_f32_32x32x16_bf16(a1, b1, ca, 0, 0, 0);
            }
        }
#pragma unroll
        for (int r = 0; r < 16; ++r) { PA[(kq * 16 + r) * 64 + lane] = ca[r]; if (paired) PB[(kq * 16 + r) * 64 + lane] = cb[r]; }
        __syncthreads();
        if (tid < 128) { const int r = tid >> 3, h2 = (tid >> 2) & 1, g = tid & 3;
          f32x4 v0 = (f32x4){0.f, 0.f, 0.f, 0.f}, v1 = v0, w0 = v0, w1 = v0;
#pragma unroll
          for (int q = 0; q < 8; ++q) { const int o = (q * 16 + r) * 64 + h2 * 32 + 8 * g;
              v0 = v0 + *(const LAS f32x4*)(PA + o); v1 = v1 + *(const LAS f32x4*)(PA + o + 4);
              if (paired) { w0 = w0 + *(const LAS f32x4*)(PB + o); w1 = w1 + *(const LAS f32x4*)(PB + o + 4); } }
          const int orow = TP + rb * 32 + (r & 3) + 8 * (r >> 2) + 4 * h2, c = ocol + 8 * g;
          const size_t off = (size_t)orow * ldc + c; bf16_t* O = (bf16_t*)(ws + oO);
          if (kind == pg8::EK_SWIGLU) {
              { const float rr = ((const float*)(ws + WS_RSB))[orow]; v0 = v0 * rr; v1 = v1 * rr; w0 = w0 * rr; w1 = w1 * rr; }
#pragma unroll
              for (int i = 0; i < 4; ++i) { v0[i] = v0[i] * pg8::sigm(v0[i]) * w0[i]; v1[i] = v1[i] * pg8::sigm(v1[i]) * w1[i]; }
          } else if (kind == pg8::EK_GATE) { const u32x4 gg = *(const u32x4*)((const bf16_t*)(ws + WS_R1) + off);
              v0[0] *= bflo(gg.x); v0[1] *= bfhi(gg.x); v0[2] *= bflo(gg.y); v0[3] *= bfhi(gg.y); v1[0] *= bflo(gg.z); v1[1] *= bfhi(gg.z); v1[2] *= bflo(gg.w); v1[3] *= bfhi(gg.w);
          } else if (kind == pg8::EK_COMBINE) { const u32x4 y = *(const u32x4*)((const bf16_t*)(ws + WS_R1) + off); const u32x4 gg = *(const u32x4*)((const bf16_t*)(ws + WS_R2) + off);
              v0[0] = bflo(y.x) + bflo(gg.x) * v0[0]; v0[1] = bfhi(y.x) + bfhi(gg.x) * v0[1]; v0[2] = bflo(y.y) + bflo(gg.y) * v0[2]; v0[3] = bfhi(y.y) + bfhi(gg.y) * v0[3];
              v1[0] = bflo(y.z) + bflo(gg.z) * v1[0]; v1[1] = bfhi(y.z) + bfhi(gg.z) * v1[1]; v1[2] = bflo(y.w) + bflo(gg.w) * v1[2]; v1[3] = bfhi(y.w) + bfhi(gg.w) * v1[3]; }
          *(u32x4*)(O + off) = (u32x4){pk2(v0[0], v0[1]), pk2(v0[2], v0[3]), pk2(v1[0], v1[1]), pk2(v1[2], v1[3])}; }
        __syncthreads();
    }
}

constexpr int NSTEP = 18;
__host__ __device__ constexpr bool step_sync(int l, int s) { return !(s == 3 || s == 4 || s == 5 || s == 8 || s == 9 || (s == 0 && l != 0)); }
__device__ __forceinline__ void run_gemm(Frame& F, int s) {
    unsigned char* ws = F.ws;
    const int grp = (s >= 8) ? 1 : 0;
    size_t oA = WS_R0, oB = WS_W, oO = WS_R1;
    int M = T, N = D, K = D, kind = pg8::EK_PLAIN, ldc = 1024, rot = 0; float scale = 1.f;
    if (s == 1) { oB = WS_W + W_IN * 2; N = DINP; kind = pg8::EK_WIN; oO = WS_BG; }
    else if (s == 3) { oB = WS_W + W_CONV * 2; kind = pg8::EK_GATE; oO = WS_R1; }
    else if (s == 4 || s == 8) { oA = WS_QLN + (size_t)grp * G0_ROWS * QL * 2; oB = WS_W + W_UQ * 2; M = grp ? G1_ROWS : G0_ROWS; N = 1536; K = QL; kind = pg8::EK_Q; oO = WS_QN; scale = QSCALE; rot = grp ? 0 : 128; }
    else if (s == 5 || s == 9) { oA = WS_CALL + (size_t)grp * G0_ROWS * KVL * 2; oB = WS_W + W_UK * 2; M = grp ? G1_KEYS : G0_ROWS; N = 1024; K = KVL; oO = WS_KN; rot = grp ? 112 : 0; }
    else if (s == 6 || s == 10) { oA = WS_W + W_UV * 2; oB = WS_CALL + (size_t)grp * G0_ROWS * KVL * 2; M = 1024; N = grp ? G1_KEYS : G0_ROWS; K = KVL; oO = WS_VT; ldc = VT_LD; rot = grp ? 104 : 0; }
    else if (s == 12) { oB = WS_W + W_ATTN * 2; kind = pg8::EK_COMBINE; oO = WS_R3; }
    else if (s == 13) { oA = WS_R3; oB = WS_W + W_MERGE * 2; oO = WS_R3 + U1; }
    else if (s == 15) { oA = WS_R2; oB = WS_W + W_GU * 2; N = 2 * DFF; kind = pg8::EK_SWIGLU; oO = WS_R3; ldc = DFF; }
    else { oA = WS_R3; oB = WS_W + W_DOWN * 2; K = DFF; oO = WS_R1; }
    const bool split_sample = (s == 3 || s == 12 || s == 13 || s == 15 || s == 16);
    if (split_sample) M = TP;
    const pg8::bf16_t* Ap = (s == 1) ? (const pg8::bf16_t*)(F.out + O_Y) : (const pg8::bf16_t*)(ws + oA);
    const pg8::Gemm g{Ap, (const pg8::bf16_t*)(ws + oB), M, N, K};
    const pg8::EpiX E{kind, ws, oO, ldc, scale, (s == 15) ? WS_RSB : WS_RSA, (s == 1 || s == 15) ? 1 : 0};
    pg8::StaticOrder S; S.init(g.M, g.N, F.G, (int)((blockIdx.x + rot) % F.G));
    pg8::gemm_phase<pg8::EpiX, pg8::StaticOrder, true, true>(F.lds, g, S, E);
    if (split_sample) small_gemm(F.lds, ws, oA, oB, kind == pg8::EK_SWIGLU ? N / 2 : N, K, kind, oO, ldc, F.G);
}

__global__ void __launch_bounds__(NWAVES * 64, 2) fwd_mega(Args args) {
    extern __shared__ __attribute__((aligned(16))) unsigned char lds_raw[];
    cg::grid_group grid = cg::this_grid();
    Frame F;
    F.lds = (LAS unsigned char*)lds_raw; F.tid = threadIdx.x; F.lane = F.tid & 63; F.wave = __builtin_amdgcn_readfirstlane(F.tid >> 6); F.G = gridDim.x;
    F.in = args.in;
    F.out = args.out; F.ws = args.ws;
    volatile LAS unsigned* bst = (volatile LAS unsigned*)(F.lds + 131072);
    if (F.tid < 64) bst[F.tid] = 0u;
    __syncthreads();
    XcdBarrier bar = xcd_barrier_post((unsigned*)(args.ws) + 1024, bst + 8);
    for (int vst = args.st_lo * 2; vst < args.st_hi * 2; ++vst) {
        const int st = vst >> 1, rep = vst & 1;
        const int l = st / NSTEP, s = st % NSTEP;
        { int t_ = threadIdx.x; asm volatile("" : "+v"(t_)); F.tid = t_; F.lane = t_ & 63; F.wave = __builtin_amdgcn_readfirstlane(t_ >> 6); }
#ifndef PROBE_GEMM
#define PROBE_GEMM 0
#endif
#ifndef PROBE_ATT
#define PROBE_ATT 0
#endif
        const bool is_g = (s == 1 || s == 4 || s == 5 || s == 6 || s == 8 || s == 9 || s == 10 || s == 12 || s == 13 || s == 15 || s == 16);
        const int reps = ((PROBE_GEMM && is_g) || (PROBE_ATT && (s == 7 || s == 11))) ? 2 : 1;
        if (rep >= reps) continue;
        if (l == 0 && (s == 0 || s == 17)) convert_weights(F, s == 0 ? 0 : 1);
        if (s == 0) { if (l == 0) { build_rope(F); phase_norm_in(F); } }
        else if (s == 2) phase_c(F, l);
        else if (s == 7 || s == 11) {
            att::Ptrs P; P.Qn = (const bf16_t*)(F.ws + WS_QN); P.Qr = (const bf16_t*)(F.ws + WS_QR); P.Kn = (const bf16_t*)(F.ws + WS_KN); P.Vt = (const bf16_t*)(F.ws + WS_VT);
            P.KR = (const bf16_t*)(F.ws + WS_KR); P.ATT = (bf16_t*)(F.ws + WS_R0); P.rope = (const float*)(F.ws + WS_ROPE);
            att::attn_phase(F.lds, P, s == 7 ? 0 : 1, F.G);
        }
        else if (s == 14) phase_h(F, l);
        else if (s == 17) phase_k(F, l);
        else run_gemm(F, s);
        if (rep + 1 == reps && step_sync(l, s) && st + 1 < args.st_hi) { if (args.st_lo < 0) grid.sync(); else xcd_barrier(bar); }
    }
}

#ifndef MK_MULTI
#define MK_MULTI 0
#endif
extern "C" void kernel_launch(void* const* d_in, const int* in_sizes, int n_in, void* d_out, int out_size, void* d_ws, size_t ws_size, hipStream_t stream) {
    static int grid_blocks = 0;
    if (grid_blocks == 0) {
        if (n_in != 20 || out_size != (int)O_END || ws_size < WS_END) { fprintf(stderr, "kernel_launch: unexpected shapes n_in %d out %d ws %zu (need %zu)\n", n_in, out_size, ws_size, (size_t)WS_END); grid_blocks = -1; return; }
        int dev = 0, cus = 0, per_cu = 0;
        (void)hipGetDevice(&dev); (void)hipDeviceGetAttribute(&cus, hipDeviceAttributeMultiprocessorCount, dev);
        (void)hipFuncSetAttribute((const void*)fwd_mega, hipFuncAttributeMaxDynamicSharedMemorySize, LDS_BYTES);
        (void)hipOccupancyMaxActiveBlocksPerMultiprocessor(&per_cu, (const void*)fwd_mega, NWAVES * 64, LDS_BYTES);
        if (per_cu < 1) per_cu = 1;
        if (cus <= 0) cus = 256;
        grid_blocks = cus * per_cu;
    }
    if (grid_blocks < 0) return;
    Args a{};
    for (int i = 0; i < 20; ++i) a.in[i] = (const float*)d_in[i];
    a.out = (float*)d_out; a.ws = (unsigned char*)d_ws;
    (void)hipMemsetAsync(d_ws, 0, 65536, stream);
#if MK_MULTI
    int lo = 0;
    for (int st = 0; st < 2 * NSTEP; ++st) {
        if (step_sync(st / NSTEP, st % NSTEP) || st + 1 == 2 * NSTEP) { a.st_lo = lo; a.st_hi = st + 1; hipLaunchKernelGGL(fwd_mega, dim3(grid_blocks), dim3(NWAVES * 64), LDS_BYTES, stream, a); lo = st + 1; }
    }
#else
    a.st_lo = 0; a.st_hi = 2 * NSTEP;
    void* params[] = {&a};
    hipError_t e = hipLaunchCooperativeKernel((const void*)fwd_mega, dim3(grid_blocks), dim3(NWAVES * 64), params, LDS_BYTES, stream);
    if (e != hipSuccess) fprintf(stderr, "cooperative launch failed: %s (grid %d)\n", hipGetErrorString(e), grid_blocks);
#endif
}
```

```cpp
#include <hip/hip_runtime.h>
#include <hip/hip_cooperative_groups.h>
#include <cstdio>
#include <cstdint>
namespace cg = cooperative_groups;
constexpr int NWAVES = 8;
constexpr int D = 1024, TP = 32768, TS = 256, T = TP + TS, SEQ = 2048, NB = 16, DB = 8, DSEQ = 32, PAST = 2048, SKEYS = PAST + DSEQ, KT = TP + DB * SKEYS;
constexpr int DIN = 5792, DINP = 5888, QL = 384, KVL = 256, RP = 32, DFF = 2816, NH = 16, LATP = 768;
constexpr int G0_ROWS = 16384, G1_ROWS = T - G0_ROWS, G1_KEYS = KT - G0_ROWS, VT_LD = 33024;
constexpr float EPS = 1e-6f;
constexpr float QSCALE = 0.10206207261596577f * 1.4426950408889634f;
static_assert(T % 256 == 0 && G1_ROWS % 256 == 0 && G1_KEYS % 256 == 0 && KT % 256 == 0 && G1_KEYS == VT_LD, "tiles");
constexpr size_t O_Y = 0, O_CONV_P = (size_t)T * D, O_CKV_P = O_CONV_P + 2 * NB * 2 * D, O_KR_P = O_CKV_P + (size_t)2 * TP * KVL, O_CONV_S = O_KR_P + (size_t)2 * TP * RP,
                 O_CKV_S = O_CONV_S + 2 * DB * 2 * D, O_KR_S = O_CKV_S + (size_t)2 * TS * KVL, O_END = O_KR_S + (size_t)2 * TS * RP;
static_assert(O_END == 52936704, "d_out size");
constexpr size_t MiB = 1u << 20, U1 = (size_t)T * D * 2;
constexpr size_t WS_RSA = 256 * 1024, WS_RSB = 512 * 1024;
constexpr size_t WS_ROPE = 1 * MiB, WS_W = 2 * MiB, WS_R0 = 40 * MiB, WS_R1 = WS_R0 + U1, WS_R2 = WS_R1 + U1, WS_R3 = WS_R2 + U1, WS_R6 = WS_R3 + 178 * MiB;
constexpr size_t WS_QLN = WS_R6, WS_CALL = WS_QLN + (size_t)T * QL * 2, WS_KR = WS_CALL + (size_t)KT * KVL * 2, WS_END = WS_KR + (size_t)KT * RP * 2;
constexpr size_t W_IN = 0, W_UQ = W_IN + (size_t)DINP * D, W_UK = W_UQ + (size_t)1536 * QL, W_UV = W_UK + (size_t)1024 * KVL, W_CONV = W_UV + (size_t)1024 * KVL,
                 W_ATTN = W_CONV + (size_t)D * D, W_MERGE = W_ATTN + (size_t)D * D, W_GU = W_MERGE + (size_t)D * D, W_DOWN = W_GU + (size_t)2 * DFF * D, W_END = W_DOWN + (size_t)D * DFF;
static_assert(WS_W + W_END * 2 <= WS_R0, "weights fit");
constexpr size_t WS_BG = WS_R3, WS_U = WS_R3 + U1, WS_LAT = WS_R3 + 2 * U1;
constexpr size_t WS_QN = WS_R3, WS_QR = WS_QN + (size_t)G1_ROWS * 1024 * 2, WS_KN = WS_QR + (size_t)G1_ROWS * 512 * 2, WS_VT = WS_KN + (size_t)G1_KEYS * 1024 * 2, WS_GEND = WS_VT + (size_t)1024 * VT_LD * 2;
static_assert(WS_GEND <= WS_R6 && WS_LAT + (size_t)T * LATP * 2 <= WS_R6 && WS_R3 + (size_t)T * DFF * 2 <= WS_R6, "R3 region");
static_assert(WS_END <= 536870912, "d_ws budget (512 MiB)");
constexpr int LDS_BYTES = 131072 + 1024;


namespace pg8 {
#define PG8_LAS __attribute__((address_space(3)))
typedef unsigned short bf16_t;
typedef short bf16x8 __attribute__((ext_vector_type(8)));
typedef float f32x4 __attribute__((ext_vector_type(4)));
typedef unsigned u32x4 __attribute__((ext_vector_type(4)));
constexpr int BM = 256, BK = 64, HALF = 128, HTB = HALF * BK * 2  , STAGE_BYTES = 8 * HTB, NXCD = 8, WGM = 8;

__host__ __device__ __forceinline__ int lds_byte(int r, int c) { const int st = (r >> 4) * 2 + (c >> 5), rr = r & 15, cc = c & 31, ob = rr * 64 + cc * 2; return st * 1024 + (ob ^ (((ob >> 9) & 1) << 5)); }
__host__ __device__ __forceinline__ void stage_rc(int b, int& R, int& C) { const int st = b / 1024, sb = b % 1024, swz = sb ^ (((sb >> 9) & 1) << 5); R = (st >> 1) * 16 + swz / 64; C = (st & 1) * 32 + (swz % 64) / 2; }
__host__ __device__ __forceinline__ int perm32(int rho) { const int n = rho >> 4, i = rho & 15; return 8 * (i >> 2) + 4 * n + (i & 3); }

struct Unit { int pm, pn; };
struct Gemm { const bf16_t* A; const bf16_t* Bt; int M, N, K; };

struct StaticOrder {
    int nM, nN, nwg, G, c;
    __host__ __device__ void init(int M, int N, int G_, int c_) { nM = M / BM; nN = N / BM; nwg = nM * nN; G = G_; c = c_; }
    __host__ __device__ bool next(int i, Unit& u) const {
        const long L = (long)i * G + c; if (L >= nwg) return false;
        int wgid = (int)L; { const int q = nwg / NXCD, r = nwg % NXCD, xcd = wgid % NXCD, off = wgid / NXCD; wgid = (xcd < r ? xcd * (q + 1) : r * (q + 1) + (xcd - r) * q) + off; }
        const int nig = WGM * nN, gid = wgid / nig, fm = gid * WGM, gsz = (nM - fm) < WGM ? (nM - fm) : WGM;
        u.pm = fm + ((wgid % nig) % gsz); u.pn = (wgid % nig) / gsz; return true;
    }
    __device__ __forceinline__ void a_ready(const Unit&) const {}
    __device__ __forceinline__ void done(const Unit&) const {}
};

__device__ __forceinline__ unsigned cvt_pk_bf16(float lo, float hi) { unsigned r; asm volatile("v_cvt_pk_bf16_f32 %0, %1, %2" : "=v"(r) : "v"(lo), "v"(hi)); return r; }
typedef float f32x2 __attribute__((ext_vector_type(2)));
typedef unsigned u32x4e __attribute__((ext_vector_type(4)));
enum { EK_PLAIN = 0, EK_PAIRMUL = 1, EK_SWIGLU = 2, EK_SIGMOID = 3, EK_GATE = 4, EK_COMBINE = 5, EK_WIN = 6, EK_Q = 7 };
__device__ __forceinline__ float sigm(float x) { return __builtin_amdgcn_rcpf(1.0f + __builtin_amdgcn_exp2f(-1.4426950408889634f * x)); }
__device__ __forceinline__ float bflo(unsigned w) { return __uint_as_float(w << 16); }
__device__ __forceinline__ float bfhi(unsigned w) { return __uint_as_float(w & 0xffff0000u); }
struct EpiX {
    static constexpr bool PERM = true, AFTER_DRAIN = false;
    int kind; unsigned char* ws; size_t oO; int ldc; float scale; size_t oRS; int use_rs;
    __device__ __forceinline__ void operator()(const f32x4 (&acc)[2][2][4][2], const Unit& u, int wr, int wc, int fr, int fq) const {
        int k = kind; size_t ob = oO; int ld = ldc; int colt = u.pn * BM; const float sc = scale;
        if (k == EK_WIN) {
            const int pn = u.pn;
            if (pn < 4) { k = EK_PLAIN; }
            else if (pn < 12) { k = EK_PAIRMUL; ob = WS_U; colt = (pn - 4) * 128; }
            else if (pn < 16) { k = EK_SIGMOID; ob = WS_R1; colt = (pn - 12) * 256; }
            else if (pn < 20) { k = EK_SIGMOID; ob = WS_R2; colt = (pn - 16) * 256; }
            else { k = EK_PLAIN; ob = WS_LAT; colt = (pn - 20) * 256; ld = 768; }
        } else if (k == EK_Q) {
            k = EK_PLAIN; if (u.pn >= 4) { ob = WS_QR; colt = (u.pn - 4) * 256; ld = 512; }
        } else if (k == EK_PAIRMUL || k == EK_SWIGLU) colt = u.pn * 128;
        const int row0 = u.pm * BM + wr * 64 + fr;
        const int col0 = colt + wc * 32 + 8 * fq;
        bf16_t* base = (bf16_t*)(ws + ob); const bf16_t* aux1 = (const bf16_t*)(ws + WS_R1); const bf16_t* aux2 = (const bf16_t*)(ws + WS_R2);
        const float* rsp = (const float*)(ws + oRS);
        if (k == EK_PAIRMUL || k == EK_SWIGLU) {
#pragma unroll
            for (int ai = 0; ai < 2; ++ai)
#pragma unroll
                for (int m = 0; m < 4; ++m) {
                    bf16_t* rowp = base + (size_t)(row0 + ai * HALF + m * 16) * ld + col0;
                    const float rr = use_rs ? rsp[row0 + ai * HALF + m * 16] : 1.f;
                    f32x4 a0 = acc[ai][0][m][0] * rr, a1 = acc[ai][0][m][1] * rr; const f32x4 b0 = acc[ai][1][m][0] * rr, b1 = acc[ai][1][m][1] * rr;
                    if (k == EK_SWIGLU) {
#pragma unroll
                        for (int i = 0; i < 4; ++i) { a0[i] = a0[i] * sigm(a0[i]); a1[i] = a1[i] * sigm(a1[i]); }
                    }
                    const f32x4 v0 = a0 * b0, v1 = a1 * b1;
                    u32x4e w; w.x = cvt_pk_bf16(v0[0], v0[1]); w.y = cvt_pk_bf16(v0[2], v0[3]); w.z = cvt_pk_bf16(v1[0], v1[1]); w.w = cvt_pk_bf16(v1[2], v1[3]);
                    *(u32x4e*)rowp = w;
                }
        } else {
#pragma unroll
            for (int ai = 0; ai < 2; ++ai)
#pragma unroll
                for (int m = 0; m < 4; ++m) {
                    const size_t roff = (size_t)(row0 + ai * HALF + m * 16) * ld + col0;
                    const float rr = use_rs ? rsp[row0 + ai * HALF + m * 16] : 1.f;
#pragma unroll
                    for (int bj = 0; bj < 2; ++bj) {
                        f32x4 v0 = acc[ai][bj][m][0], v1 = acc[ai][bj][m][1];
                        const size_t off = roff + bj * HALF;
                        if (k == EK_PLAIN) { v0 = v0 * (sc * rr); v1 = v1 * (sc * rr); }
                        else if (k == EK_SIGMOID) {
#pragma unroll
                            for (int i = 0; i < 4; ++i) { v0[i] = sigm(v0[i] * rr); v1[i] = sigm(v1[i] * rr); }
                        } else if (k == EK_GATE) {
                            const u32x4e g = *(const u32x4e*)(aux1 + off);
                            v0[0] *= bflo(g.x); v0[1] *= bfhi(g.x); v0[2] *= bflo(g.y); v0[3] *= bfhi(g.y);
                            v1[0] *= bflo(g.z); v1[1] *= bfhi(g.z); v1[2] *= bflo(g.w); v1[3] *= bfhi(g.w);
                        } else {
                            const u32x4e y = *(const u32x4e*)(aux1 + off); const u32x4e g = *(const u32x4e*)(aux2 + off);
                            v0[0] = bflo(y.x) + bflo(g.x) * v0[0]; v0[1] = bfhi(y.x) + bfhi(g.x) * v0[1]; v0[2] = bflo(y.y) + bflo(g.y) * v0[2]; v0[3] = bfhi(y.y) + bfhi(g.y) * v0[3];
                            v1[0] = bflo(y.z) + bflo(g.z) * v1[0]; v1[1] = bfhi(y.z) + bfhi(g.z) * v1[1]; v1[2] = bflo(y.w) + bflo(g.w) * v1[2]; v1[3] = bfhi(y.w) + bfhi(g.w) * v1[3];
                        }
                        u32x4e w; w.x = cvt_pk_bf16(v0[0], v0[1]); w.y = cvt_pk_bf16(v0[2], v0[3]); w.z = cvt_pk_bf16(v1[0], v1[1]); w.w = cvt_pk_bf16(v1[2], v1[3]);
                        *(u32x4e*)(base + off) = w;
                    }
                }
        }
    }
};
template <class Epi, class Sched, bool ALIGN_EPI = false, bool SP2 = false>
__device__ __forceinline__ void gemm_phase(PG8_LAS unsigned char* lds, const Gemm g, const Sched& S, const Epi& E) {
    int tid_ = threadIdx.x; asm volatile("" : "+v"(tid_));
    const int tid = tid_, wid = __builtin_amdgcn_readfirstlane(tid >> 6), lane = tid & 63, wr = wid >> 2, wc = wid & 3, fr = lane & 15, fq = lane >> 4;
    const int K = g.K, nt = K / BK;
    unsigned voffA[2], voffB[2];
#pragma unroll
    for (int i = 0; i < 2; ++i) { int R, C; stage_rc(tid * 16 + i * 8192, R, C); const int Rb = Epi::PERM ? ((R & ~31) + perm32(R & 31)) : R;
        voffA[i] = (unsigned)(R * K + C) * 2u; voffB[i] = (unsigned)(Rb * K + C) * 2u; }
    const size_t kstep = (size_t)(BK * 2);
    const size_t hstep = (size_t)HALF * K * 2;
    const size_t tstep = 2 * hstep;
    const unsigned ldsw = (unsigned)wid * 1024u;
    const int aoff = lds_byte(wr * 64 + fr, fq * 8), boff = lds_byte(wc * 32 + fr, fq * 8);
#define PG8_SA(b, h) (((b) * 2 + (h)) * HTB)
#define PG8_SB(b, h) ((4 + (b) * 2 + (h)) * HTB)
#define PG8_STAGE(bufoff, gbase, voff) do { _Pragma("unroll") for (int _i = 0; _i < 2; ++_i) \
        __builtin_amdgcn_global_load_lds((const unsigned*)((const char*)(gbase) + (voff)[_i]), (PG8_LAS unsigned*)(lds + (bufoff) + ldsw + _i * 8192), 16, 0, 0); } while (0)
#define PG8_LDA(dst, b, h) do { _Pragma("unroll") for (int m = 0; m < 4; ++m) _Pragma("unroll") for (int k = 0; k < 2; ++k) dst[m][k] = *(const PG8_LAS bf16x8*)(lds + PG8_SA(b, h) + aoff + m * 2048 + k * 1024); } while (0)
#define PG8_LDB(dst, b, h) do { _Pragma("unroll") for (int n = 0; n < 2; ++n) _Pragma("unroll") for (int k = 0; k < 2; ++k) dst[n][k] = *(const PG8_LAS bf16x8*)(lds + PG8_SB(b, h) + boff + n * 2048 + k * 1024); } while (0)
#define PG8_MMA(ai, bj, At, Bt) do { __builtin_amdgcn_s_setprio(1); _Pragma("unroll") for (int m = 0; m < 4; ++m) _Pragma("unroll") for (int n = 0; n < 2; ++n) _Pragma("unroll") for (int k = 0; k < 2; ++k) \
        acc[ai][bj][m][n] = __builtin_amdgcn_mfma_f32_16x16x32_bf16(Bt[n][k], At[m][k], acc[ai][bj][m][n], 0, 0, 0); __builtin_amdgcn_s_setprio(0); } while (0)
#define PG8_WAIT_V(n) asm volatile("s_waitcnt vmcnt(" #n ")" ::: "memory")
#define PG8_WAIT_L(n) asm volatile("s_waitcnt lgkmcnt(" #n ")" ::: "memory")
#define PG8_BAR __builtin_amdgcn_s_barrier()
#define PG8_SCHED __builtin_amdgcn_sched_barrier(0)
    Unit cur, nxt; int ui = 0;
    if (!S.next(0, cur)) return;
    f32x4 acc[2][2][4][2];
#pragma unroll
    for (int a = 0; a < 2; ++a)
#pragma unroll
        for (int b = 0; b < 2; ++b)
#pragma unroll
            for (int m = 0; m < 4; ++m)
#pragma unroll
                for (int n = 0; n < 2; ++n) acc[a][b][m][n] = (f32x4){0.f, 0.f, 0.f, 0.f};
    bf16x8 At[4][2], B0[2][2], B1[2][2];
    const char* cA = (const char*)g.A + (size_t)cur.pm * tstep; const char* cB = (const char*)g.Bt + (size_t)cur.pn * tstep;
    S.a_ready(cur);
    if constexpr (SP2) {
        PG8_STAGE(PG8_SB(0, 0), cB, voffB); PG8_STAGE(PG8_SB(0, 1), cB + hstep, voffB); PG8_STAGE(PG8_SA(0, 0), cA, voffA); PG8_STAGE(PG8_SA(0, 1), cA + hstep, voffA);
        if (wr == 1) PG8_BAR;
        PG8_WAIT_V(2); PG8_BAR;
        PG8_STAGE(PG8_SB(1, 0), cB + kstep, voffB); PG8_STAGE(PG8_SA(1, 0), cA + kstep, voffA); PG8_STAGE(PG8_SB(1, 1), cB + hstep + kstep, voffB);
        PG8_WAIT_V(6); PG8_BAR;
    } else {
        PG8_STAGE(PG8_SB(0, 0), cB, voffB); PG8_STAGE(PG8_SA(0, 0), cA, voffA); PG8_STAGE(PG8_SB(0, 1), cB + hstep, voffB); PG8_STAGE(PG8_SA(0, 1), cA + hstep, voffA);
        if (wr == 1) PG8_BAR;
        PG8_WAIT_V(4); PG8_BAR;
        PG8_STAGE(PG8_SB(1, 0), cB + kstep, voffB); PG8_STAGE(PG8_SA(1, 0), cA + kstep, voffA); PG8_STAGE(PG8_SB(1, 1), cB + hstep + kstep, voffB);
        PG8_WAIT_V(6); PG8_BAR;
    }
    for (;;) {
        const bool has_next = S.next(ui + 1, nxt);
        const char* nA = has_next ? (const char*)g.A + (size_t)nxt.pm * tstep : cA; const char* nB = has_next ? (const char*)g.Bt + (size_t)nxt.pn * tstep : cB;
        for (int t = 0; t < nt; t += 2) {
            const bool last = (t == nt - 2);
            const char* a1 = cA + (size_t)(t + 1) * kstep;
            const char* a2 = last ? nA : cA + (size_t)(t + 2) * kstep; const char* b2 = last ? nB : cB + (size_t)(t + 2) * kstep;
            const char* a3 = a2 + kstep; const char* b3 = b2 + kstep;
            if (last && has_next) S.a_ready(nxt);
            if constexpr (SP2) {
            PG8_LDB(B0, 0, 0); PG8_LDB(B1, 0, 1); PG8_SCHED; PG8_LDA(At, 0, 0); PG8_STAGE(PG8_SA(1, 1), a1 + hstep, voffA);
            PG8_WAIT_V(8); PG8_WAIT_L(0); PG8_BAR; PG8_MMA(0, 0, At, B0); PG8_MMA(0, 1, At, B1); PG8_BAR; PG8_SCHED;
            PG8_LDA(At, 0, 1); PG8_STAGE(PG8_SB(0, 0), b2, voffB); PG8_STAGE(PG8_SB(0, 1), b2 + hstep, voffB); PG8_STAGE(PG8_SA(0, 0), a2, voffA);
            PG8_WAIT_V(8); PG8_WAIT_L(0); PG8_BAR; PG8_MMA(1, 0, At, B0); PG8_MMA(1, 1, At, B1); PG8_BAR; PG8_SCHED;
            PG8_LDB(B0, 1, 0); PG8_LDB(B1, 1, 1); PG8_SCHED; PG8_LDA(At, 1, 0); PG8_STAGE(PG8_SA(0, 1), a2 + hstep, voffA);
            PG8_WAIT_V(8); PG8_WAIT_L(0); PG8_BAR; PG8_MMA(0, 0, At, B0); PG8_MMA(0, 1, At, B1); PG8_BAR; PG8_SCHED;
            PG8_LDA(At, 1, 1); PG8_STAGE(PG8_SB(1, 0), b3, voffB); PG8_STAGE(PG8_SB(1, 1), b3 + hstep, voffB); PG8_STAGE(PG8_SA(1, 0), a3, voffA);
            PG8_WAIT_V(8); PG8_WAIT_L(0); PG8_BAR; PG8_MMA(1, 0, At, B0); PG8_MMA(1, 1, At, B1); PG8_BAR; PG8_SCHED;
            } else {
            PG8_LDB(B0, 0, 0); PG8_SCHED; PG8_LDA(At, 0, 0); PG8_STAGE(PG8_SA(1, 1), a1 + hstep, voffA);
            PG8_WAIT_L(8); PG8_BAR; PG8_WAIT_L(0); PG8_MMA(0, 0, At, B0); PG8_BAR; PG8_SCHED;
            PG8_LDB(B1, 0, 1); PG8_STAGE(PG8_SB(0, 0), b2, voffB);
            PG8_BAR; PG8_WAIT_L(0); PG8_MMA(0, 1, At, B1); PG8_BAR;
            PG8_LDA(At, 0, 1); PG8_STAGE(PG8_SA(0, 0), a2, voffA);
            PG8_BAR; PG8_WAIT_L(0); PG8_MMA(1, 0, At, B0); PG8_BAR; PG8_SCHED;
            PG8_STAGE(PG8_SB(0, 1), b2 + hstep, voffB);
            PG8_WAIT_V(6); PG8_BAR; PG8_MMA(1, 1, At, B1); PG8_BAR;
            PG8_LDB(B0, 1, 0); PG8_SCHED; PG8_LDA(At, 1, 0); PG8_STAGE(PG8_SA(0, 1), a2 + hstep, voffA);
            PG8_WAIT_L(8); PG8_BAR; PG8_WAIT_L(0); PG8_MMA(0, 0, At, B0); PG8_BAR; PG8_SCHED;
            PG8_LDB(B1, 1, 1); PG8_STAGE(PG8_SB(1, 0), b3, voffB);
            PG8_BAR; PG8_WAIT_L(0); PG8_MMA(0, 1, At, B1); PG8_BAR;
            PG8_LDA(At, 1, 1); PG8_STAGE(PG8_SA(1, 0), a3, voffA);
            PG8_BAR; PG8_WAIT_L(0); PG8_MMA(1, 0, At, B0); PG8_BAR; PG8_SCHED;
            PG8_STAGE(PG8_SB(1, 1), b3 + hstep, voffB);
            PG8_WAIT_V(6); PG8_BAR; PG8_MMA(1, 1, At, B1); PG8_BAR;
            }
        }
        if constexpr (ALIGN_EPI) { if (wr == 0) PG8_BAR; }
        if constexpr (!Epi::AFTER_DRAIN) { E(acc, cur, wr, wc, fr, fq); S.done(cur); }
        if (!has_next) break;
#pragma unroll
        for (int a = 0; a < 2; ++a)
#pragma unroll
            for (int b = 0; b < 2; ++b)
#pragma unroll
                for (int m = 0; m < 4; ++m)
#pragma unroll
                    for (int n = 0; n < 2; ++n) acc[a][b][m][n] = (f32x4){0.f, 0.f, 0.f, 0.f};
        cur = nxt; cA = nA; cB = nB; ++ui;
        if constexpr (ALIGN_EPI) { if (wr == 1) PG8_BAR; }
    }
    PG8_WAIT_V(0);
    if constexpr (!ALIGN_EPI) { if (wr == 0) PG8_BAR; }
    PG8_BAR;
    if constexpr (Epi::AFTER_DRAIN) { E.fused(acc, cur, wr, wc, fr, fq, lds, wid, lane); S.done(cur); }
#undef PG8_SA
#undef PG8_SB
#undef PG8_STAGE
#undef PG8_LDA
#undef PG8_LDB
#undef PG8_MMA
#undef PG8_WAIT_V
#undef PG8_WAIT_L
#undef PG8_BAR
#undef PG8_SCHED
}
}

#define LAS __attribute__((address_space(3)))
typedef unsigned short bf16_t;
typedef short bf16x8 __attribute__((ext_vector_type(8)));
typedef float f32x4 __attribute__((ext_vector_type(4)));
typedef float f32x16 __attribute__((ext_vector_type(16)));
typedef unsigned u32x4 __attribute__((ext_vector_type(4)));
typedef unsigned u32x2 __attribute__((ext_vector_type(2)));
struct Args { const float* in[20]; float* out; unsigned char* ws; int st_lo, st_hi; };

struct Frame {
    LAS unsigned char* lds; int tid, lane, wave, G;
    const float* const* in; float* out; unsigned char* ws;
};
__device__ __forceinline__ float wave_sum(float v) {
#pragma unroll
    for (int o = 1; o < 64; o <<= 1) v += __shfl_xor(v, o);
    return v;
}
__device__ __forceinline__ unsigned pk2(float lo, float hi) { return pg8::cvt_pk_bf16(lo, hi); }
__device__ __forceinline__ float bflo(unsigned w) { return __uint_as_float(w << 16); }
__device__ __forceinline__ float bfhi(unsigned w) { return __uint_as_float(w & 0xffff0000u); }
__device__ __forceinline__ float bf2f(bf16_t b) { return __uint_as_float(((unsigned)b) << 16); }

__device__ __forceinline__ void tr_load(float (&v)[32], const float* W, int N, int k0, int n0, int lane, const float* gain) {
#pragma unroll
    for (int i = 0; i < 32; ++i) { const int kk = 2 * i + (lane >> 5); v[i] = W[(size_t)(k0 + kk) * N + n0 + (lane & 31)] * (gain ? gain[k0 + kk] : 1.f); }
}
__device__ __forceinline__ void tr_finish(const float (&v)[32], int K, bf16_t* dst_row0  , int k0, LAS float* scr, int lane) {
#pragma unroll
    for (int i = 0; i < 32; ++i) { const int kk = 2 * i + (lane >> 5); scr[kk * 33 + (lane & 31)] = v[i]; }
    asm volatile("s_waitcnt lgkmcnt(0)" ::: "memory");
    const int c = lane & 7;
#pragma unroll
    for (int j = 0; j < 4; ++j) { const int n = (lane >> 3) + 8 * j; const LAS float* s = scr + (8 * c) * 33 + n;
        u32x4 o; o.x = pk2(s[0 * 33], s[1 * 33]); o.y = pk2(s[2 * 33], s[3 * 33]); o.z = pk2(s[4 * 33], s[5 * 33]); o.w = pk2(s[6 * 33], s[7 * 33]);
        *(u32x4*)(dst_row0 + (size_t)n * K + k0 + 8 * c) = o; }
    asm volatile("s_waitcnt lgkmcnt(0)" ::: "memory");
}
__device__ __forceinline__ size_t wdst(int mat, int n0) {
    switch (mat) {
    case 0: {
        int r;
        if (n0 < 1024) r = n0;
        else if (n0 < 2048) { const int j = n0 - 1024; r = 1024 + (j >> 7) * 256 + (j & 127); }
        else if (n0 < 3072) { const int j = n0 - 2048; r = 1024 + (j >> 7) * 256 + 128 + (j & 127); }
        else if (n0 < 3744) r = 5120 + (n0 - 3072);
        else r = 3072 + (n0 - 3744);
        return W_IN + (size_t)r * D; }
    case 1: { const int g = n0 >> 5, h = g / 3, part = g % 3; const int r = part < 2 ? h * 64 + part * 32 : 1024 + h * 32; return W_UQ + (size_t)r * QL; }
    case 2: { const int h = n0 >> 7, e = n0 & 127; return e < 64 ? W_UK + (size_t)(h * 64 + e) * KVL : W_UV + (size_t)(h * 64 + e - 64) * KVL; }
    case 3: return W_CONV + (size_t)n0 * D;
    case 4: return W_ATTN + (size_t)n0 * D;
    case 5: return W_MERGE + (size_t)n0 * D;
    case 6: { int r; if (n0 < DFF) r = (n0 >> 7) * 256 + (n0 & 127); else { const int j = n0 - DFF; r = (j >> 7) * 256 + 128 + (j & 127); } return W_GU + (size_t)r * D; }
    default: return W_DOWN + (size_t)n0 * DFF;
    }
}
__device__ __forceinline__ void convert_weights(Frame& F, int l) {
    LAS float* scr = (LAS float*)(F.lds + F.wave * 16384);
    bf16_t* Wb = (bf16_t*)(F.ws + WS_W);
    const int gw = blockIdx.x * NWAVES + F.wave, NGW = F.G * NWAVES;
    constexpr int I0 = 16 * (DIN / 32), I1 = 6 * 48, I2 = 4 * 64, I3 = 16 * 32, I6 = 16 * (2 * DFF / 32), I7 = 44 * 32;
    constexpr int NIT = I0 + I1 + I2 + 3 * I3 + I6 + I7;
#define CW_DECODE(it_, K_, N_, src_, gain_, dst_, k0_, n0_) do { int r = (it_), mat; gain_ = nullptr; \
        if (r < I0) { mat = 0; K_ = D; N_ = DIN; src_ = F.in[5] + (size_t)l * D * DIN; gain_ = F.in[6] + l * D; } \
        else if ((r -= I0) < I1) { mat = 1; K_ = QL; N_ = 1536; src_ = F.in[10] + (size_t)l * QL * 1536; } \
        else if ((r -= I1) < I2) { mat = 2; K_ = KVL; N_ = 2048; src_ = F.in[11] + (size_t)l * KVL * 2048; } \
        else if ((r -= I2) < I3) { mat = 3; K_ = D; N_ = D; src_ = F.in[13] + (size_t)l * D * D; } \
        else if ((r -= I3) < I3) { mat = 4; K_ = D; N_ = D; src_ = F.in[14] + (size_t)l * D * D; } \
        else if ((r -= I3) < I3) { mat = 5; K_ = D; N_ = D; src_ = F.in[15] + (size_t)l * D * D; } \
        else if ((r -= I3) < I6) { mat = 6; K_ = D; N_ = 2 * DFF; src_ = F.in[18] + (size_t)l * D * 2 * DFF; gain_ = F.in[16] + l * D; } \
        else { r -= I6; mat = 7; K_ = DFF; N_ = D; src_ = F.in[19] + (size_t)l * DFF * D; } \
        const int nblk = N_ / 32, kb = r / nblk, nb = r % nblk; k0_ = kb * 64; n0_ = nb * 32; dst_ = Wb + wdst(mat, nb * 32); } while (0)
    {
        float va[32], vb[32];
        int it = gw, Ka = 0, Na = 0, k0a = 0, n0a = 0, Kb = 0, Nb = 0, k0b = 0, n0b = 0; const float* sa = nullptr; const float* ga = nullptr; bf16_t* da = nullptr; const float* sb = nullptr; const float* gb = nullptr; bf16_t* db = nullptr;
        if (it < NIT) { CW_DECODE(it, Ka, Na, sa, ga, da, k0a, n0a); tr_load(va, sa, Na, k0a, n0a, F.lane, ga); }
        while (it < NIT) {
            const int itb = it + NGW;
            if (itb < NIT) { CW_DECODE(itb, Kb, Nb, sb, gb, db, k0b, n0b); tr_load(vb, sb, Nb, k0b, n0b, F.lane, gb); }
            tr_finish(va, Ka, da, k0a, scr, F.lane);
            if (itb >= NIT) break;
            const int itc = itb + NGW;
            if (itc < NIT) { CW_DECODE(itc, Ka, Na, sa, ga, da, k0a, n0a); tr_load(va, sa, Na, k0a, n0a, F.lane, ga); }
            tr_finish(vb, Kb, db, k0b, scr, F.lane);
            it = itc;
        }
    }
#undef CW_DECODE
    for (int i = (blockIdx.x * 512 + F.tid); i < (DINP - DIN) * D / 8; i += F.G * 512) *(u32x4*)(Wb + W_IN + (size_t)DIN * D + (size_t)i * 8) = (u32x4){0u, 0u, 0u, 0u};
}
__device__ __forceinline__ void build_rope(Frame& F) {
    float* rope = (float*)(F.ws + WS_ROPE);
    for (int i = blockIdx.x * 512 + F.tid; i < SKEYS * 16; i += F.G * 512) {
        const int pos = i >> 4, f = i & 15;
        const int a = f & 3; const double q = a == 0 ? 1.0 : (a == 1 ? 0.5623413251903491 : (a == 2 ? 0.31622776601683794 : 0.1778279410038923));
        const int bq = f >> 2; const double p10 = bq == 0 ? 1.0 : (bq == 1 ? 0.1 : (bq == 2 ? 0.01 : 0.001));
        const double rev = (double)pos * (q * p10) * 0.15915494309189535;
        const float fr = (float)(rev - __builtin_rint(rev));
        rope[pos * 32 + f] = __builtin_amdgcn_cosf(fr); rope[pos * 32 + 16 + f] = __builtin_amdgcn_sinf(fr);
    }
}
__device__ __forceinline__ const float* xrow_in(Frame& F, int m) { return m < TP ? F.in[0] + (size_t)m * D : F.in[1] + (size_t)(m - TP) * D; }
__device__ __forceinline__ void store_norm_bf16(bf16_t* orow, const f32x4 (&v)[4], float rstd, const float* g, int lane) {
#pragma unroll
    for (int j = 0; j < 4; ++j) { const f32x4 gg = *(const f32x4*)(g + 4 * lane + 256 * j);
        u32x2 w; w.x = pk2(v[j][0] * rstd * gg[0], v[j][1] * rstd * gg[1]); w.y = pk2(v[j][2] * rstd * gg[2], v[j][3] * rstd * gg[3]);
        *(u32x2*)(orow + 4 * lane + 256 * j) = w; }
}
__device__ __forceinline__ float sumsq16(const f32x4 (&v)[4]) { float s = 0.f;
#pragma unroll
    for (int j = 0; j < 4; ++j) s += (v[j][0] * v[j][0] + v[j][1] * v[j][1]) + (v[j][2] * v[j][2] + v[j][3] * v[j][3]);
    return wave_sum(s); }
__device__ __forceinline__ void store_bf16_row(bf16_t* orow, const f32x4 (&v)[4], int lane) {
#pragma unroll
    for (int j = 0; j < 4; ++j) { u32x2 w; w.x = pk2(v[j][0], v[j][1]); w.y = pk2(v[j][2], v[j][3]); *(u32x2*)(orow + 4 * lane + 256 * j) = w; }
}
__device__ __forceinline__ void load_bf16_row(f32x4 (&v)[4], const bf16_t* irow, int lane) {
#pragma unroll
    for (int j = 0; j < 4; ++j) { const u32x2 w = *(const u32x2*)(irow + 4 * lane + 256 * j); v[j] = (f32x4){bflo(w.x), bfhi(w.x), bflo(w.y), bfhi(w.y)}; }
}
constexpr int RB = 4;
__device__ __forceinline__ void phase_norm_in(Frame& F) {
    bf16_t* XA = (bf16_t*)(F.out + O_Y); float* RSA = (float*)(F.ws + WS_RSA);
    const int gw = blockIdx.x * NWAVES + F.wave, NGW = F.G * NWAVES;
    for (int m0 = gw; m0 < T; m0 += RB * NGW) { f32x4 v[RB][4];
#pragma unroll
        for (int q = 0; q < RB; ++q) { const int m = m0 + q * NGW; if (m < T) { const float* xr = xrow_in(F, m);
#pragma unroll
            for (int j = 0; j < 4; ++j) v[q][j] = *(const f32x4*)(xr + 4 * F.lane + 256 * j); } }
#pragma unroll
        for (int q = 0; q < RB; ++q) { const int m = m0 + q * NGW; if (m < T) {
            const float rstd = rsqrtf(sumsq16(v[q]) * (1.f / D) + EPS);
            store_bf16_row(XA + (size_t)m * D, v[q], F.lane); if (F.lane == 0) RSA[m] = rstd; } } }
}
__device__ __forceinline__ void phase_h(Frame& F, int l) {
    const bf16_t* XA = (const bf16_t*)(F.out + O_Y); bf16_t* XB = (bf16_t*)(F.ws + WS_R2); float* RSB = (float*)(F.ws + WS_RSB);
    const bf16_t* Mo = (const bf16_t*)(F.ws + WS_R3 + U1);
    const float* gp = F.in[7] + l * D;
    f32x4 gg[4];
#pragma unroll
    for (int j = 0; j < 4; ++j) gg[j] = *(const f32x4*)(gp + 4 * F.lane + 256 * j);
    const int gw = blockIdx.x * NWAVES + F.wave, NGW = F.G * NWAVES;
    for (int m0 = gw; m0 < T; m0 += RB * NGW) { f32x4 x[RB][4], mm[RB][4];
#pragma unroll
        for (int q = 0; q < RB; ++q) { const int m = m0 + q * NGW; if (m < T) { load_bf16_row(x[q], XA + (size_t)m * D, F.lane); load_bf16_row(mm[q], Mo + (size_t)m * D, F.lane); } }
#pragma unroll
        for (int q = 0; q < RB; ++q) { const int m = m0 + q * NGW; if (m < T) {
            const float rm = rsqrtf(sumsq16(mm[q]) * (1.f / D) + EPS);
#pragma unroll
            for (int j = 0; j < 4; ++j) x[q][j] = x[q][j] + mm[q][j] * rm * gg[j];
            const float rstd = rsqrtf(sumsq16(x[q]) * (1.f / D) + EPS);
            store_bf16_row(XB + (size_t)m * D, x[q], F.lane); if (F.lane == 0) RSB[m] = rstd; } } }
}
__device__ __forceinline__ void phase_k(Frame& F, int l) {
    bf16_t* XA = (bf16_t*)(F.out + O_Y); const bf16_t* XB = (const bf16_t*)(F.ws + WS_R2); float* RSA = (float*)(F.ws + WS_RSA);
    const bf16_t* Fo = (const bf16_t*)(F.ws + WS_R1); float* Y = F.out + O_Y;
    const float* gp = F.in[17] + l * D;
    f32x4 gg[4];
#pragma unroll
    for (int j = 0; j < 4; ++j) gg[j] = *(const f32x4*)(gp + 4 * F.lane + 256 * j);
    const int gw = blockIdx.x * NWAVES + F.wave, NGW = F.G * NWAVES;
    for (int m0 = gw; m0 < T; m0 += RB * NGW) { f32x4 x[RB][4], mm[RB][4];
#pragma unroll
        for (int q = 0; q < RB; ++q) { const int m = m0 + q * NGW; if (m < T) { load_bf16_row(x[q], XB + (size_t)m * D, F.lane); load_bf16_row(mm[q], Fo + (size_t)m * D, F.lane); } }
#pragma unroll
        for (int q = 0; q < RB; ++q) { const int m = m0 + q * NGW; if (m < T) {
            const float rm = rsqrtf(sumsq16(mm[q]) * (1.f / D) + EPS);
#pragma unroll
            for (int j = 0; j < 4; ++j) x[q][j] = x[q][j] + mm[q][j] * rm * gg[j];
            if (l == 0) { const float rstd = rsqrtf(sumsq16(x[q]) * (1.f / D) + EPS); store_bf16_row(XA + (size_t)m * D, x[q], F.lane); if (F.lane == 0) RSA[m] = rstd; }
            else {
#pragma unroll
                for (int j = 0; j < 4; ++j) *(f32x4*)(Y + (size_t)m * D + 4 * F.lane + 256 * j) = x[q][j]; } } } }
}
__device__ __forceinline__ void ld16bf(float (&d)[16], const bf16_t* p) {
    const u32x4 a = *(const u32x4*)p, b = *(const u32x4*)(p + 8);
    d[0] = bflo(a.x); d[1] = bfhi(a.x); d[2] = bflo(a.y); d[3] = bfhi(a.y); d[4] = bflo(a.z); d[5] = bfhi(a.z); d[6] = bflo(a.w); d[7] = bfhi(a.w);
    d[8] = bflo(b.x); d[9] = bfhi(b.x); d[10] = bflo(b.y); d[11] = bfhi(b.y); d[12] = bflo(b.z); d[13] = bfhi(b.z); d[14] = bflo(b.w); d[15] = bfhi(b.w);
}
__device__ __forceinline__ void cvt16(float (&d)[16], const u32x4 a, const u32x4 b) {
    d[0] = bflo(a.x); d[1] = bfhi(a.x); d[2] = bflo(a.y); d[3] = bfhi(a.y); d[4] = bflo(a.z); d[5] = bfhi(a.z); d[6] = bflo(a.w); d[7] = bfhi(a.w);
    d[8] = bflo(b.x); d[9] = bfhi(b.x); d[10] = bflo(b.y); d[11] = bfhi(b.y); d[12] = bflo(b.z); d[13] = bfhi(b.z); d[14] = bflo(b.w); d[15] = bfhi(b.w);
}
__device__ __forceinline__ void ld16f(float (&d)[16], const float* p) {
#pragma unroll
    for (int j = 0; j < 4; ++j) { const f32x4 a = *(const f32x4*)(p + 4 * j); d[4 * j] = a[0]; d[4 * j + 1] = a[1]; d[4 * j + 2] = a[2]; d[4 * j + 3] = a[3]; }
}
__device__ __forceinline__ void phase_c(Frame& F, int l) {
    const bf16_t* Bg = (const bf16_t*)(F.ws + WS_BG); const bf16_t* U = (const bf16_t*)(F.ws + WS_U); const bf16_t* LAT = (const bf16_t*)(F.ws + WS_LAT);
    bf16_t* YAin = (bf16_t*)(F.ws + WS_R0); bf16_t* QLn = (bf16_t*)(F.ws + WS_QLN); bf16_t* Call = (bf16_t*)(F.ws + WS_CALL); bf16_t* KR = (bf16_t*)(F.ws + WS_KR);
    const float* rope = (const float*)(F.ws + WS_ROPE);
    const int lane = F.lane;
    { const float* cc = F.in[3] + (size_t)l * DB * PAST * KVL; const float* ck = F.in[4] + (size_t)l * DB * PAST * RP;
      for (int i = blockIdx.x * 512 + F.tid; i < DB * PAST * KVL / 8; i += F.G * 512) { const int e = i * 8, b = e / (PAST * KVL), r = e % (PAST * KVL);
          const f32x4 a = *(const f32x4*)(cc + e), c = *(const f32x4*)(cc + e + 4);
          *(u32x4*)(Call + (size_t)(TP + b * SKEYS) * KVL + r) = (u32x4){pk2(a[0], a[1]), pk2(a[2], a[3]), pk2(c[0], c[1]), pk2(c[2], c[3])}; }
      for (int i = blockIdx.x * 512 + F.tid; i < DB * PAST * RP / 8; i += F.G * 512) { const int e = i * 8, b = e / (PAST * RP), r = e % (PAST * RP);
          const f32x4 a = *(const f32x4*)(ck + e), c = *(const f32x4*)(ck + e + 4);
          *(u32x4*)(KR + (size_t)(TP + b * SKEYS) * RP + r) = (u32x4){pk2(a[0], a[1]), pk2(a[2], a[3]), pk2(c[0], c[1]), pk2(c[2], c[3])}; } }
    float cw0[16], cw1[16], cw2[16];
    ld16f(cw0, F.in[12] + (size_t)l * 3 * D + 16 * lane); ld16f(cw1, F.in[12] + (size_t)l * 3 * D + D + 16 * lane); ld16f(cw2, F.in[12] + (size_t)l * 3 * D + 2 * D + 16 * lane);
    float gq[8], gk[8];
#pragma unroll
    for (int i = 0; i < 8; ++i) { gq[i] = lane < 48 ? F.in[8][l * QL + 8 * lane + i] : 0.f; gk[i] = lane < 32 ? F.in[9][l * KVL + 8 * lane + i] : 0.f; }
    const int gw = blockIdx.x * NWAVES + F.wave, NGW = F.G * NWAVES;
    for (int run = gw; run < T / 8; run += NGW) {
        const int t0 = run * 8; const bool smp = t0 >= TP;
        const int b = smp ? (t0 - TP) / DSEQ : t0 / SEQ, s0 = smp ? (t0 - TP) % DSEQ : t0 % SEQ, slen = smp ? DSEQ : SEQ;
        float up1[16], up2[16];
        if (s0 == 0) {
            if (smp) { const float* hs = F.in[2] + ((size_t)(l * DB + b) * 2) * D + 16 * lane; ld16f(up2, hs); ld16f(up1, hs + D); }
            else {
#pragma unroll
                for (int i = 0; i < 16; ++i) { up1[i] = 0.f; up2[i] = 0.f; } }
        } else { ld16bf(up1, U + (size_t)(t0 - 1) * D + 16 * lane); ld16bf(up2, U + (size_t)(t0 - 2) * D + 16 * lane); }
#pragma unroll 1
        for (int i4 = 0; i4 < 8; i4 += 2) {
            u32x4 rU[2][2], rB[2][2], rQ[2], rC[2]; unsigned rR1[2], rR2[2];
#pragma unroll
            for (int q = 0; q < 2; ++q) { const int t = t0 + i4 + q; const bf16_t* lat = LAT + (size_t)t * LATP;
                rU[q][0] = *(const u32x4*)(U + (size_t)t * D + 16 * lane); rU[q][1] = *(const u32x4*)(U + (size_t)t * D + 16 * lane + 8);
                rB[q][0] = *(const u32x4*)(Bg + (size_t)t * D + 16 * lane); rB[q][1] = *(const u32x4*)(Bg + (size_t)t * D + 16 * lane + 8);
                rQ[q] = (u32x4){0u, 0u, 0u, 0u}; rC[q] = rQ[q]; rR1[q] = 0u; rR2[q] = 0u;
                if (lane < 48) rQ[q] = *(const u32x4*)(lat + 8 * lane);
                if (lane < 32) rC[q] = *(const u32x4*)(lat + QL + 8 * lane);
                if (lane < 16) { rR1[q] = lat[QL + KVL + lane]; rR2[q] = lat[QL + KVL + 16 + lane]; } }
#pragma unroll
            for (int q = 0; q < 2; ++q) {
            const int t = t0 + i4 + q, s = s0 + i4 + q;
            float uc[16], bg[16], y[16];
            cvt16(uc, rU[q][0], rU[q][1]); cvt16(bg, rB[q][0], rB[q][1]);
#pragma unroll
            for (int i = 0; i < 16; ++i) y[i] = bg[i] * (cw0[i] * up2[i] + cw1[i] * up1[i] + cw2[i] * uc[i]);
            *(u32x4*)(YAin + (size_t)t * D + 16 * lane) = (u32x4){pk2(y[0], y[1]), pk2(y[2], y[3]), pk2(y[4], y[5]), pk2(y[6], y[7])};
            *(u32x4*)(YAin + (size_t)t * D + 16 * lane + 8) = (u32x4){pk2(y[8], y[9]), pk2(y[10], y[11]), pk2(y[12], y[13]), pk2(y[14], y[15])};
            if (s >= slen - 2) {
                float* oc = smp ? F.out + O_CONV_S + ((size_t)(l * DB + b) * 2 + (s - (slen - 2))) * D : F.out + O_CONV_P + ((size_t)(l * NB + b) * 2 + (s - (slen - 2))) * D;
#pragma unroll
                for (int j = 0; j < 4; ++j) *(f32x4*)(oc + 16 * lane + 4 * j) = (f32x4){uc[4 * j], uc[4 * j + 1], uc[4 * j + 2], uc[4 * j + 3]};
            }
#pragma unroll
            for (int i = 0; i < 16; ++i) { up2[i] = up1[i]; up1[i] = uc[i]; }
            const size_t krow = smp ? (size_t)(TP + b * SKEYS + PAST + s) : (size_t)t;
            const int pos = smp ? PAST + s : s;
            { float v[8]; const u32x4 w = rQ[q];
              v[0] = bflo(w.x); v[1] = bfhi(w.x); v[2] = bflo(w.y); v[3] = bfhi(w.y); v[4] = bflo(w.z); v[5] = bfhi(w.z); v[6] = bflo(w.w); v[7] = bfhi(w.w);
              float ss = 0.f;
#pragma unroll
              for (int i = 0; i < 8; ++i) ss += v[i] * v[i];
              const float r = rsqrtf(wave_sum(ss) * (1.f / QL) + EPS);
              if (lane < 48) *(u32x4*)(QLn + (size_t)t * QL + 8 * lane) = (u32x4){pk2(v[0] * r * gq[0], v[1] * r * gq[1]), pk2(v[2] * r * gq[2], v[3] * r * gq[3]), pk2(v[4] * r * gq[4], v[5] * r * gq[5]), pk2(v[6] * r * gq[6], v[7] * r * gq[7])}; }
            { float v[8]; const u32x4 w = rC[q];
              v[0] = bflo(w.x); v[1] = bfhi(w.x); v[2] = bflo(w.y); v[3] = bfhi(w.y); v[4] = bflo(w.z); v[5] = bfhi(w.z); v[6] = bflo(w.w); v[7] = bfhi(w.w);
              float ss = 0.f;
#pragma unroll
              for (int i = 0; i < 8; ++i) ss += v[i] * v[i];
              const float r = rsqrtf(wave_sum(ss) * (1.f / KVL) + EPS);
              if (lane < 32) {
#pragma unroll
                  for (int i = 0; i < 8; ++i) v[i] = v[i] * r * gk[i];
                  float* oc = smp ? F.out + O_CKV_S + ((size_t)l * TS + (t - TP)) * KVL : F.out + O_CKV_P + ((size_t)l * TP + t) * KVL;
                  *(f32x4*)(oc + 8 * lane) = (f32x4){v[0], v[1], v[2], v[3]}; *(f32x4*)(oc + 8 * lane + 4) = (f32x4){v[4], v[5], v[6], v[7]};
                  *(u32x4*)(Call + krow * KVL + 8 * lane) = (u32x4){pk2(v[0], v[1]), pk2(v[2], v[3]), pk2(v[4], v[5]), pk2(v[6], v[7])}; } }
            if (lane < 16) { const float x1 = __uint_as_float(rR1[q] << 16), x2 = __uint_as_float(rR2[q] << 16); const float c = rope[pos * 32 + lane], sn = rope[pos * 32 + 16 + lane];
                const float o1 = x1 * c - x2 * sn, o2 = x1 * sn + x2 * c;
                float* ok = smp ? F.out + O_KR_S + ((size_t)l * TS + (t - TP)) * RP : F.out + O_KR_P + ((size_t)l * TP + t) * RP;
                ok[lane] = o1; ok[16 + lane] = o2;
                KR[krow * RP + lane] = (bf16_t)(pk2(o1, o1) & 0xffffu); KR[krow * RP + 16 + lane] = (bf16_t)(pk2(o2, o2) & 0xffffu); }
            }
        }
    }
}
namespace att {
constexpr int KP = 208, VP = 144, KB = 64 * KP, VB = 64 * VP, BUFB = KB + VB;
struct Ptrs { const bf16_t *Qn, *Qr, *Kn, *Vt, *KR; bf16_t* ATT; const float* rope; };
__device__ __forceinline__ float fmax3(float a, float b, float c) { return fmaxf(fmaxf(a, b), c); }
__device__ __forceinline__ void tile_core(const bf16x8 (&kf)[2][6], const bf16x8 (&vf)[2][4], const bf16x8 (&qf)[6], f32x16& negm, float& l, f32x16 (&o)[2], int nvalid, int hi, bool first) {
    f32x16 p0 = __builtin_amdgcn_mfma_f32_32x32x16_bf16(kf[0][0], qf[0], negm, 0, 0, 0), p1 = __builtin_amdgcn_mfma_f32_32x32x16_bf16(kf[1][0], qf[0], negm, 0, 0, 0);
#pragma unroll
    for (int d0 = 1; d0 < 6; ++d0) { p0 = __builtin_amdgcn_mfma_f32_32x32x16_bf16(kf[0][d0], qf[d0], p0, 0, 0, 0); p1 = __builtin_amdgcn_mfma_f32_32x32x16_bf16(kf[1][d0], qf[d0], p1, 0, 0, 0); }
    if (nvalid < 64) {
#pragma unroll
        for (int r = 0; r < 16; ++r) { const int kv = (r & 3) + 8 * (r >> 2) + 4 * hi; if (kv >= nvalid) p0[r] = -1e30f; if (kv + 32 >= nvalid) p1[r] = -1e30f; }
    }
    float rm = fmax3(p0[0], p0[1], p1[0]);
#pragma unroll
    for (int r = 1; r < 16; ++r) rm = fmax3(rm, p0[r], p1[r]);
    rm = fmaxf(rm, __shfl_xor(rm, 32));
    if (first || __any(rm > 8.0f)) { const float d = first ? rm : fmaxf(rm, 0.f), f = __builtin_amdgcn_exp2f(-d); l *= f;
#pragma unroll
        for (int r = 0; r < 16; ++r) { o[0][r] *= f; o[1][r] *= f; p0[r] -= d; p1[r] -= d; negm[r] -= d; } }
    float s = 0.f;
#pragma unroll
    for (int r = 0; r < 16; ++r) { p0[r] = __builtin_amdgcn_exp2f(p0[r]); p1[r] = __builtin_amdgcn_exp2f(p1[r]); s += p0[r] + p1[r]; }
    l += s;
    bf16x8 pa[4];
    { u32x4 w;
      w = (u32x4){pk2(p0[0], p0[1]), pk2(p0[2], p0[3]), pk2(p0[4], p0[5]), pk2(p0[6], p0[7])}; pa[0] = __builtin_bit_cast(bf16x8, w);
      w = (u32x4){pk2(p0[8], p0[9]), pk2(p0[10], p0[11]), pk2(p0[12], p0[13]), pk2(p0[14], p0[15])}; pa[1] = __builtin_bit_cast(bf16x8, w);
      w = (u32x4){pk2(p1[0], p1[1]), pk2(p1[2], p1[3]), pk2(p1[4], p1[5]), pk2(p1[6], p1[7])}; pa[2] = __builtin_bit_cast(bf16x8, w);
      w = (u32x4){pk2(p1[8], p1[9]), pk2(p1[10], p1[11]), pk2(p1[12], p1[13]), pk2(p1[14], p1[15])}; pa[3] = __builtin_bit_cast(bf16x8, w); }
#pragma unroll
    for (int db = 0; db < 2; ++db)
#pragma unroll
        for (int s4 = 0; s4 < 4; ++s4) o[db] = __builtin_amdgcn_mfma_f32_32x32x16_bf16(vf[db][s4], pa[s4], o[db], 0, 0, 0);
}
__device__ __forceinline__ void load_q(bf16x8 (&qf)[6], const bf16_t* qn, const bf16_t* qr, const float* rp, int hi) {
#pragma unroll
    for (int d0 = 0; d0 < 4; ++d0) qf[d0] = *(const bf16x8*)(qn + d0 * 16 + hi * 8);
    const u32x4 a = *(const u32x4*)(qr + hi * 8), b = *(const u32x4*)(qr + 16 + hi * 8);
    const f32x4 c0 = *(const f32x4*)(rp + hi * 8), c1 = *(const f32x4*)(rp + hi * 8 + 4), s0 = *(const f32x4*)(rp + 16 + hi * 8), s1 = *(const f32x4*)(rp + 16 + hi * 8 + 4);
    const float x1[8] = {bflo(a.x), bfhi(a.x), bflo(a.y), bfhi(a.y), bflo(a.z), bfhi(a.z), bflo(a.w), bfhi(a.w)};
    const float x2[8] = {bflo(b.x), bfhi(b.x), bflo(b.y), bfhi(b.y), bflo(b.z), bfhi(b.z), bflo(b.w), bfhi(b.w)};
    const float cs[8] = {c0[0], c0[1], c0[2], c0[3], c1[0], c1[1], c1[2], c1[3]}, sn[8] = {s0[0], s0[1], s0[2], s0[3], s1[0], s1[1], s1[2], s1[3]};
    float o1[8], o2[8];
#pragma unroll
    for (int j = 0; j < 8; ++j) { o1[j] = x1[j] * cs[j] - x2[j] * sn[j]; o2[j] = x1[j] * sn[j] + x2[j] * cs[j]; }
    u32x4 w1 = (u32x4){pk2(o1[0], o1[1]), pk2(o1[2], o1[3]), pk2(o1[4], o1[5]), pk2(o1[6], o1[7])}, w2 = (u32x4){pk2(o2[0], o2[1]), pk2(o2[2], o2[3]), pk2(o2[4], o2[5]), pk2(o2[6], o2[7])};
    qf[4] = __builtin_bit_cast(bf16x8, w1); qf[5] = __builtin_bit_cast(bf16x8, w2);
}
__device__ __forceinline__ void prompt_unit(LAS unsigned char* lds, const Ptrs& P, int qloc0, int qglob0, int kloc0, int kglob0, int h, int qb) {
    int tid_ = threadIdx.x; asm volatile("" : "+v"(tid_));
    const int tid = tid_, lane = tid & 63, r32 = lane & 31, hi = lane >> 5; const int wid = __builtin_amdgcn_readfirstlane(tid >> 6);
    const int NTL = 4 * qb + 4, cq = 4 * qb + (wid >> 1);
    bf16x8 qf[6];
    { const int ql = qloc0 + 32 * wid + r32, pos = qb * 256 + 32 * wid + r32;
      load_q(qf, P.Qn + (size_t)ql * 1024 + h * 64, P.Qr + (size_t)ql * 512 + h * 32, P.rope + pos * 32, hi); }
    const bf16_t* kn_src = P.Kn + (size_t)(kloc0 + (tid >> 3)) * 1024 + h * 64 + (tid & 7) * 8;
    const bf16_t* vt_src = P.Vt + (size_t)(h * 64 + (tid >> 3)) * VT_LD + kloc0 + (tid & 7) * 8;
    const bf16_t* kr_src = P.KR + (size_t)(kglob0 + ((tid & 255) >> 2)) * 32 + (tid & 3) * 8;
    const int k_w = (tid >> 3) * KP + (tid & 7) * 16, r_w = ((tid & 255) >> 2) * KP + 128 + (tid & 3) * 16;
    const int v_w = KB + (tid >> 3) * VP + ((tid & 7) >> 1) * 32 + (tid & 1) * 8;
    u32x4 kreg, vreg, rreg = (u32x4){0u, 0u, 0u, 0u};
    kreg = *(const u32x4*)kn_src; vreg = *(const u32x4*)vt_src; if (tid < 256) rreg = *(const u32x4*)kr_src;
    *(LAS u32x4*)(lds + k_w) = kreg; if (tid < 256) *(LAS u32x4*)(lds + r_w) = rreg;
    *(LAS u32x2*)(lds + v_w) = (u32x2){vreg.x, vreg.y}; *(LAS u32x2*)(lds + v_w + 16) = (u32x2){vreg.z, vreg.w};
    __syncthreads();
    float l = 0.f; f32x16 o[2], negm;
#pragma unroll
    for (int r = 0; r < 16; ++r) { o[0][r] = 0.f; o[1][r] = 0.f; negm[r] = 0.f; }
    for (int j = 0; j < NTL; ++j) {
        const bool more = j + 1 < NTL;
        if (more) { kreg = *(const u32x4*)(kn_src + (size_t)(j + 1) * 64 * 1024); vreg = *(const u32x4*)(vt_src + (j + 1) * 64); if (tid < 256) rreg = *(const u32x4*)(kr_src + (size_t)(j + 1) * 64 * 32); }
        if (j <= cq) {
            const LAS unsigned char* buf = lds + (j & 1) * BUFB;
            bf16x8 kf[2][6], vf[2][4];
#pragma unroll
            for (int kb = 0; kb < 2; ++kb)
#pragma unroll
                for (int d0 = 0; d0 < 6; ++d0) kf[kb][d0] = *(const LAS bf16x8*)(buf + (kb * 32 + r32) * KP + d0 * 32 + hi * 16);
#pragma unroll
            for (int db = 0; db < 2; ++db)
#pragma unroll
                for (int s4 = 0; s4 < 4; ++s4) vf[db][s4] = *(const LAS bf16x8*)(buf + KB + (db * 32 + r32) * VP + s4 * 32 + hi * 16);
            tile_core(kf, vf, qf, negm, l, o, 64, hi, j == 0);
        }
        if (more) { LAS unsigned char* nb = lds + ((j + 1) & 1) * BUFB;
            *(LAS u32x4*)(nb + k_w) = kreg; if (tid < 256) *(LAS u32x4*)(nb + r_w) = rreg;
            *(LAS u32x2*)(nb + v_w) = (u32x2){vreg.x, vreg.y}; *(LAS u32x2*)(nb + v_w + 16) = (u32x2){vreg.z, vreg.w}; }
        __syncthreads();
    }
    l += __shfl_xor(l, 32);
    const float inv = 1.0f / l;
    bf16_t* orow = P.ATT + (size_t)(qglob0 + 32 * wid + r32) * 1024 + h * 64;
#pragma unroll
    for (int db = 0; db < 2; ++db)
#pragma unroll
        for (int g = 0; g < 4; ++g) { u32x2 w; w.x = pk2(o[db][4 * g] * inv, o[db][4 * g + 1] * inv); w.y = pk2(o[db][4 * g + 2] * inv, o[db][4 * g + 3] * inv);
            *(u32x2*)(orow + 32 * db + 8 * g + 4 * hi) = w; }
}
__device__ __forceinline__ void sample_unit(LAS unsigned char* lds, const Ptrs& P, int b, int h) {
    int tid_ = threadIdx.x; asm volatile("" : "+v"(tid_));
    const int tid = tid_, lane = tid & 63, r32 = lane & 31, hi = lane >> 5; const int wid = __builtin_amdgcn_readfirstlane(tid >> 6);
    const int qglob0 = TP + b * DSEQ, qloc0 = qglob0 - G0_ROWS, kglob0 = TP + b * SKEYS, kloc0 = kglob0 - G0_ROWS;
    bf16x8 qf[6];
    load_q(qf, P.Qn + (size_t)(qloc0 + r32) * 1024 + h * 64, P.Qr + (size_t)(qloc0 + r32) * 512 + h * 32, P.rope + (PAST + r32) * 32, hi);
    float l = 0.f; f32x16 o[2], negm;
#pragma unroll
    for (int r = 0; r < 16; ++r) { o[0][r] = 0.f; o[1][r] = 0.f; negm[r] = 0.f; }
    constexpr int NTS = (SKEYS + 63) / 64;
    for (int j = wid; j < NTS; j += NWAVES) {
        const int nvalid = (SKEYS - j * 64) < 64 ? (SKEYS - j * 64) : 64;
        bf16x8 kf[2][6], vf[2][4];
#pragma unroll
        for (int kb = 0; kb < 2; ++kb) { int key = j * 64 + kb * 32 + r32; key = key < SKEYS ? key : SKEYS - 1;
            const bf16_t* kn = P.Kn + (size_t)(kloc0 + key) * 1024 + h * 64 + hi * 8; const bf16_t* kr = P.KR + (size_t)(kglob0 + key) * 32 + hi * 8;
#pragma unroll
            for (int d0 = 0; d0 < 4; ++d0) kf[kb][d0] = *(const bf16x8*)(kn + d0 * 16);
            kf[kb][4] = *(const bf16x8*)(kr); kf[kb][5] = *(const bf16x8*)(kr + 16); }
#pragma unroll
        for (int db = 0; db < 2; ++db) { const bf16_t* vr = P.Vt + (size_t)(h * 64 + db * 32 + r32) * VT_LD + kloc0 + j * 64 + 4 * hi;
#pragma unroll
            for (int s4 = 0; s4 < 4; ++s4) { u32x2 a = (u32x2){0u, 0u}, c = (u32x2){0u, 0u};
                if (16 * s4 + 4 * hi < nvalid) a = *(const u32x2*)(vr + 16 * s4); if (16 * s4 + 8 + 4 * hi < nvalid) c = *(const u32x2*)(vr + 16 * s4 + 8);
                const u32x4 w = (u32x4){a.x, a.y, c.x, c.y}; vf[db][s4] = __builtin_bit_cast(bf16x8, w); } }
        tile_core(kf, vf, qf, negm, l, o, nvalid, hi, j == wid);
    }
    l += __shfl_xor(l, 32);
    LAS float* OL = (LAS float*)lds + wid * (32 * 68); LAS float* ML = (LAS float*)(lds + NWAVES * 32 * 68 * 4);
#pragma unroll
    for (int db = 0; db < 2; ++db)
#pragma unroll
        for (int g = 0; g < 4; ++g) *(LAS f32x4*)(OL + r32 * 68 + 32 * db + 8 * g + 4 * hi) = (f32x4){o[db][4 * g], o[db][4 * g + 1], o[db][4 * g + 2], o[db][4 * g + 3]};
    if (hi == 0) { ML[wid * 64 + r32] = -negm[0]; ML[wid * 64 + 32 + r32] = l; }
    __syncthreads();
    { const int q = tid >> 4, d = (tid & 15) * 4; float M = -1e30f;
#pragma unroll
      for (int w = 0; w < NWAVES; ++w) M = fmaxf(M, ML[w * 64 + q]);
      float L = 0.f; f32x4 acc = (f32x4){0.f, 0.f, 0.f, 0.f};
#pragma unroll
      for (int w = 0; w < NWAVES; ++w) { const float f = __builtin_amdgcn_exp2f(ML[w * 64 + q] - M); L += f * ML[w * 64 + 32 + q]; acc = acc + *(const LAS f32x4*)((LAS float*)lds + w * (32 * 68) + q * 68 + d) * f; }
      const float inv = 1.0f / L; u32x2 wv; wv.x = pk2(acc[0] * inv, acc[1] * inv); wv.y = pk2(acc[2] * inv, acc[3] * inv);
      *(u32x2*)(P.ATT + (size_t)(qglob0 + q) * 1024 + h * 64 + d) = wv; }
    __syncthreads();
}
__device__ __forceinline__ void attn_phase(LAS unsigned char* lds, const Ptrs& P, int g, int G) {
    const int vb = (G % 8 == 0) ? (int)((blockIdx.x & 7) * (G >> 3) + (blockIdx.x >> 3)) : (int)blockIdx.x;
    for (int pi = vb; pi < 512; pi += G) { const int combo = pi >> 2, s = pi & 3, bl = combo >> 4, h = combo & 15;
        const int brow_glob = (g * 8 + bl) * SEQ, brow_loc = brow_glob - g * G0_ROWS;
#pragma unroll 1
        for (int hf = 0; hf < 2; ++hf) { const int qb = hf ? 7 - s : s; prompt_unit(lds, P, brow_loc + qb * 256, brow_glob + qb * 256, brow_loc, brow_glob, h, qb); } }
    if (g == 1) for (int ui = blockIdx.x; ui < DB * NH; ui += G) sample_unit(lds, P, ui >> 4, ui & 15);
}
}
#define XB_TMO      128
#define XB_XCNT(j)  (256  + 64 * (j))
#define XB_XSUB(j)  (1280 + 64 * (j))
#define XB_XGEN(j)  (2304 + 64 * (j))
#define XB_TOP      3328
#define XB_TOPGEN   3392
#define XCD_BAR_WORDS 3456
#define XB_SPIN_CAP (1u << 18)

__device__ __forceinline__ unsigned xb_ld(unsigned* p)              { return __hip_atomic_load(p, __ATOMIC_RELAXED, __HIP_MEMORY_SCOPE_AGENT); }
__device__ __forceinline__ unsigned xb_add(unsigned* p, unsigned v) { return __hip_atomic_fetch_add(p, v, __ATOMIC_RELAXED, __HIP_MEMORY_SCOPE_AGENT); }
__device__ __forceinline__ unsigned xb_xcc_id() { return (unsigned)__builtin_amdgcn_s_getreg((3 << 11) | 20) & 0xFu; }
#define XB_SPIN(cond, bar) do { unsigned _sp = 0; while (cond) { __builtin_amdgcn_s_sleep(1); \
    if ((++_sp & 255u) == 0u) { if (xb_ld(&(bar)[XB_TMO])) break; if (_sp > XB_SPIN_CAP) { atomicAdd(&(bar)[XB_TMO], 1u); break; } } } } while (0)

struct XcdBarrier {
    unsigned* bar; unsigned x;
    volatile __attribute__((address_space(3))) unsigned* st;
};

__device__ __forceinline__ XcdBarrier xcd_barrier_post(unsigned* bar, volatile __attribute__((address_space(3))) unsigned* st) {
    XcdBarrier b; b.bar = bar; b.x = xb_xcc_id(); b.st = st;
    if (threadIdx.x == 0) (void)xb_add(&bar[XB_XCNT(b.x)], 1u);
    return b;
}
__device__ __forceinline__ void xcd_barrier_complete(unsigned* bar, unsigned x, unsigned& nloc, unsigned& nx) {
    const unsigned G = gridDim.x * gridDim.y * gridDim.z;
    unsigned sum, cnt, mine, sp = 0u;
    for (;;) {
        sum = 0u; cnt = 0u; mine = 0u;
#pragma unroll
        for (unsigned j = 0; j < 16; ++j) { const unsigned c = xb_ld(&bar[XB_XCNT(j)]); sum += c; cnt += (c > 0u) ? 1u : 0u; mine = (j == x) ? c : mine; }
        if (sum == G) break;
        __builtin_amdgcn_s_sleep(1);
        if ((++sp & 255u) == 0u) { if (xb_ld(&bar[XB_TMO])) break; if (sp > XB_SPIN_CAP) { atomicAdd(&bar[XB_TMO], 1u); break; } }
    }
    nloc = mine > 0u ? mine : 1u; nx = cnt > 0u ? cnt : 1u;
}

__device__ __forceinline__ void xcd_barrier(const XcdBarrier& b) {
    asm volatile("s_waitcnt vmcnt(0)" ::: "memory");
    __syncthreads();
    if (threadIdx.x == 0) {
        unsigned* bar = b.bar;
        __builtin_amdgcn_s_waitcnt(0);
        unsigned nloc = b.st[0], nx = b.st[1];
        if (nloc == 0u) { xcd_barrier_complete(bar, b.x, nloc, nx); b.st[0] = nloc; b.st[1] = nx; }
        const unsigned old = xb_add(&bar[XB_XSUB(b.x)], 1u);
        const unsigned gen = old / nloc;
        if (old + 1u == (gen + 1u) * nloc) {
            __builtin_amdgcn_fence(__ATOMIC_RELEASE, "agent");
            asm volatile("s_waitcnt vmcnt(0)" ::: "memory");
            const unsigned og = xb_add(&bar[XB_TOP], 1u);
            const unsigned tg = og / nx;
            if (og + 1u == (tg + 1u) * nx) xb_add(&bar[XB_TOPGEN], 1u);
            else XB_SPIN(xb_ld(&bar[XB_TOPGEN]) == tg, bar);
            __builtin_amdgcn_fence(__ATOMIC_ACQUIRE, "agent");
            xb_add(&bar[XB_XGEN(b.x)], 1u);
            asm volatile("s_waitcnt vmcnt(0)" ::: "memory");
        } else {
            XB_SPIN(xb_ld(&bar[XB_XGEN(b.x)]) == gen, bar);
            __builtin_amdgcn_fence(__ATOMIC_ACQUIRE, "agent");
            asm volatile("s_waitcnt vmcnt(0)" ::: "memory");
        }
    }
    __syncthreads();
}

__device__ __forceinline__ void small_gemm(LAS unsigned char* lds, unsigned char* ws, size_t oA, size_t oB, int N_out, int K, int kind, size_t oO, int ldc, int G) {
    int tid_ = threadIdx.x; asm volatile("" : "+v"(tid_));
    const int tid = tid_, lane = tid & 63, r32 = lane & 31, hi = lane >> 5; const int kq = __builtin_amdgcn_readfirstlane(tid >> 6);
    const bool paired = kind == pg8::EK_SWIGLU;
    const int nitems = 8 * (N_out / 32);
    const bf16_t* A = (const bf16_t*)(ws + oA) + (size_t)TP * K; const bf16_t* Bt = (const bf16_t*)(ws + oB);
    const int kslice = K / 8, k0 = kq * kslice;
    LAS float* PA = (LAS float*)lds; LAS float* PB = (LAS float*)(lds + 32768);
    for (int it = blockIdx.x; it < nitems; it += G) {
        const int rb = it & 7, cg = it >> 3;
        int browa, ocol;
        if (paired) { const int tile = cg >> 2, q4 = cg & 3; browa = tile * 256 + q4 * 32; ocol = tile * 128 + q4 * 32; } else { browa = cg * 32; ocol = cg * 32; }
        const bf16_t* ap = A + (size_t)(rb * 32 + r32) * K + k0 + 8 * hi;
        const bf16_t* bp = Bt + (size_t)(browa + r32) * K + k0 + 8 * hi;
        f32x16 ca, cb;
#pragma unroll
        for (int r = 0; r < 16; ++r) { ca[r] = 0.f; cb[r] = 0.f; }
        if (paired) {
#pragma unroll 4
            for (int k = 0; k < kslice; k += 32) {
                const bf16x8 a0 = *(const bf16x8*)(ap + k), a1 = *(const bf16x8*)(ap + k + 16);
                const bf16x8 b0 = *(const bf16x8*)(bp + k), b1 = *(const bf16x8*)(bp + k + 16), c0 = *(const bf16x8*)(bp + (size_t)128 * K + k), c1 = *(const bf16x8*)(bp + (size_t)128 * K + k + 16);
                ca = __builtin_amdgcn_mfma_f32_32x32x16_bf16(a0, b0, ca, 0, 0, 0); ca = __builtin_amdgcn_mfma_f32_32x32x16_bf16(a1, b1, ca, 0, 0, 0);
                cb = __builtin_amdgcn_mfma_f32_32x32x16_bf16(a0, c0, cb, 0, 0, 0); cb = __builtin_amdgcn_mfma_f32_32x32x16_bf16(a1, c1, cb, 0, 0, 0);
            }
        } else {
#pragma unroll 4
            for (int k = 0; k < kslice; k += 32) {
                const bf16x8 a0 = *(const bf16x8*)(ap + k), a1 = *(const bf16x8*)(ap + k + 16);
                const bf16x8 b0 = *(const bf16x8*)(bp + k), b1 = *(const bf16x8*)(bp + k + 16);
                ca = __builtin_amdgcn_mfma_f32_32x32x16_bf16(a0, b0, ca, 0, 0, 0); ca = __builtin_amdgcn_mfma_f32_32x32x16_bf16(a1, b1, ca, 0, 0, 0);
            }
        }
#pragma unroll
        for (int r = 0; r < 16; ++r) { PA[(kq * 16 + r) * 64 + lane] = ca[r]; if (paired) PB[(kq * 16 + r) * 64 + lane] = cb[r]; }
        __syncthreads();
        if (tid < 128) { const int r = tid >> 3, h2 = (tid >> 2) & 1, g = tid & 3;
          f32x4 v0 = (f32x4){0.f, 0.f, 0.f, 0.f}, v1 = v0, w0 = v0, w1 = v0;
#pragma unroll
          for (int q = 0; q < 8; ++q) { const int o = (q * 16 + r) * 64 + h2 * 32 + 8 * g;
              v0 = v0 + *(const LAS f32x4*)(PA + o); v1 = v1 + *(const LAS f32x4*)(PA + o + 4);
              if (paired) { w0 = w0 + *(const LAS f32x4*)(PB + o); w1 = w1 + *(const LAS f32x4*)(PB + o + 4); } }
          const int orow = TP + rb * 32 + (r & 3) + 8 * (r >> 2) + 4 * h2, c = ocol + 8 * g;
          const size_t off = (size_t)orow * ldc + c; bf16_t* O = (bf16_t*)(ws + oO);
          if (kind == pg8::EK_SWIGLU) {
              { const float rr = ((const float*)(ws + WS_RSB))[orow]; v0 = v0 * rr; v1 = v1 * rr; w0 = w0 * rr; w1 = w1 * rr; }
#pragma unroll
              for (int i = 0; i < 4; ++i) { v0[i] = v0[i] * pg8::sigm(v0[i]) * w0[i]; v1[i] = v1[i] * pg8::sigm(v1[i]) * w1[i]; }
          } else if (kind == pg8::EK_GATE) { const u32x4 gg = *(const u32x4*)((const bf16_t*)(ws + WS_R1) + off);
              v0[0] *= bflo(gg.x); v0[1] *= bfhi(gg.x); v0[2] *= bflo(gg.y); v0[3] *= bfhi(gg.y); v1[0] *= bflo(gg.z); v1[1] *= bfhi(gg.z); v1[2] *= bflo(gg.w); v1[3] *= bfhi(gg.w);
          } else if (kind == pg8::EK_COMBINE) { const u32x4 y = *(const u32x4*)((const bf16_t*)(ws + WS_R1) + off); const u32x4 gg = *(const u32x4*)((const bf16_t*)(ws + WS_R2) + off);
              v0[0] = bflo(y.x) + bflo(gg.x) * v0[0]; v0[1] = bfhi(y.x) + bfhi(gg.x) * v0[1]; v0[2] = bflo(y.y) + bflo(gg.y) * v0[2]; v0[3] = bfhi(y.y) + bfhi(gg.y) * v0[3];
              v1[0] = bflo(y.z) + bflo(gg.z) * v1[0]; v1[1] = bfhi(y.z) + bfhi(gg.z) * v1[1]; v1[2] = bflo(y.w) + bflo(gg.w) * v1[2]; v1[3] = bfhi(y.w) + bfhi(gg.w) * v1[3]; }
          *(u32x4*)(O + off) = (u32x4){pk2(v0[0], v0[1]), pk2(v0[2], v0[3]), pk2(v1[0], v1[1]), pk2(v1[2], v1[3])}; }
        __syncthreads();
    }
}

constexpr int NSTEP = 18;
__host__ __device__ constexpr bool step_sync(int l, int s) { return !(s == 3 || s == 4 || s == 5 || s == 8 || s == 9 || (s == 0 && l != 0)); }
__device__ __forceinline__ void run_gemm(Frame& F, int s) {
    unsigned char* ws = F.ws;
    const int grp = (s >= 8) ? 1 : 0;
    size_t oA = WS_R0, oB = WS_W, oO = WS_R1;
    int M = T, N = D, K = D, kind = pg8::EK_PLAIN, ldc = 1024, rot = 0; float scale = 1.f;
    if (s == 1) { oB = WS_W + W_IN * 2; N = DINP; kind = pg8::EK_WIN; oO = WS_BG; }
    else if (s == 3) { oB = WS_W + W_CONV * 2; kind = pg8::EK_GATE; oO = WS_R1; }
    else if (s == 4 || s == 8) { oA = WS_QLN + (size_t)grp * G0_ROWS * QL * 2; oB = WS_W + W_UQ * 2; M = grp ? G1_ROWS : G0_ROWS; N = 1536; K = QL; kind = pg8::EK_Q; oO = WS_QN; scale = QSCALE; rot = grp ? 0 : 128; }
    else if (s == 5 || s == 9) { oA = WS_CALL + (size_t)grp * G0_ROWS * KVL * 2; oB = WS_W + W_UK * 2; M = grp ? G1_KEYS : G0_ROWS; N = 1024; K = KVL; oO = WS_KN; rot = grp ? 112 : 0; }
    else if (s == 6 || s == 10) { oA = WS_W + W_UV * 2; oB = WS_CALL + (size_t)grp * G0_ROWS * KVL * 2; M = 1024; N = grp ? G1_KEYS : G0_ROWS; K = KVL; oO = WS_VT; ldc = VT_LD; rot = grp ? 104 : 0; }
    else if (s == 12) { oB = WS_W + W_ATTN * 2; kind = pg8::EK_COMBINE; oO = WS_R3; }
    else if (s == 13) { oA = WS_R3; oB = WS_W + W_MERGE * 2; oO = WS_R3 + U1; }
    else if (s == 15) { oA = WS_R2; oB = WS_W + W_GU * 2; N = 2 * DFF; kind = pg8::EK_SWIGLU; oO = WS_R3; ldc = DFF; }
    else { oA = WS_R3; oB = WS_W + W_DOWN * 2; K = DFF; oO = WS_R1; }
    const bool split_sample = (s == 3 || s == 12 || s == 13 || s == 15 || s == 16);
    if (split_sample) M = TP;
    const pg8::bf16_t* Ap = (s == 1) ? (const pg8::bf16_t*)(F.out + O_Y) : (const pg8::bf16_t*)(ws + oA);
    const pg8::Gemm g{Ap, (const pg8::bf16_t*)(ws + oB), M, N, K};
    const pg8::EpiX E{kind, ws, oO, ldc, scale, (s == 15) ? WS_RSB : WS_RSA, (s == 1 || s == 15) ? 1 : 0};
    pg8::StaticOrder S; S.init(g.M, g.N, F.G, (int)((blockIdx.x + rot) % F.G));
    pg8::gemm_phase<pg8::EpiX, pg8::StaticOrder, true, true>(F.lds, g, S, E);
    if (split_sample) small_gemm(F.lds, ws, oA, oB, kind == pg8::EK_SWIGLU ? N / 2 : N, K, kind, oO, ldc, F.G);
}

__global__ void __launch_bounds__(NWAVES * 64, 2) fwd_mega(Args args) {
    extern __shared__ __attribute__((aligned(16))) unsigned char lds_raw[];
    cg::grid_group grid = cg::this_grid();
    Frame F;
    F.lds = (LAS unsigned char*)lds_raw; F.tid = threadIdx.x; F.lane = F.tid & 63; F.wave = __builtin_amdgcn_readfirstlane(F.tid >> 6); F.G = gridDim.x;
    F.in = args.in;
    F.out = args.out; F.ws = args.ws;
    volatile LAS unsigned* bst = (volatile LAS unsigned*)(F.lds + 131072);
    if (F.tid < 64) bst[F.tid] = 0u;
    __syncthreads();
    XcdBarrier bar = xcd_barrier_post((unsigned*)(args.ws) + 1024, bst + 8);
    for (int vst = args.st_lo * 2; vst < args.st_hi * 2; ++vst) {
        const int st = vst >> 1, rep = vst & 1;
        const int l = st / NSTEP, s = st % NSTEP;
        { int t_ = threadIdx.x; asm volatile("" : "+v"(t_)); F.tid = t_; F.lane = t_ & 63; F.wave = __builtin_amdgcn_readfirstlane(t_ >> 6); }
#ifndef PROBE_GEMM
#define PROBE_GEMM 0
#endif
#ifndef PROBE_ATT
#define PROBE_ATT 0
#endif
        const bool is_g = (s == 1 || s == 4 || s == 5 || s == 6 || s == 8 || s == 9 || s == 10 || s == 12 || s == 13 || s == 15 || s == 16);
        const int reps = ((PROBE_GEMM && is_g) || (PROBE_ATT && (s == 7 || s == 11))) ? 2 : 1;
        if (rep >= reps) continue;
        if (l == 0 && (s == 0 || s == 17)) convert_weights(F, s == 0 ? 0 : 1);
        if (s == 0) { if (l == 0) { build_rope(F); phase_norm_in(F); } }
        else if (s == 2) phase_c(F, l);
        else if (s == 7 || s == 11) {
            att::Ptrs P; P.Qn = (const bf16_t*)(F.ws + WS_QN); P.Qr = (const bf16_t*)(F.ws + WS_QR); P.Kn = (const bf16_t*)(F.ws + WS_KN); P.Vt = (const bf16_t*)(F.ws + WS_VT);
            P.KR = (const bf16_t*)(F.ws + WS_KR); P.ATT = (bf16_t*)(F.ws + WS_R0); P.rope = (const float*)(F.ws + WS_ROPE);
            att::attn_phase(F.lds, P, s == 7 ? 0 : 1, F.G);
        }
        else if (s == 14) phase_h(F, l);
        else if (s == 17) phase_k(F, l);
        else run_gemm(F, s);
        if (rep + 1 == reps && step_sync(l, s) && st + 1 < args.st_hi) { if (args.st_lo < 0) grid.sync(); else xcd_barrier(bar); }
    }
}

#ifndef MK_MULTI
#define MK_MULTI 0
#endif
extern "C" void kernel_launch(void* const* d_in, const int* in_sizes, int n_in, void* d_out, int out_size, void* d_ws, size_t ws_size, hipStream_t stream) {
    static int grid_blocks = 0;
    if (grid_blocks == 0) {
        if (n_in != 20 || out_size != (int)O_END || ws_size < WS_END) { fprintf(stderr, "kernel_launch: unexpected shapes n_in %d out %d ws %zu (need %zu)\n", n_in, out_size, ws_size, (size_t)WS_END); grid_blocks = -1; return; }
        int dev = 0, cus = 0, per_cu = 0;
        (void)hipGetDevice(&dev); (void)hipDeviceGetAttribute(&cus, hipDeviceAttributeMultiprocessorCount, dev);
        (void)hipFuncSetAttribute((const void*)fwd_mega, hipFuncAttributeMaxDynamicSharedMemorySize, LDS_BYTES);
        (void)hipOccupancyMaxActiveBlocksPerMultiprocessor(&per_cu, (const void*)fwd_mega, NWAVES * 64, LDS_BYTES);
        if (per_cu < 1) per_cu = 1;
        if (cus <= 0) cus = 256;
        grid_blocks = cus * per_cu;
    }
    if (grid_blocks < 0) return;
    Args a{};
    for (int i = 0; i < 20; ++i) a.in[i] = (const float*)d_in[i];
    a.out = (float*)d_out; a.ws = (unsigned char*)d_ws;
    (void)hipMemsetAsync(d_ws, 0, 65536, stream);
#if MK_MULTI
    int lo = 0;
    for (int st = 0; st < 2 * NSTEP; ++st) {
        if (step_sync(st / NSTEP, st % NSTEP) || st + 1 == 2 * NSTEP) { a.st_lo = lo; a.st_hi = st + 1; hipLaunchKernelGGL(fwd_mega, dim3(grid_blocks), dim3(NWAVES * 64), LDS_BYTES, stream, a); lo = st + 1; }
    }
#else
    a.st_lo = 0; a.st_hi = 2 * NSTEP;
    void* params[] = {&a};
    hipError_t e = hipLaunchCooperativeKernel((const void*)fwd_mega, dim3(grid_blocks), dim3(NWAVES * 64), params, LDS_BYTES, stream);
    if (e != hipSuccess) fprintf(stderr, "cooperative launch failed: %s (grid %d)\n", hipGetErrorString(e), grid_blocks);
#endif
}
```

```cpp
#include <hip/hip_runtime.h>
#include <hip/hip_cooperative_groups.h>
#include <cstdio>
#include <cstdint>
namespace cg = cooperative_groups;
constexpr int NWAVES = 8;
constexpr int D = 1024, TP = 32768, TS = 256, T = TP + TS, SEQ = 2048, NB = 16, DB = 8, DSEQ = 32, PAST = 2048, SKEYS = PAST + DSEQ, KT = TP + DB * SKEYS;
constexpr int DIN = 5792, DINP = 5888, QL = 384, KVL = 256, RP = 32, DFF = 2816, NH = 16, LATP = 768;
constexpr int G0_ROWS = 16384, G1_ROWS = T - G0_ROWS, G1_KEYS = KT - G0_ROWS, VT_LD = 33024;
constexpr float EPS = 1e-6f;
constexpr float QSCALE = 0.10206207261596577f * 1.4426950408889634f;
static_assert(T % 256 == 0 && G1_ROWS % 256 == 0 && G1_KEYS % 256 == 0 && KT % 256 == 0 && G1_KEYS == VT_LD, "tiles");
constexpr size_t O_Y = 0, O_CONV_P = (size_t)T * D, O_CKV_P = O_CONV_P + 2 * NB * 2 * D, O_KR_P = O_CKV_P + (size_t)2 * TP * KVL, O_CONV_S = O_KR_P + (size_t)2 * TP * RP,
                 O_CKV_S = O_CONV_S + 2 * DB * 2 * D, O_KR_S = O_CKV_S + (size_t)2 * TS * KVL, O_END = O_KR_S + (size_t)2 * TS * RP;
static_assert(O_END == 52936704, "d_out size");
constexpr size_t MiB = 1u << 20, U1 = (size_t)T * D * 2;
constexpr size_t WS_RSA = 256 * 1024, WS_RSB = 512 * 1024;
constexpr size_t WS_ROPE = 1 * MiB, WS_W = 2 * MiB, WS_R0 = 40 * MiB, WS_R1 = WS_R0 + U1, WS_R2 = WS_R1 + U1, WS_R3 = WS_R2 + U1, WS_R6 = WS_R3 + 178 * MiB;
constexpr size_t WS_QLN = WS_R6, WS_CALL = WS_QLN + (size_t)T * QL * 2, WS_KR = WS_CALL + (size_t)KT * KVL * 2, WS_END = WS_KR + (size_t)KT * RP * 2;
constexpr size_t W_IN = 0, W_UQ = W_IN + (size_t)DINP * D, W_UK = W_UQ + (size_t)1536 * QL, W_UV = W_UK + (size_t)1024 * KVL, W_CONV = W_UV + (size_t)1024 * KVL,
                 W_ATTN = W_CONV + (size_t)D * D, W_MERGE = W_ATTN + (size_t)D * D, W_GU = W_MERGE + (size_t)D * D, W_DOWN = W_GU + (size_t)2 * DFF * D, W_END = W_DOWN + (size_t)D * DFF;
static_assert(WS_W + W_END * 2 <= WS_R0, "weights fit");
constexpr size_t WS_BG = WS_R3, WS_U = WS_R3 + U1, WS_LAT = WS_R3 + 2 * U1;
constexpr size_t WS_QN = WS_R3, WS_QR = WS_QN + (size_t)G1_ROWS * 1024 * 2, WS_KN = WS_QR + (size_t)G1_ROWS * 512 * 2, WS_VT = WS_KN + (size_t)G1_KEYS * 1024 * 2, WS_GEND = WS_VT + (size_t)1024 * VT_LD * 2;
static_assert(WS_GEND <= WS_R6 && WS_LAT + (size_t)T * LATP * 2 <= WS_R6 && WS_R3 + (size_t)T * DFF * 2 <= WS_R6, "R3 region");
static_assert(WS_END <= 536870912, "d_ws budget (512 MiB)");
constexpr int LDS_BYTES = 131072 + 1024;


namespace pg8 {
#define PG8_LAS __attribute__((address_space(3)))
typedef unsigned short bf16_t;
typedef short bf16x8 __attribute__((ext_vector_type(8)));
typedef float f32x4 __attribute__((ext_vector_type(4)));
typedef unsigned u32x4 __attribute__((ext_vector_type(4)));
constexpr int BM = 256, BK = 64, HALF = 128, HTB = HALF * BK * 2  , STAGE_BYTES = 8 * HTB, NXCD = 8, WGM = 8;

__host__ __device__ __forceinline__ int lds_byte(int r, int c) { const int st = (r >> 4) * 2 + (c >> 5), rr = r & 15, cc = c & 31, ob = rr * 64 + cc * 2; return st * 1024 + (ob ^ (((ob >> 9) & 1) << 5)); }
__host__ __device__ __forceinline__ void stage_rc(int b, int& R, int& C) { const int st = b / 1024, sb = b % 1024, swz = sb ^ (((sb >> 9) & 1) << 5); R = (st >> 1) * 16 + swz / 64; C = (st & 1) * 32 + (swz % 64) / 2; }
__host__ __device__ __forceinline__ int perm32(int rho) { const int n = rho >> 4, i = rho & 15; return 8 * (i >> 2) + 4 * n + (i & 3); }

struct Unit { int pm, pn; };
struct Gemm { const bf16_t* A; const bf16_t* Bt; int M, N, K; };

struct StaticOrder {
    int nM, nN, nwg, G, c;
    __host__ __device__ void init(int M, int N, int G_, int c_) { nM = M / BM; nN = N / BM; nwg = nM * nN; G = G_; c = c_; }
    __host__ __device__ bool next(int i, Unit& u) const {
        const long L = (long)i * G + c; if (L >= nwg) return false;
        int wgid = (int)L; { const int q = nwg / NXCD, r = nwg % NXCD, xcd = wgid % NXCD, off = wgid / NXCD; wgid = (xcd < r ? xcd * (q + 1) : r * (q + 1) + (xcd - r) * q) + off; }
        const int nig = WGM * nN, gid = wgid / nig, fm = gid * WGM, gsz = (nM - fm) < WGM ? (nM - fm) : WGM;
        u.pm = fm + ((wgid % nig) % gsz); u.pn = (wgid % nig) / gsz; return true;
    }
    __device__ __forceinline__ void a_ready(const Unit&) const {}
    __device__ __forceinline__ void done(const Unit&) const {}
};

__device__ __forceinline__ unsigned cvt_pk_bf16(float lo, float hi) { unsigned r; asm volatile("v_cvt_pk_bf16_f32 %0, %1, %2" : "=v"(r) : "v"(lo), "v"(hi)); return r; }
typedef float f32x2 __attribute__((ext_vector_type(2)));
typedef unsigned u32x4e __attribute__((ext_vector_type(4)));
enum { EK_PLAIN = 0, EK_PAIRMUL = 1, EK_SWIGLU = 2, EK_SIGMOID = 3, EK_GATE = 4, EK_COMBINE = 5, EK_WIN = 6, EK_Q = 7 };
__device__ __forceinline__ float sigm(float x) { return __builtin_amdgcn_rcpf(1.0f + __builtin_amdgcn_exp2f(-1.4426950408889634f * x)); }
__device__ __forceinline__ float bflo(unsigned w) { return __uint_as_float(w << 16); }
__device__ __forceinline__ float bfhi(unsigned w) { return __uint_as_float(w & 0xffff0000u); }
struct EpiX {
    static constexpr bool PERM = true, AFTER_DRAIN = false;
    int kind; unsigned char* ws; size_t oO; int ldc; float scale; size_t oRS; int use_rs;
    __device__ __forceinline__ void operator()(const f32x4 (&acc)[2][2][4][2], const Unit& u, int wr, int wc, int fr, int fq) const {
        int k = kind; size_t ob = oO; int ld = ldc; int colt = u.pn * BM; const float sc = scale;
        if (k == EK_WIN) {
            const int pn = u.pn;
            if (pn < 4) { k = EK_PLAIN; }
            else if (pn < 12) { k = EK_PAIRMUL; ob = WS_U; colt = (pn - 4) * 128; }
            else if (pn < 16) { k = EK_SIGMOID; ob = WS_R1; colt = (pn - 12) * 256; }
            else if (pn < 20) { k = EK_SIGMOID; ob = WS_R2; colt = (pn - 16) * 256; }
            else { k = EK_PLAIN; ob = WS_LAT; colt = (pn - 20) * 256; ld = 768; }
        } else if (k == EK_Q) {
            k = EK_PLAIN; if (u.pn >= 4) { ob = WS_QR; colt = (u.pn - 4) * 256; ld = 512; }
        } else if (k == EK_PAIRMUL || k == EK_SWIGLU) colt = u.pn * 128;
        const int row0 = u.pm * BM + wr * 64 + fr;
        const int col0 = colt + wc * 32 + 8 * fq;
        bf16_t* base = (bf16_t*)(ws + ob); const bf16_t* aux1 = (const bf16_t*)(ws + WS_R1); const bf16_t* aux2 = (const bf16_t*)(ws + WS_R2);
        const float* rsp = (const float*)(ws + oRS);
        if (k == EK_PAIRMUL || k == EK_SWIGLU) {
#pragma unroll
            for (int ai = 0; ai < 2; ++ai)
#pragma unroll
                for (int m = 0; m < 4; ++m) {
                    bf16_t* rowp = base + (size_t)(row0 + ai * HALF + m * 16) * ld + col0;
                    const float rr = use_rs ? rsp[row0 + ai * HALF + m * 16] : 1.f;
                    f32x4 a0 = acc[ai][0][m][0] * rr, a1 = acc[ai][0][m][1] * rr; const f32x4 b0 = acc[ai][1][m][0] * rr, b1 = acc[ai][1][m][1] * rr;
                    if (k == EK_SWIGLU) {
#pragma unroll
                        for (int i = 0; i < 4; ++i) { a0[i] = a0[i] * sigm(a0[i]); a1[i] = a1[i] * sigm(a1[i]); }
                    }
                    const f32x4 v0 = a0 * b0, v1 = a1 * b1;
                    u32x4e w; w.x = cvt_pk_bf16(v0[0], v0[1]); w.y = cvt_pk_bf16(v0[2], v0[3]); w.z = cvt_pk_bf16(v1[0], v1[1]); w.w = cvt_pk_bf16(v1[2], v1[3]);
                    *(u32x4e*)rowp = w;
                }
        } else {
#pragma unroll
            for (int ai = 0; ai < 2; ++ai)
#pragma unroll
                for (int m = 0; m < 4; ++m) {
                    const size_t roff = (size_t)(row0 + ai * HALF + m * 16) * ld + col0;
                    const float rr = use_rs ? rsp[row0 + ai * HALF + m * 16] : 1.f;
#pragma unroll
                    for (int bj = 0; bj < 2; ++bj) {
                        f32x4 v0 = acc[ai][bj][m][0], v1 = acc[ai][bj][m][1];
                        const size_t off = roff + bj * HALF;
                        if (k == EK_PLAIN) { v0 = v0 * (sc * rr); v1 = v1 * (sc * rr); }
                        else if (k == EK_SIGMOID) {
#pragma unroll
                            for (int i = 0; i < 4; ++i) { v0[i] = sigm(v0[i] * rr); v1[i] = sigm(v1[i] * rr); }
                        } else if (k == EK_GATE) {
                            const u32x4e g = *(const u32x4e*)(aux1 + off);
                            v0[0] *= bflo(g.x); v0[1] *= bfhi(g.x); v0[2] *= bflo(g.y); v0[3] *= bfhi(g.y);
                            v1[0] *= bflo(g.z); v1[1] *= bfhi(g.z); v1[2] *= bflo(g.w); v1[3] *= bfhi(g.w);
                        } else {
                            const u32x4e y = *(const u32x4e*)(aux1 + off); const u32x4e g = *(const u32x4e*)(aux2 + off);
                            v0[0] = bflo(y.x) + bflo(g.x) * v0[0]; v0[1] = bfhi(y.x) + bfhi(g.x) * v0[1]; v0[2] = bflo(y.y) + bflo(g.y) * v0[2]; v0[3] = bfhi(y.y) + bfhi(g.y) * v0[3];
                            v1[0] = bflo(y.z) + bflo(g.z) * v1[0]; v1[1] = bfhi(y.z) + bfhi(g.z) * v1[1]; v1[2] = bflo(y.w) + bflo(g.w) * v1[2]; v1[3] = bfhi(y.w) + bfhi(g.w) * v1[3];
                        }
                        u32x4e w; w.x = cvt_pk_bf16(v0[0], v0[1]); w.y = cvt_pk_bf16(v0[2], v0[3]); w.z = cvt_pk_bf16(v1[0], v1[1]); w.w = cvt_pk_bf16(v1[2], v1[3]);
                        *(u32x4e*)(base + off) = w;
                    }
                }
        }
    }
};
template <class Epi, class Sched, bool ALIGN_EPI = false, bool SP2 = false>
__device__ __forceinline__ void gemm_phase(PG8_LAS unsigned char* lds, const Gemm g, const Sched& S, const Epi& E) {
    int tid_ = threadIdx.x; asm volatile("" : "+v"(tid_));
    const int tid = tid_, wid = __builtin_amdgcn_readfirstlane(tid >> 6), lane = tid & 63, wr = wid >> 2, wc = wid & 3, fr = lane & 15, fq = lane >> 4;
    const int K = g.K, nt = K / BK;
    unsigned voffA[2], voffB[2];
#pragma unroll
    for (int i = 0; i < 2; ++i) { int R, C; stage_rc(tid * 16 + i * 8192, R, C); const int Rb = Epi::PERM ? ((R & ~31) + perm32(R & 31)) : R;
        voffA[i] = (unsigned)(R * K + C) * 2u; voffB[i] = (unsigned)(Rb * K + C) * 2u; }
    const size_t kstep = (size_t)(BK * 2);
    const size_t hstep = (size_t)HALF * K * 2;
    const size_t tstep = 2 * hstep;
    const unsigned ldsw = (unsigned)wid * 1024u;
    const int aoff = lds_byte(wr * 64 + fr, fq * 8), boff = lds_byte(wc * 32 + fr, fq * 8);
#define PG8_SA(b, h) (((b) * 2 + (h)) * HTB)
#define PG8_SB(b, h) ((4 + (b) * 2 + (h)) * HTB)
#define PG8_STAGE(bufoff, gbase, voff) do { _Pragma("unroll") for (int _i = 0; _i < 2; ++_i) \
        __builtin_amdgcn_global_load_lds((const unsigned*)((const char*)(gbase) + (voff)[_i]), (PG8_LAS unsigned*)(lds + (bufoff) + ldsw + _i * 8192), 16, 0, 0); } while (0)
#define PG8_LDA(dst, b, h) do { _Pragma("unroll") for (int m = 0; m < 4; ++m) _Pragma("unroll") for (int k = 0; k < 2; ++k) dst[m][k] = *(const PG8_LAS bf16x8*)(lds + PG8_SA(b, h) + aoff + m * 2048 + k * 1024); } while (0)
#define PG8_LDB(dst, b, h) do { _Pragma("unroll") for (int n = 0; n < 2; ++n) _Pragma("unroll") for (int k = 0; k < 2; ++k) dst[n][k] = *(const PG8_LAS bf16x8*)(lds + PG8_SB(b, h) + boff + n * 2048 + k * 1024); } while (0)
#define PG8_MMA(ai, bj, At, Bt) do { __builtin_amdgcn_s_setprio(1); _Pragma("unroll") for (int m = 0; m < 4; ++m) _Pragma("unroll") for (int n = 0; n < 2; ++n) _Pragma("unroll") for (int k = 0; k < 2; ++k) \
        acc[ai][bj][m][n] = __builtin_amdgcn_mfma_f32_16x16x32_bf16(Bt[n][k], At[m][k], acc[ai][bj][m][n], 0, 0, 0); __builtin_amdgcn_s_setprio(0); } while (0)
#define PG8_WAIT_V(n) asm volatile("s_waitcnt vmcnt(" #n ")" ::: "memory")
#define PG8_WAIT_L(n) asm volatile("s_waitcnt lgkmcnt(" #n ")" ::: "memory")
#define PG8_BAR __builtin_amdgcn_s_barrier()
#define PG8_SCHED __builtin_amdgcn_sched_barrier(0)
    Unit cur, nxt; int ui = 0;
    if (!S.next(0, cur)) return;
    f32x4 acc[2][2][4][2];
#pragma unroll
    for (int a = 0; a < 2; ++a)
#pragma unroll
        for (int b = 0; b < 2; ++b)
#pragma unroll
            for (int m = 0; m < 4; ++m)
#pragma unroll
                for (int n = 0; n < 2; ++n) acc[a][b][m][n] = (f32x4){0.f, 0.f, 0.f, 0.f};
    bf16x8 At[4][2], B0[2][2], B1[2][2];
    const char* cA = (const char*)g.A + (size_t)cur.pm * tstep; const char* cB = (const char*)g.Bt + (size_t)cur.pn * tstep;
    S.a_ready(cur);
    if constexpr (SP2) {
        PG8_STAGE(PG8_SB(0, 0), cB, voffB); PG8_STAGE(PG8_SB(0, 1), cB + hstep, voffB); PG8_STAGE(PG8_SA(0, 0), cA, voffA); PG8_STAGE(PG8_SA(0, 1), cA + hstep, voffA);
        if (wr == 1) PG8_BAR;
        PG8_WAIT_V(2); PG8_BAR;
        PG8_STAGE(PG8_SB(1, 0), cB + kstep, voffB); PG8_STAGE(PG8_SA(1, 0), cA + kstep, voffA); PG8_STAGE(PG8_SB(1, 1), cB + hstep + kstep, voffB);
        PG8_WAIT_V(6); PG8_BAR;
    } else {
        PG8_STAGE(PG8_SB(0, 0), cB, voffB); PG8_STAGE(PG8_SA(0, 0), cA, voffA); PG8_STAGE(PG8_SB(0, 1), cB + hstep, voffB); PG8_STAGE(PG8_SA(0, 1), cA + hstep, voffA);
        if (wr == 1) PG8_BAR;
        PG8_WAIT_V(4); PG8_BAR;
        PG8_STAGE(PG8_SB(1, 0), cB + kstep, voffB); PG8_STAGE(PG8_SA(1, 0), cA + kstep, voffA); PG8_STAGE(PG8_SB(1, 1), cB + hstep + kstep, voffB);
        PG8_WAIT_V(6); PG8_BAR;
    }
    for (;;) {
        const bool has_next = S.next(ui + 1, nxt);
        const char* nA = has_next ? (const char*)g.A + (size_t)nxt.pm * tstep : cA; const char* nB = has_next ? (const char*)g.Bt + (size_t)nxt.pn * tstep : cB;
        for (int t = 0; t < nt; t += 2) {
            const bool last = (t == nt - 2);
            const char* a1 = cA + (size_t)(t + 1) * kstep;
            const char* a2 = last ? nA : cA + (size_t)(t + 2) * kstep; const char* b2 = last ? nB : cB + (size_t)(t + 2) * kstep;
            const char* a3 = a2 + kstep; const char* b3 = b2 + kstep;
            if (last && has_next) S.a_ready(nxt);
            if constexpr (SP2) {
            PG8_LDB(B0, 0, 0); PG8_LDB(B1, 0, 1); PG8_SCHED; PG8_LDA(At, 0, 0); PG8_STAGE(PG8_SA(1, 1), a1 + hstep, voffA);
            PG8_WAIT_V(8); PG8_WAIT_L(0); PG8_BAR; PG8_MMA(0, 0, At, B0); PG8_MMA(0, 1, At, B1); PG8_BAR; PG8_SCHED;
            PG8_LDA(At, 0, 1); PG8_STAGE(PG8_SB(0, 0), b2, voffB); PG8_STAGE(PG8_SB(0, 1), b2 + hstep, voffB); PG8_STAGE(PG8_SA(0, 0), a2, voffA);
            PG8_WAIT_V(8); PG8_WAIT_L(0); PG8_BAR; PG8_MMA(1, 0, At, B0); PG8_MMA(1, 1, At, B1); PG8_BAR; PG8_SCHED;
            PG8_LDB(B0, 1, 0); PG8_LDB(B1, 1, 1); PG8_SCHED; PG8_LDA(At, 1, 0); PG8_STAGE(PG8_SA(0, 1), a2 + hstep, voffA);
            PG8_WAIT_V(8); PG8_WAIT_L(0); PG8_BAR; PG8_MMA(0, 0, At, B0); PG8_MMA(0, 1, At, B1); PG8_BAR; PG8_SCHED;
            PG8_LDA(At, 1, 1); PG8_STAGE(PG8_SB(1, 0), b3, voffB); PG8_STAGE(PG8_SB(1, 1), b3 + hstep, voffB); PG8_STAGE(PG8_SA(1, 0), a3, voffA);
            PG8_WAIT_V(8); PG8_WAIT_L(0); PG8_BAR; PG8_MMA(1, 0, At, B0); PG8_MMA(1, 1, At, B1); PG8_BAR; PG8_SCHED;
            } else {
            PG8_LDB(B0, 0, 0); PG8_SCHED; PG8_LDA(At, 0, 0); PG8_STAGE(PG8_SA(1, 1), a1 + hstep, voffA);
            PG8_WAIT_L(8); PG8_BAR; PG8_WAIT_L(0); PG8_MMA(0, 0, At, B0); PG8_BAR; PG8_SCHED;
            PG8_LDB(B1, 0, 1); PG8_STAGE(PG8_SB(0, 0), b2, voffB);
            PG8_BAR; PG8_WAIT_L(0); PG8_MMA(0, 1, At, B1); PG8_BAR;
            PG8_LDA(At, 0, 1); PG8_STAGE(PG8_SA(0, 0), a2, voffA);
            PG8_BAR; PG8_WAIT_L(0); PG8_MMA(1, 0, At, B0); PG8_BAR; PG8_SCHED;
            PG8_STAGE(PG8_SB(0, 1), b2 + hstep, voffB);
            PG8_WAIT_V(6); PG8_BAR; PG8_MMA(1, 1, At, B1); PG8_BAR;
            PG8_LDB(B0, 1, 0); PG8_SCHED; PG8_LDA(At, 1, 0); PG8_STAGE(PG8_SA(0, 1), a2 + hstep, voffA);
            PG8_WAIT_L(8); PG8_BAR; PG8_WAIT_L(0); PG8_MMA(0, 0, At, B0); PG8_BAR; PG8_SCHED;
            PG8_LDB(B1, 1, 1); PG8_STAGE(PG8_SB(1, 0), b3, voffB);
            PG8_BAR; PG8_WAIT_L(0); PG8_MMA(0, 1, At, B1); PG8_BAR;
            PG8_LDA(At, 1, 1); PG8_STAGE(PG8_SA(1, 0), a3, voffA);
            PG8_BAR; PG8_WAIT_L(0); PG8_MMA(1, 0, At, B0); PG8_BAR; PG8_SCHED;
            PG8_STAGE(PG8_SB(1, 1), b3 + hstep, voffB);
            PG8_WAIT_V(6); PG8_BAR; PG8_MMA(1, 1, At, B1); PG8_BAR;
            }
        }
        if constexpr (ALIGN_EPI) { if (wr == 0) PG8_BAR; }
        if constexpr (!Epi::AFTER_DRAIN) { E(acc, cur, wr, wc, fr, fq); S.done(cur); }
        if (!has_next) break;
#pragma unroll
        for (int a = 0; a < 2; ++a)
#pragma unroll
            for (int b = 0; b < 2; ++b)
#pragma unroll
                for (int m = 0; m < 4; ++m)
#pragma unroll
                    for (int n = 0; n < 2; ++n) acc[a][b][m][n] = (f32x4){0.f, 0.f, 0.f, 0.f};
        cur = nxt; cA = nA; cB = nB; ++ui;
        if constexpr (ALIGN_EPI) { if (wr == 1) PG8_BAR; }
    }
    PG8_WAIT_V(0);
    if constexpr (!ALIGN_EPI) { if (wr == 0) PG8_BAR; }
    PG8_BAR;
    if constexpr (Epi::AFTER_DRAIN) { E.fused(acc, cur, wr, wc, fr, fq, lds, wid, lane); S.done(cur); }
#undef PG8_SA
#undef PG8_SB
#undef PG8_STAGE
#undef PG8_LDA
#undef PG8_LDB
#undef PG8_MMA
#undef PG8_WAIT_V
#undef PG8_WAIT_L
#undef PG8_BAR
#undef PG8_SCHED
}
}

#define LAS __attribute__((address_space(3)))
typedef unsigned short bf16_t;
typedef short bf16x8 __attribute__((ext_vector_type(8)));
typedef float f32x4 __attribute__((ext_vector_type(4)));
typedef float f32x16 __attribute__((ext_vector_type(16)));
typedef unsigned u32x4 __attribute__((ext_vector_type(4)));
typedef unsigned u32x2 __attribute__((ext_vector_type(2)));
struct Args { const float* in[20]; float* out; unsigned char* ws; int st_lo, st_hi; };

struct Frame {
    LAS unsigned char* lds; int tid, lane, wave, G;
    const float* const* in; float* out; unsigned char* ws;
};
__device__ __forceinline__ float wave_sum(float v) {
#pragma unroll
    for (int o = 1; o < 64; o <<= 1) v += __shfl_xor(v, o);
    return v;
}
__device__ __forceinline__ unsigned pk2(float lo, float hi) { return pg8::cvt_pk_bf16(lo, hi); }
__device__ __forceinline__ float bflo(unsigned w) { return __uint_as_float(w << 16); }
__device__ __forceinline__ float bfhi(unsigned w) { return __uint_as_float(w & 0xffff0000u); }
__device__ __forceinline__ float bf2f(bf16_t b) { return __uint_as_float(((unsigned)b) << 16); }

__device__ __forceinline__ void tr_load(float (&v)[32], const float* W, int N, int k0, int n0, int lane, const float* gain) {
#pragma unroll
    for (int i = 0; i < 32; ++i) { const int kk = 2 * i + (lane >> 5); v[i] = W[(size_t)(k0 + kk) * N + n0 + (lane & 31)] * (gain ? gain[k0 + kk] : 1.f); }
}
__device__ __forceinline__ void tr_finish(const float (&v)[32], int K, bf16_t* dst_row0  , int k0, LAS float* scr, int lane) {
#pragma unroll
    for (int i = 0; i < 32; ++i) { const int kk = 2 * i + (lane >> 5); scr[kk * 33 + (lane & 31)] = v[i]; }
    asm volatile("s_waitcnt lgkmcnt(0)" ::: "memory");
    const int c = lane & 7;
#pragma unroll
    for (int j = 0; j < 4; ++j) { const int n = (lane >> 3) + 8 * j; const LAS float* s = scr + (8 * c) * 33 + n;
        u32x4 o; o.x = pk2(s[0 * 33], s[1 * 33]); o.y = pk2(s[2 * 33], s[3 * 33]); o.z = pk2(s[4 * 33], s[5 * 33]); o.w = pk2(s[6 * 33], s[7 * 33]);
        *(u32x4*)(dst_row0 + (size_t)n * K + k0 + 8 * c) = o; }
    asm volatile("s_waitcnt lgkmcnt(0)" ::: "memory");
}
__device__ __forceinline__ size_t wdst(int mat, int n0) {
    switch (mat) {
    case 0: {
        int r;
        if (n0 < 1024) r = n0;
        else if (n0 < 2048) { const int j = n0 - 1024; r = 1024 + (j >> 7) * 256 + (j & 127); }
        else if (n0 < 3072) { const int j = n0 - 2048; r = 1024 + (j >> 7) * 256 + 128 + (j & 127); }
        else if (n0 < 3744) r = 5120 + (n0 - 3072);
        else r = 3072 + (n0 - 3744);
        return W_IN + (size_t)r * D; }
    case 1: { const int g = n0 >> 5, h = g / 3, part = g % 3; const int r = part < 2 ? h * 64 + part * 32 : 1024 + h * 32; return W_UQ + (size_t)r * QL; }
    case 2: { const int h = n0 >> 7, e = n0 & 127; return e < 64 ? W_UK + (size_t)(h * 64 + e) * KVL : W_UV + (size_t)(h * 64 + e - 64) * KVL; }
    case 3: return W_CONV + (size_t)n0 * D;
    case 4: return W_ATTN + (size_t)n0 * D;
    case 5: return W_MERGE + (size_t)n0 * D;
    case 6: { int r; if (n0 < DFF) r = (n0 >> 7) * 256 + (n0 & 127); else { const int j = n0 - DFF; r = (j >> 7) * 256 + 128 + (j & 127); } return W_GU + (size_t)r * D; }
    default: return W_DOWN + (size_t)n0 * DFF;
    }
}
__device__ __forceinline__ void convert_weights(Frame& F, int l) {
    LAS float* scr = (LAS float*)(F.lds + F.wave * 16384);
    bf16_t* Wb = (bf16_t*)(F.ws + WS_W);
    const int gw = blockIdx.x * NWAVES + F.wave, NGW = F.G * NWAVES;
    constexpr int I0 = 16 * (DIN / 32), I1 = 6 * 48, I2 = 4 * 64, I3 = 16 * 32, I6 = 16 * (2 * DFF / 32), I7 = 44 * 32;
    constexpr int NIT = I0 + I1 + I2 + 3 * I3 + I6 + I7;
#define CW_DECODE(it_, K_, N_, src_, gain_, dst_, k0_, n0_) do { int r = (it_), mat; gain_ = nullptr; \
        if (r < I0) { mat = 0; K_ = D; N_ = DIN; src_ = F.in[5] + (size_t)l * D * DIN; gain_ = F.in[6] + l * D; } \
        else if ((r -= I0) < I1) { mat = 1; K_ = QL; N_ = 1536; src_ = F.in[10] + (size_t)l * QL * 1536; } \
        else if ((r -= I1) < I2) { mat = 2; K_ = KVL; N_ = 2048; src_ = F.in[11] + (size_t)l * KVL * 2048; } \
        else if ((r -= I2) < I3) { mat = 3; K_ = D; N_ = D; src_ = F.in[13] + (size_t)l * D * D; } \
        else if ((r -= I3) < I3) { mat = 4; K_ = D; N_ = D; src_ = F.in[14] + (size_t)l * D * D; } \
        else if ((r -= I3) < I3) { mat = 5; K_ = D; N_ = D; src_ = F.in[15] + (size_t)l * D * D; } \
        else if ((r -= I3) < I6) { mat = 6; K_ = D; N_ = 2 * DFF; src_ = F.in[18] + (size_t)l * D * 2 * DFF; gain_ = F.in[16] + l * D; } \
        else { r -= I6; mat = 7; K_ = DFF; N_ = D; src_ = F.in[19] + (size_t)l * DFF * D; } \
        const int nblk = N_ / 32, kb = r / nblk, nb = r % nblk; k0_ = kb * 64; n0_ = nb * 32; dst_ = Wb + wdst(mat, nb * 32); } while (0)
    {
        float va[32], vb[32];
        int it = gw, Ka = 0, Na = 0, k0a = 0, n0a = 0, Kb = 0, Nb = 0, k0b = 0, n0b = 0; const float* sa = nullptr; const float* ga = nullptr; bf16_t* da = nullptr; const float* sb = nullptr; const float* gb = nullptr; bf16_t* db = nullptr;
        if (it < NIT) { CW_DECODE(it, Ka, Na, sa, ga, da, k0a, n0a); tr_load(va, sa, Na, k0a, n0a, F.lane, ga); }
        while (it < NIT) {
            const int itb = it + NGW;
            if (itb < NIT) { CW_DECODE(itb, Kb, Nb, sb, gb, db, k0b, n0b); tr_load(vb, sb, Nb, k0b, n0b, F.lane, gb); }
            tr_finish(va, Ka, da, k0a, scr, F.lane);
            if (itb >= NIT) break;
            const int itc = itb + NGW;
            if (itc < NIT) { CW_DECODE(itc, Ka, Na, sa, ga, da, k0a, n0a); tr_load(va, sa, Na, k0a, n0a, F.lane, ga); }
            tr_finish(vb, Kb, db, k0b, scr, F.lane);
            it = itc;
        }
    }
#undef CW_DECODE
    for (int i = (blockIdx.x * 512 + F.tid); i < (DINP - DIN) * D / 8; i += F.G * 512) *(u32x4*)(Wb + W_IN + (size_t)DIN * D + (size_t)i * 8) = (u32x4){0u, 0u, 0u, 0u};
}
__device__ __forceinline__ void build_rope(Frame& F) {
    float* rope = (float*)(F.ws + WS_ROPE);
    for (int i = blockIdx.x * 512 + F.tid; i < SKEYS * 16; i += F.G * 512) {
        const int pos = i >> 4, f = i & 15;
        const int a = f & 3; const double q = a == 0 ? 1.0 : (a == 1 ? 0.5623413251903491 : (a == 2 ? 0.31622776601683794 : 0.1778279410038923));
        const int bq = f >> 2; const double p10 = bq == 0 ? 1.0 : (bq == 1 ? 0.1 : (bq == 2 ? 0.01 : 0.001));
        const double rev = (double)pos * (q * p10) * 0.15915494309189535;
        const float fr = (float)(rev - __builtin_rint(rev));
        rope[pos * 32 + f] = __builtin_amdgcn_cosf(fr); rope[pos * 32 + 16 + f] = __builtin_amdgcn_sinf(fr);
    }
}
__device__ __forceinline__ const float* xrow_in(Frame& F, int m) { return m < TP ? F.in[0] + (size_t)m * D : F.in[1] + (size_t)(m - TP) * D; }
__device__ __forceinline__ void store_norm_bf16(bf16_t* orow, const f32x4 (&v)[4], float rstd, const float* g, int lane) {
#pragma unroll
    for (int j = 0; j < 4; ++j) { const f32x4 gg = *(const f32x4*)(g + 4 * lane + 256 * j);
        u32x2 w; w.x = pk2(v[j][0] * rstd * gg[0], v[j][1] * rstd * gg[1]); w.y = pk2(v[j][2] * rstd * gg[2], v[j][3] * rstd * gg[3]);
        *(u32x2*)(orow + 4 * lane + 256 * j) = w; }
}
__device__ __forceinline__ float sumsq16(const f32x4 (&v)[4]) { float s = 0.f;
#pragma unroll
    for (int j = 0; j < 4; ++j) s += (v[j][0] * v[j][0] + v[j][1] * v[j][1]) + (v[j][2] * v[j][2] + v[j][3] * v[j][3]);
    return wave_sum(s); }
__device__ __forceinline__ void store_bf16_row(bf16_t* orow, const f32x4 (&v)[4], int lane) {
#pragma unroll
    for (int j = 0; j < 4; ++j) { u32x2 w; w.x = pk2(v[j][0], v[j][1]); w.y = pk2(v[j][2], v[j][3]); *(u32x2*)(orow + 4 * lane + 256 * j) = w; }
}
__device__ __forceinline__ void load_bf16_row(f32x4 (&v)[4], const bf16_t* irow, int lane) {
#pragma unroll
    for (int j = 0; j < 4; ++j) { const u32x2 w = *(const u32x2*)(irow + 4 * lane + 256 * j); v[j] = (f32x4){bflo(w.x), bfhi(w.x), bflo(w.y), bfhi(w.y)}; }
}
constexpr int RB = 4;
__device__ __forceinline__ void phase_norm_in(Frame& F) {
    bf16_t* XA = (bf16_t*)(F.out + O_Y); float* RSA = (float*)(F.ws + WS_RSA);
    const int gw = blockIdx.x * NWAVES + F.wave, NGW = F.G * NWAVES;
    for (int m0 = gw; m0 < T; m0 += RB * NGW) { f32x4 v[RB][4];
#pragma unroll
        for (int q = 0; q < RB; ++q) { const int m = m0 + q * NGW; if (m < T) { const float* xr = xrow_in(F, m);
#pragma unroll
            for (int j = 0; j < 4; ++j) v[q][j] = *(const f32x4*)(xr + 4 * F.lane + 256 * j); } }
#pragma unroll
        for (int q = 0; q < RB; ++q) { const int m = m0 + q * NGW; if (m < T) {
            const float rstd = rsqrtf(sumsq16(v[q]) * (1.f / D) + EPS);
            store_bf16_row(XA + (size_t)m * D, v[q], F.lane); if (F.lane == 0) RSA[m] = rstd; } } }
}
__device__ __forceinline__ void phase_h(Frame& F, int l) {
    const bf16_t* XA = (const bf16_t*)(F.out + O_Y); bf16_t* XB = (bf16_t*)(F.ws + WS_R2); float* RSB = (float*)(F.ws + WS_RSB);
    const bf16_t* Mo = (const bf16_t*)(F.ws + WS_R3 + U1);
    const float* gp = F.in[7] + l * D;
    f32x4 gg[4];
#pragma unroll
    for (int j = 0; j < 4; ++j) gg[j] = *(const f32x4*)(gp + 4 * F.lane + 256 * j);
    const int gw = blockIdx.x * NWAVES + F.wave, NGW = F.G * NWAVES;
    for (int m0 = gw; m0 < T; m0 += RB * NGW) { f32x4 x[RB][4], mm[RB][4];
#pragma unroll
        for (int q = 0; q < RB; ++q) { const int m = m0 + q * NGW; if (m < T) { load_bf16_row(x[q], XA + (size_t)m * D, F.lane); load_bf16_row(mm[q], Mo + (size_t)m * D, F.lane); } }
#pragma unroll
        for (int q = 0; q < RB; ++q) { const int m = m0 + q * NGW; if (m < T) {
            const float rm = rsqrtf(sumsq16(mm[q]) * (1.f / D) + EPS);
#pragma unroll
            for (int j = 0; j < 4; ++j) x[q][j] = x[q][j] + mm[q][j] * rm * gg[j];
            const float rstd = rsqrtf(sumsq16(x[q]) * (1.f / D) + EPS);
            store_bf16_row(XB + (size_t)m * D, x[q], F.lane); if (F.lane == 0) RSB[m] = rstd; } } }
}
__device__ __forceinline__ void phase_k(Frame& F, int l) {
    bf16_t* XA = (bf16_t*)(F.out + O_Y); const bf16_t* XB = (const bf16_t*)(F.ws + WS_R2); float* RSA = (float*)(F.ws + WS_RSA);
    const bf16_t* Fo = (const bf16_t*)(F.ws + WS_R1); float* Y = F.out + O_Y;
    const float* gp = F.in[17] + l * D;
    f32x4 gg[4];
#pragma unroll
    for (int j = 0; j < 4; ++j) gg[j] = *(const f32x4*)(gp + 4 * F.lane + 256 * j);
    const int gw = blockIdx.x * NWAVES + F.wave, NGW = F.G * NWAVES;
    for (int m0 = gw; m0 < T; m0 += RB * NGW) { f32x4 x[RB][4], mm[RB][4];
#pragma unroll
        for (int q = 0; q < RB; ++q) { const int m = m0 + q * NGW; if (m < T) { load_bf16_row(x[q], XB + (size_t)m * D, F.lane); load_bf16_row(mm[q], Fo + (size_t)m * D, F.lane); } }
#pragma unroll
        for (int q = 0; q < RB; ++q) { const int m = m0 + q * NGW; if (m < T) {
            const float rm = rsqrtf(sumsq16(mm[q]) * (1.f / D) + EPS);
#pragma unroll
            for (int j = 0; j < 4; ++j) x[q][j] = x[q][j] + mm[q][j] * rm * gg[j];
            if (l == 0) { const float rstd = rsqrtf(sumsq16(x[q]) * (1.f / D) + EPS); store_bf16_row(XA + (size_t)m * D, x[q], F.lane); if (F.lane == 0) RSA[m] = rstd; }
            else {
#pragma unroll
                for (int j = 0; j < 4; ++j) *(f32x4*)(Y + (size_t)m * D + 4 * F.lane + 256 * j) = x[q][j]; } } } }
}
__device__ __forceinline__ void ld16bf(float (&d)[16], const bf16_t* p) {
    const u32x4 a = *(const u32x4*)p, b = *(const u32x4*)(p + 8);
    d[0] = bflo(a.x); d[1] = bfhi(a.x); d[2] = bflo(a.y); d[3] = bfhi(a.y); d[4] = bflo(a.z); d[5] = bfhi(a.z); d[6] = bflo(a.w); d[7] = bfhi(a.w);
    d[8] = bflo(b.x); d[9] = bfhi(b.x); d[10] = bflo(b.y); d[11] = bfhi(b.y); d[12] = bflo(b.z); d[13] = bfhi(b.z); d[14] = bflo(b.w); d[15] = bfhi(b.w);
}
__device__ __forceinline__ void cvt16(float (&d)[16], const u32x4 a, const u32x4 b) {
    d[0] = bflo(a.x); d[1] = bfhi(a.x); d[2] = bflo(a.y); d[3] = bfhi(a.y); d[4] = bflo(a.z); d[5] = bfhi(a.z); d[6] = bflo(a.w); d[7] = bfhi(a.w);
    d[8] = bflo(b.x); d[9] = bfhi(b.x); d[10] = bflo(b.y); d[11] = bfhi(b.y); d[12] = bflo(b.z); d[13] = bfhi(b.z); d[14] = bflo(b.w); d[15] = bfhi(b.w);
}
__device__ __forceinline__ void ld16f(float (&d)[16], const float* p) {
#pragma unroll
    for (int j = 0; j < 4; ++j) { const f32x4 a = *(const f32x4*)(p + 4 * j); d[4 * j] = a[0]; d[4 * j + 1] = a[1]; d[4 * j + 2] = a[2]; d[4 * j + 3] = a[3]; }
}
__device__ __forceinline__ void phase_c(Frame& F, int l) {
    const bf16_t* Bg = (const bf16_t*)(F.ws + WS_BG); const bf16_t* U = (const bf16_t*)(F.ws + WS_U); const bf16_t* LAT = (const bf16_t*)(F.ws + WS_LAT);
    bf16_t* YAin = (bf16_t*)(F.ws + WS_R0); bf16_t* QLn = (bf16_t*)(F.ws + WS_QLN); bf16_t* Call = (bf16_t*)(F.ws + WS_CALL); bf16_t* KR = (bf16_t*)(F.ws + WS_KR);
    const float* rope = (const float*)(F.ws + WS_ROPE);
    const int lane = F.lane;
    { const float* cc = F.in[3] + (size_t)l * DB * PAST * KVL; const float* ck = F.in[4] + (size_t)l * DB * PAST * RP;
      for (int i = blockIdx.x * 512 + F.tid; i < DB * PAST * KVL / 8; i += F.G * 512) { const int e = i * 8, b = e / (PAST * KVL), r = e % (PAST * KVL);
          const f32x4 a = *(const f32x4*)(cc + e), c = *(const f32x4*)(cc + e + 4);
          *(u32x4*)(Call + (size_t)(TP + b * SKEYS) * KVL + r) = (u32x4){pk2(a[0], a[1]), pk2(a[2], a[3]), pk2(c[0], c[1]), pk2(c[2], c[3])}; }
      for (int i = blockIdx.x * 512 + F.tid; i < DB * PAST * RP / 8; i += F.G * 512) { const int e = i * 8, b = e / (PAST * RP), r = e % (PAST * RP);
          const f32x4 a = *(const f32x4*)(ck + e), c = *(const f32x4*)(ck + e + 4);
          *(u32x4*)(KR + (size_t)(TP + b * SKEYS) * RP + r) = (u32x4){pk2(a[0], a[1]), pk2(a[2], a[3]), pk2(c[0], c[1]), pk2(c[2], c[3])}; } }
    float cw0[16], cw1[16], cw2[16];
    ld16f(cw0, F.in[12] + (size_t)l * 3 * D + 16 * lane); ld16f(cw1, F.in[12] + (size_t)l * 3 * D + D + 16 * lane); ld16f(cw2, F.in[12] + (size_t)l * 3 * D + 2 * D + 16 * lane);
    float gq[8], gk[8];
#pragma unroll
    for (int i = 0; i < 8; ++i) { gq[i] = lane < 48 ? F.in[8][l * QL + 8 * lane + i] : 0.f; gk[i] = lane < 32 ? F.in[9][l * KVL + 8 * lane + i] : 0.f; }
    const int gw = blockIdx.x * NWAVES + F.wave, NGW = F.G * NWAVES;
    for (int run = gw; run < T / 8; run += NGW) {
        const int t0 = run * 8; const bool smp = t0 >= TP;
        const int b = smp ? (t0 - TP) / DSEQ : t0 / SEQ, s0 = smp ? (t0 - TP) % DSEQ : t0 % SEQ, slen = smp ? DSEQ : SEQ;
        float up1[16], up2[16];
        if (s0 == 0) {
            if (smp) { const float* hs = F.in[2] + ((size_t)(l * DB + b) * 2) * D + 16 * lane; ld16f(up2, hs); ld16f(up1, hs + D); }
            else {
#pragma unroll
                for (int i = 0; i < 16; ++i) { up1[i] = 0.f; up2[i] = 0.f; } }
        } else { ld16bf(up1, U + (size_t)(t0 - 1) * D + 16 * lane); ld16bf(up2, U + (size_t)(t0 - 2) * D + 16 * lane); }
#pragma unroll 1
        for (int i4 = 0; i4 < 8; i4 += 2) {
            u32x4 rU[2][2], rB[2][2], rQ[2], rC[2]; unsigned rR1[2], rR2[2];
#pragma unroll
            for (int q = 0; q < 2; ++q) { const int t = t0 + i4 + q; const bf16_t* lat = LAT + (size_t)t * LATP;
                rU[q][0] = *(const u32x4*)(U + (size_t)t * D + 16 * lane); rU[q][1] = *(const u32x4*)(U + (size_t)t * D + 16 * lane + 8);
                rB[q][0] = *(const u32x4*)(Bg + (size_t)t * D + 16 * lane); rB[q][1] = *(const u32x4*)(Bg + (size_t)t * D + 16 * lane + 8);
                rQ[q] = (u32x4){0u, 0u, 0u, 0u}; rC[q] = rQ[q]; rR1[q] = 0u; rR2[q] = 0u;
                if (lane < 48) rQ[q] = *(const u32x4*)(lat + 8 * lane);
                if (lane < 32) rC[q] = *(const u32x4*)(lat + QL + 8 * lane);
                if (lane < 16) { rR1[q] = lat[QL + KVL + lane]; rR2[q] = lat[QL + KVL + 16 + lane]; } }
#pragma unroll
            for (int q = 0; q < 2; ++q) {
            const int t = t0 + i4 + q, s = s0 + i4 + q;
            float uc[16], bg[16], y[16];
            cvt16(uc, rU[q][0], rU[q][1]); cvt16(bg, rB[q][0], rB[q][1]);
#pragma unroll
            for (int i = 0; i < 16; ++i) y[i] = bg[i] * (cw0[i] * up2[i] + cw1[i] * up1[i] + cw2[i] * uc[i]);
            *(u32x4*)(YAin + (size_t)t * D + 16 * lane) = (u32x4){pk2(y[0], y[1]), pk2(y[2], y[3]), pk2(y[4], y[5]), pk2(y[6], y[7])};
            *(u32x4*)(YAin + (size_t)t * D + 16 * lane + 8) = (u32x4){pk2(y[8], y[9]), pk2(y[10], y[11]), pk2(y[12], y[13]), pk2(y[14], y[15])};
            if (s >= slen - 2) {
                float* oc = smp ? F.out + O_CONV_S + ((size_t)(l * DB + b) * 2 + (s - (slen - 2))) * D : F.out + O_CONV_P + ((size_t)(l * NB + b) * 2 + (s - (slen - 2))) * D;
#pragma unroll
                for (int j = 0; j < 4; ++j) *(f32x4*)(oc + 16 * lane + 4 * j) = (f32x4){uc[4 * j], uc[4 * j + 1], uc[4 * j + 2], uc[4 * j + 3]};
            }
#pragma unroll
            for (int i = 0; i < 16; ++i) { up2[i] = up1[i]; up1[i] = uc[i]; }
            const size_t krow = smp ? (size_t)(TP + b * SKEYS + PAST + s) : (size_t)t;
            const int pos = smp ? PAST + s : s;
            { float v[8]; const u32x4 w = rQ[q];
              v[0] = bflo(w.x); v[1] = bfhi(w.x); v[2] = bflo(w.y); v[3] = bfhi(w.y); v[4] = bflo(w.z); v[5] = bfhi(w.z); v[6] = bflo(w.w); v[7] = bfhi(w.w);
              float ss = 0.f;
#pragma unroll
              for (int i = 0; i < 8; ++i) ss += v[i] * v[i];
              const float r = rsqrtf(wave_sum(ss) * (1.f / QL) + EPS);
              if (lane < 48) *(u32x4*)(QLn + (size_t)t * QL + 8 * lane) = (u32x4){pk2(v[0] * r * gq[0], v[1] * r * gq[1]), pk2(v[2] * r * gq[2], v[3] * r * gq[3]), pk2(v[4] * r * gq[4], v[5] * r * gq[5]), pk2(v[6] * r * gq[6], v[7] * r * gq[7])}; }
            { float v[8]; const u32x4 w = rC[q];
              v[0] = bflo(w.x); v[1] = bfhi(w.x); v[2] = bflo(w.y); v[3] = bfhi(w.y); v[4] = bflo(w.z); v[5] = bfhi(w.z); v[6] = bflo(w.w); v[7] = bfhi(w.w);
              float ss = 0.f;
#pragma unroll
              for (int i = 0; i < 8; ++i) ss += v[i] * v[i];
              const float r = rsqrtf(wave_sum(ss) * (1.f / KVL) + EPS);
              if (lane < 32) {
#pragma unroll
                  for (int i = 0; i < 8; ++i) v[i] = v[i] * r * gk[i];
                  float* oc = smp ? F.out + O_CKV_S + ((size_t)l * TS + (t - TP)) * KVL : F.out + O_CKV_P + ((size_t)l * TP + t) * KVL;
                  *(f32x4*)(oc + 8 * lane) = (f32x4){v[0], v[1], v[2], v[3]}; *(f32x4*)(oc + 8 * lane + 4) = (f32x4){v[4], v[5], v[6], v[7]};
                  *(u32x4*)(Call + krow * KVL + 8 * lane) = (u32x4){pk2(v[0], v[1]), pk2(v[2], v[3]), pk2(v[4], v[5]), pk2(v[6], v[7])}; } }
            if (lane < 16) { const float x1 = __uint_as_float(rR1[q] << 16), x2 = __uint_as_float(rR2[q] << 16); const float c = rope[pos * 32 + lane], sn = rope[pos * 32 + 16 + lane];
                const float o1 = x1 * c - x2 * sn, o2 = x1 * sn + x2 * c;
                float* ok = smp ? F.out + O_KR_S + ((size_t)l * TS + (t - TP)) * RP : F.out + O_KR_P + ((size_t)l * TP + t) * RP;
                ok[lane] = o1; ok[16 + lane] = o2;
                KR[krow * RP + lane] = (bf16_t)(pk2(o1, o1) & 0xffffu); KR[krow * RP + 16 + lane] = (bf16_t)(pk2(o2, o2) & 0xffffu); }
            }
        }
    }
}
namespace att {
constexpr int KP = 208, VP = 144, KB = 64 * KP, VB = 64 * VP, BUFB = KB + VB;
struct Ptrs { const bf16_t *Qn, *Qr, *Kn, *Vt, *KR; bf16_t* ATT; const float* rope; };
__device__ __forceinline__ float fmax3(float a, float b, float c) { return fmaxf(fmaxf(a, b), c); }
__device__ __forceinline__ void tile_core(const bf16x8 (&kf)[2][6], const bf16x8 (&vf)[2][4], const bf16x8 (&qf)[6], float& m, float& l, f32x16 (&o)[2], int nvalid, int hi) {
    f32x16 p0, p1;
#pragma unroll
    for (int r = 0; r < 16; ++r) { p0[r] = 0.f; p1[r] = 0.f; }
#pragma unroll
    for (int d0 = 0; d0 < 6; ++d0) { p0 = __builtin_amdgcn_mfma_f32_32x32x16_bf16(kf[0][d0], qf[d0], p0, 0, 0, 0); p1 = __builtin_amdgcn_mfma_f32_32x32x16_bf16(kf[1][d0], qf[d0], p1, 0, 0, 0); }
    if (nvalid < 64) {
#pragma unroll
        for (int r = 0; r < 16; ++r) { const int kv = (r & 3) + 8 * (r >> 2) + 4 * hi; if (kv >= nvalid) p0[r] = -1e30f; if (kv + 32 >= nvalid) p1[r] = -1e30f; }
    }
    float rm = fmax3(p0[0], p0[1], p1[0]);
#pragma unroll
    for (int r = 1; r < 16; ++r) rm = fmax3(rm, p0[r], p1[r]);
    rm = fmaxf(rm, __shfl_xor(rm, 32));
    if (__any(rm > m + 8.0f)) { const float mn = fmaxf(m, rm), f = __builtin_amdgcn_exp2f(m - mn); l *= f; m = mn;
#pragma unroll
        for (int r = 0; r < 16; ++r) { o[0][r] *= f; o[1][r] *= f; } }
    float s = 0.f;
#pragma unroll
    for (int r = 0; r < 16; ++r) { p0[r] = __builtin_amdgcn_exp2f(p0[r] - m); p1[r] = __builtin_amdgcn_exp2f(p1[r] - m); s += p0[r] + p1[r]; }
    l += s;
    bf16x8 pa[4];
    { u32x4 w;
      w = (u32x4){pk2(p0[0], p0[1]), pk2(p0[2], p0[3]), pk2(p0[4], p0[5]), pk2(p0[6], p0[7])}; pa[0] = __builtin_bit_cast(bf16x8, w);
      w = (u32x4){pk2(p0[8], p0[9]), pk2(p0[10], p0[11]), pk2(p0[12], p0[13]), pk2(p0[14], p0[15])}; pa[1] = __builtin_bit_cast(bf16x8, w);
      w = (u32x4){pk2(p1[0], p1[1]), pk2(p1[2], p1[3]), pk2(p1[4], p1[5]), pk2(p1[6], p1[7])}; pa[2] = __builtin_bit_cast(bf16x8, w);
      w = (u32x4){pk2(p1[8], p1[9]), pk2(p1[10], p1[11]), pk2(p1[12], p1[13]), pk2(p1[14], p1[15])}; pa[3] = __builtin_bit_cast(bf16x8, w); }
#pragma unroll
    for (int db = 0; db < 2; ++db)
#pragma unroll
        for (int s4 = 0; s4 < 4; ++s4) o[db] = __builtin_amdgcn_mfma_f32_32x32x16_bf16(vf[db][s4], pa[s4], o[db], 0, 0, 0);
}
__device__ __forceinline__ void load_q(bf16x8 (&qf)[6], const bf16_t* qn, const bf16_t* qr, const float* rp, int hi) {
#pragma unroll
    for (int d0 = 0; d0 < 4; ++d0) qf[d0] = *(const bf16x8*)(qn + d0 * 16 + hi * 8);
    const u32x4 a = *(const u32x4*)(qr + hi * 8), b = *(const u32x4*)(qr + 16 + hi * 8);
    const f32x4 c0 = *(const f32x4*)(rp + hi * 8), c1 = *(const f32x4*)(rp + hi * 8 + 4), s0 = *(const f32x4*)(rp + 16 + hi * 8), s1 = *(const f32x4*)(rp + 16 + hi * 8 + 4);
    const float x1[8] = {bflo(a.x), bfhi(a.x), bflo(a.y), bfhi(a.y), bflo(a.z), bfhi(a.z), bflo(a.w), bfhi(a.w)};
    const float x2[8] = {bflo(b.x), bfhi(b.x), bflo(b.y), bfhi(b.y), bflo(b.z), bfhi(b.z), bflo(b.w), bfhi(b.w)};
    const float cs[8] = {c0[0], c0[1], c0[2], c0[3], c1[0], c1[1], c1[2], c1[3]}, sn[8] = {s0[0], s0[1], s0[2], s0[3], s1[0], s1[1], s1[2], s1[3]};
    float o1[8], o2[8];
#pragma unroll
    for (int j = 0; j < 8; ++j) { o1[j] = x1[j] * cs[j] - x2[j] * sn[j]; o2[j] = x1[j] * sn[j] + x2[j] * cs[j]; }
    u32x4 w1 = (u32x4){pk2(o1[0], o1[1]), pk2(o1[2], o1[3]), pk2(o1[4], o1[5]), pk2(o1[6], o1[7])}, w2 = (u32x4){pk2(o2[0], o2[1]), pk2(o2[2], o2[3]), pk2(o2[4], o2[5]), pk2(o2[6], o2[7])};
    qf[4] = __builtin_bit_cast(bf16x8, w1); qf[5] = __builtin_bit_cast(bf16x8, w2);
}
__device__ __forceinline__ void prompt_unit(LAS unsigned char* lds, const Ptrs& P, int qloc0, int qglob0, int kloc0, int kglob0, int h, int qb) {
    int tid_ = threadIdx.x; asm volatile("" : "+v"(tid_));
    const int tid = tid_, lane = tid & 63, r32 = lane & 31, hi = lane >> 5; const int wid = __builtin_amdgcn_readfirstlane(tid >> 6);
    const int NTL = 4 * qb + 4, cq = 4 * qb + (wid >> 1);
    const bf16_t* kn_src = P.Kn + (size_t)(kloc0 + (tid >> 3)) * 1024 + h * 64 + (tid & 7) * 8;
    const bf16_t* vt_src = P.Vt + (size_t)(h * 64 + (tid >> 3)) * VT_LD + kloc0 + (tid & 7) * 8;
    const bf16_t* kr_src = P.KR + (size_t)(kglob0 + ((tid & 255) >> 2)) * 32 + (tid & 3) * 8;
    const int k_w = (tid >> 3) * KP + (tid & 7) * 16, r_w = ((tid & 255) >> 2) * KP + 128 + (tid & 3) * 16;
    const int v_w = KB + (tid >> 3) * VP + ((tid & 7) >> 1) * 32 + (tid & 1) * 8;
    u32x4 kreg, vreg, rreg = (u32x4){0u, 0u, 0u, 0u};
    kreg = *(const u32x4*)kn_src; vreg = *(const u32x4*)vt_src; if (tid < 256) rreg = *(const u32x4*)kr_src;
    __builtin_amdgcn_sched_barrier(0);
    bf16x8 qf[6];
    { const int ql = qloc0 + 32 * wid + r32, pos = qb * 256 + 32 * wid + r32;
      load_q(qf, P.Qn + (size_t)ql * 1024 + h * 64, P.Qr + (size_t)ql * 512 + h * 32, P.rope + pos * 32, hi); }
    *(LAS u32x4*)(lds + k_w) = kreg; if (tid < 256) *(LAS u32x4*)(lds + r_w) = rreg;
    *(LAS u32x2*)(lds + v_w) = (u32x2){vreg.x, vreg.y}; *(LAS u32x2*)(lds + v_w + 16) = (u32x2){vreg.z, vreg.w};
    __syncthreads();
    float m = -1e30f, l = 0.f; f32x16 o[2];
#pragma unroll
    for (int r = 0; r < 16; ++r) { o[0][r] = 0.f; o[1][r] = 0.f; }
    for (int j = 0; j < NTL; ++j) {
        const bool more = j + 1 < NTL;
        if (more) { kreg = *(const u32x4*)(kn_src + (size_t)(j + 1) * 64 * 1024); vreg = *(const u32x4*)(vt_src + (j + 1) * 64); if (tid < 256) rreg = *(const u32x4*)(kr_src + (size_t)(j + 1) * 64 * 32); }
        if (j <= cq) {
            const LAS unsigned char* buf = lds + (j & 1) * BUFB;
            bf16x8 kf[2][6], vf[2][4];
#pragma unroll
            for (int kb = 0; kb < 2; ++kb)
#pragma unroll
                for (int d0 = 0; d0 < 6; ++d0) kf[kb][d0] = *(const LAS bf16x8*)(buf + (kb * 32 + r32) * KP + d0 * 32 + hi * 16);
#pragma unroll
            for (int db = 0; db < 2; ++db)
#pragma unroll
                for (int s4 = 0; s4 < 4; ++s4) vf[db][s4] = *(const LAS bf16x8*)(buf + KB + (db * 32 + r32) * VP + s4 * 32 + hi * 16);
            tile_core(kf, vf, qf, m, l, o, 64, hi);
        }
        if (more) { LAS unsigned char* nb = lds + ((j + 1) & 1) * BUFB;
            *(LAS u32x4*)(nb + k_w) = kreg; if (tid < 256) *(LAS u32x4*)(nb + r_w) = rreg;
            *(LAS u32x2*)(nb + v_w) = (u32x2){vreg.x, vreg.y}; *(LAS u32x2*)(nb + v_w + 16) = (u32x2){vreg.z, vreg.w}; }
        __syncthreads();
    }
    l += __shfl_xor(l, 32);
    const float inv = 1.0f / l;
    bf16_t* orow = P.ATT + (size_t)(qglob0 + 32 * wid + r32) * 1024 + h * 64;
#pragma unroll
    for (int db = 0; db < 2; ++db)
#pragma unroll
        for (int g = 0; g < 4; ++g) { u32x2 w; w.x = pk2(o[db][4 * g] * inv, o[db][4 * g + 1] * inv); w.y = pk2(o[db][4 * g + 2] * inv, o[db][4 * g + 3] * inv);
            *(u32x2*)(orow + 32 * db + 8 * g + 4 * hi) = w; }
}
__device__ __forceinline__ void sample_unit(LAS unsigned char* lds, const Ptrs& P, int b, int h) {
    int tid_ = threadIdx.x; asm volatile("" : "+v"(tid_));
    const int tid = tid_, lane = tid & 63, r32 = lane & 31, hi = lane >> 5; const int wid = __builtin_amdgcn_readfirstlane(tid >> 6);
    const int qglob0 = TP + b * DSEQ, qloc0 = qglob0 - G0_ROWS, kglob0 = TP + b * SKEYS, kloc0 = kglob0 - G0_ROWS;
    bf16x8 qf[6];
    load_q(qf, P.Qn + (size_t)(qloc0 + r32) * 1024 + h * 64, P.Qr + (size_t)(qloc0 + r32) * 512 + h * 32, P.rope + (PAST + r32) * 32, hi);
    float m = -1e30f, l = 0.f; f32x16 o[2];
#pragma unroll
    for (int r = 0; r < 16; ++r) { o[0][r] = 0.f; o[1][r] = 0.f; }
    constexpr int NTS = (SKEYS + 63) / 64;
    for (int j = wid; j < NTS; j += NWAVES) {
        const int nvalid = (SKEYS - j * 64) < 64 ? (SKEYS - j * 64) : 64;
        bf16x8 kf[2][6], vf[2][4];
#pragma unroll
        for (int kb = 0; kb < 2; ++kb) { int key = j * 64 + kb * 32 + r32; key = key < SKEYS ? key : SKEYS - 1;
            const bf16_t* kn = P.Kn + (size_t)(kloc0 + key) * 1024 + h * 64 + hi * 8; const bf16_t* kr = P.KR + (size_t)(kglob0 + key) * 32 + hi * 8;
#pragma unroll
            for (int d0 = 0; d0 < 4; ++d0) kf[kb][d0] = *(const bf16x8*)(kn + d0 * 16);
            kf[kb][4] = *(const bf16x8*)(kr); kf[kb][5] = *(const bf16x8*)(kr + 16); }
#pragma unroll
        for (int db = 0; db < 2; ++db) { const bf16_t* vr = P.Vt + (size_t)(h * 64 + db * 32 + r32) * VT_LD + kloc0 + j * 64 + 4 * hi;
#pragma unroll
            for (int s4 = 0; s4 < 4; ++s4) { u32x2 a = (u32x2){0u, 0u}, c = (u32x2){0u, 0u};
                if (16 * s4 + 4 * hi < nvalid) a = *(const u32x2*)(vr + 16 * s4); if (16 * s4 + 8 + 4 * hi < nvalid) c = *(const u32x2*)(vr + 16 * s4 + 8);
                const u32x4 w = (u32x4){a.x, a.y, c.x, c.y}; vf[db][s4] = __builtin_bit_cast(bf16x8, w); } }
        tile_core(kf, vf, qf, m, l, o, nvalid, hi);
    }
    l += __shfl_xor(l, 32);
    LAS float* OL = (LAS float*)lds + wid * (32 * 68); LAS float* ML = (LAS float*)(lds + NWAVES * 32 * 68 * 4);
#pragma unroll
    for (int db = 0; db < 2; ++db)
#pragma unroll
        for (int g = 0; g < 4; ++g) *(LAS f32x4*)(OL + r32 * 68 + 32 * db + 8 * g + 4 * hi) = (f32x4){o[db][4 * g], o[db][4 * g + 1], o[db][4 * g + 2], o[db][4 * g + 3]};
    if (hi == 0) { ML[wid * 64 + r32] = m; ML[wid * 64 + 32 + r32] = l; }
    __syncthreads();
    { const int q = tid >> 4, d = (tid & 15) * 4; float M = -1e30f;
#pragma unroll
      for (int w = 0; w < NWAVES; ++w) M = fmaxf(M, ML[w * 64 + q]);
      float L = 0.f; f32x4 acc = (f32x4){0.f, 0.f, 0.f, 0.f};
#pragma unroll
      for (int w = 0; w < NWAVES; ++w) { const float f = __builtin_amdgcn_exp2f(ML[w * 64 + q] - M); L += f * ML[w * 64 + 32 + q]; acc = acc + *(const LAS f32x4*)((LAS float*)lds + w * (32 * 68) + q * 68 + d) * f; }
      const float inv = 1.0f / L; u32x2 wv; wv.x = pk2(acc[0] * inv, acc[1] * inv); wv.y = pk2(acc[2] * inv, acc[3] * inv);
      *(u32x2*)(P.ATT + (size_t)(qglob0 + q) * 1024 + h * 64 + d) = wv; }
    __syncthreads();
}
__device__ __forceinline__ void attn_phase(LAS unsigned char* lds, const Ptrs& P, int g, int G) {
    const int vb = (G % 8 == 0) ? (int)((blockIdx.x & 7) * (G >> 3) + (blockIdx.x >> 3)) : (int)blockIdx.x;
    for (int pi = vb; pi < 512; pi += G) { const int combo = pi >> 2, s = pi & 3, bl = combo >> 4, h = combo & 15;
        const int brow_glob = (g * 8 + bl) * SEQ, brow_loc = brow_glob - g * G0_ROWS;
#pragma unroll 1
        for (int hf = 0; hf < 2; ++hf) { const int qb = hf ? 7 - s : s; prompt_unit(lds, P, brow_loc + qb * 256, brow_glob + qb * 256, brow_loc, brow_glob, h, qb); } }
    if (g == 1) for (int ui = blockIdx.x; ui < DB * NH; ui += G) sample_unit(lds, P, ui >> 4, ui & 15);
}
}
#define XB_TMO      128
#define XB_XCNT(j)  (256  + 64 * (j))
#define XB_XSUB(j)  (1280 + 64 * (j))
#define XB_XGEN(j)  (2304 + 64 * (j))
#define XB_TOP      3328
#define XB_TOPGEN   3392
#define XCD_BAR_WORDS 3456
#define XB_SPIN_CAP (1u << 18)

__device__ __forceinline__ unsigned xb_ld(unsigned* p)              { return __hip_atomic_load(p, __ATOMIC_RELAXED, __HIP_MEMORY_SCOPE_AGENT); }
__device__ __forceinline__ unsigned xb_add(unsigned* p, unsigned v) { return __hip_atomic_fetch_add(p, v, __ATOMIC_RELAXED, __HIP_MEMORY_SCOPE_AGENT); }
__device__ __forceinline__ unsigned xb_xcc_id() { return (unsigned)__builtin_amdgcn_s_getreg((3 << 11) | 20) & 0xFu; }
#define XB_SPIN(cond, bar) do { unsigned _sp = 0; while (cond) { __builtin_amdgcn_s_sleep(1); \
    if ((++_sp & 255u) == 0u) { if (xb_ld(&(bar)[XB_TMO])) break; if (_sp > XB_SPIN_CAP) { atomicAdd(&(bar)[XB_TMO], 1u); break; } } } } while (0)

struct XcdBarrier {
    unsigned* bar; unsigned x;
    volatile __attribute__((address_space(3))) unsigned* st;
};

__device__ __forceinline__ XcdBarrier xcd_barrier_post(unsigned* bar, volatile __attribute__((address_space(3))) unsigned* st) {
    XcdBarrier b; b.bar = bar; b.x = xb_xcc_id(); b.st = st;
    if (threadIdx.x == 0) (void)xb_add(&bar[XB_XCNT(b.x)], 1u);
    return b;
}
__device__ __forceinline__ void xcd_barrier_complete(unsigned* bar, unsigned x, unsigned& nloc, unsigned& nx) {
    const unsigned G = gridDim.x * gridDim.y * gridDim.z;
    unsigned sum, cnt, mine, sp = 0u;
    for (;;) {
        sum = 0u; cnt = 0u; mine = 0u;
#pragma unroll
        for (unsigned j = 0; j < 16; ++j) { const unsigned c = xb_ld(&bar[XB_XCNT(j)]); sum += c; cnt += (c > 0u) ? 1u : 0u; mine = (j == x) ? c : mine; }
        if (sum == G) break;
        __builtin_amdgcn_s_sleep(1);
        if ((++sp & 255u) == 0u) { if (xb_ld(&bar[XB_TMO])) break; if (sp > XB_SPIN_CAP) { atomicAdd(&bar[XB_TMO], 1u); break; } }
    }
    nloc = mine > 0u ? mine : 1u; nx = cnt > 0u ? cnt : 1u;
}

__device__ __forceinline__ void xcd_barrier(const XcdBarrier& b) {
    asm volatile("s_waitcnt vmcnt(0)" ::: "memory");
    __syncthreads();
    if (threadIdx.x == 0) {
        unsigned* bar = b.bar;
        __builtin_amdgcn_s_waitcnt(0);
        unsigned nloc = b.st[0], nx = b.st[1];
        if (nloc == 0u) { xcd_barrier_complete(bar, b.x, nloc, nx); b.st[0] = nloc; b.st[1] = nx; }
        const unsigned old = xb_add(&bar[XB_XSUB(b.x)], 1u);
        const unsigned gen = old / nloc;
        if (old + 1u == (gen + 1u) * nloc) {
            __builtin_amdgcn_fence(__ATOMIC_RELEASE, "agent");
            asm volatile("s_waitcnt vmcnt(0)" ::: "memory");
            const unsigned og = xb_add(&bar[XB_TOP], 1u);
            const unsigned tg = og / nx;
            if (og + 1u == (tg + 1u) * nx) xb_add(&bar[XB_TOPGEN], 1u);
            else XB_SPIN(xb_ld(&bar[XB_TOPGEN]) == tg, bar);
            __builtin_amdgcn_fence(__ATOMIC_ACQUIRE, "agent");
            xb_add(&bar[XB_XGEN(b.x)], 1u);
            asm volatile("s_waitcnt vmcnt(0)" ::: "memory");
        } else {
            XB_SPIN(xb_ld(&bar[XB_XGEN(b.x)]) == gen, bar);
            __builtin_amdgcn_fence(__ATOMIC_ACQUIRE, "agent");
            asm volatile("s_waitcnt vmcnt(0)" ::: "memory");
        }
    }
    __syncthreads();
}

__device__ __forceinline__ void small_gemm(LAS unsigned char* lds, unsigned char* ws, size_t oA, size_t oB, int N_out, int K, int kind, size_t oO, int ldc, int G) {
    int tid_ = threadIdx.x; asm volatile("" : "+v"(tid_));
    const int tid = tid_, lane = tid & 63, r32 = lane & 31, hi = lane >> 5; const int kq = __builtin_amdgcn_readfirstlane(tid >> 6);
    const bool paired = kind == pg8::EK_SWIGLU;
    const int nitems = 8 * (N_out / 32);
    const bf16_t* A = (const bf16_t*)(ws + oA) + (size_t)TP * K; const bf16_t* Bt = (const bf16_t*)(ws + oB);
    const int kslice = K / 8, k0 = kq * kslice;
    LAS float* PA = (LAS float*)lds; LAS float* PB = (LAS float*)(lds + 32768);
    for (int it = blockIdx.x; it < nitems; it += G) {
        const int rb = it & 7, cg = it >> 3;
        int browa, ocol;
        if (paired) { const int tile = cg >> 2, q4 = cg & 3; browa = tile * 256 + q4 * 32; ocol = tile * 128 + q4 * 32; } else { browa = cg * 32; ocol = cg * 32; }
        const bf16_t* ap = A + (size_t)(rb * 32 + r32) * K + k0 + 8 * hi;
        const bf16_t* bp = Bt + (size_t)(browa + r32) * K + k0 + 8 * hi;
        f32x16 ca, cb;
#pragma unroll
        for (int r = 0; r < 16; ++r) { ca[r] = 0.f; cb[r] = 0.f; }
        if (paired) {
#pragma unroll 4
            for (int k = 0; k < kslice; k += 32) {
                const bf16x8 a0 = *(const bf16x8*)(ap + k), a1 = *(const bf16x8*)(ap + k + 16);
                const bf16x8 b0 = *(const bf16x8*)(bp + k), b1 = *(const bf16x8*)(bp + k + 16), c0 = *(const bf16x8*)(bp + (size_t)128 * K + k), c1 = *(const bf16x8*)(bp + (size_t)128 * K + k + 16);
                ca = __builtin_amdgcn_mfma_f32_32x32x16_bf16(a0, b0, ca, 0, 0, 0); ca = __builtin_amdgcn_mfma_f32_32x32x16_bf16(a1, b1, ca, 0, 0, 0);
                cb = __builtin_amdgcn_mfma_f32_32x32x16_bf16(a0, c0, cb, 0, 0, 0); cb = __builtin_amdgcn_mfma_f32_32x32x16_bf16(a1, c1, cb, 0, 0, 0);
            }
        } else {
#pragma unroll 4
            for (int k = 0; k < kslice; k += 32) {
                const bf16x8 a0 = *(const bf16x8*)(ap + k), a1 = *(const bf16x8*)(ap + k + 16);
                const bf16x8 b0 = *(const bf16x8*)(bp + k), b1 = *(const bf16x8*)(bp + k + 16);
                ca = __builtin_amdgcn_mfma_f32_32x32x16_bf16(a0, b0, ca, 0, 0, 0); ca = __builtin_amdgcn_mfma_f32_32x32x16_bf16(a1, b1, ca, 0, 0, 0);
            }
        }
#pragma unroll
        for (int r = 0; r < 16; ++r) { PA[(kq * 16 + r) * 64 + lane] = ca[r]; if (paired) PB[(kq * 16 + r) * 64 + lane] = cb[r]; }
        __syncthreads();
        if (tid < 128) { const int r = tid >> 3, h2 = (tid >> 2) & 1, g = tid & 3;
          f32x4 v0 = (f32x4){0.f, 0.f, 0.f, 0.f}, v1 = v0, w0 = v0, w1 = v0;
#pragma unroll
          for (int q = 0; q < 8; ++q) { const int o = (q * 16 + r) * 64 + h2 * 32 + 8 * g;
              v0 = v0 + *(const LAS f32x4*)(PA + o); v1 = v1 + *(const LAS f32x4*)(PA + o + 4);
              if (paired) { w0 = w0 + *(const LAS f32x4*)(PB + o); w1 = w1 + *(const LAS f32x4*)(PB + o + 4); } }
          const int orow = TP + rb * 32 + (r & 3) + 8 * (r >> 2) + 4 * h2, c = ocol + 8 * g;
          const size_t off = (size_t)orow * ldc + c; bf16_t* O = (bf16_t*)(ws + oO);
          if (kind == pg8::EK_SWIGLU) {
              { const float rr = ((const float*)(ws + WS_RSB))[orow]; v0 = v0 * rr; v1 = v1 * rr; w0 = w0 * rr; w1 = w1 * rr; }
#pragma unroll
              for (int i = 0; i < 4; ++i) { v0[i] = v0[i] * pg8::sigm(v0[i]) * w0[i]; v1[i] = v1[i] * pg8::sigm(v1[i]) * w1[i]; }
          } else if (kind == pg8::EK_GATE) { const u32x4 gg = *(const u32x4*)((const bf16_t*)(ws + WS_R1) + off);
              v0[0] *= bflo(gg.x); v0[1] *= bfhi(gg.x); v0[2] *= bflo(gg.y); v0[3] *= bfhi(gg.y); v1[0] *= bflo(gg.z); v1[1] *= bfhi(gg.z); v1[2] *= bflo(gg.w); v1[3] *= bfhi(gg.w);
          } else if (kind == pg8::EK_COMBINE) { const u32x4 y = *(const u32x4*)((const bf16_t*)(ws + WS_R1) + off); const u32x4 gg = *(const u32x4*)((const bf16_t*)(ws + WS_R2) + off);
              v0[0] = bflo(y.x) + bflo(gg.x) * v0[0]; v0[1] = bfhi(y.x) + bfhi(gg.x) * v0[1]; v0[2] = bflo(y.y) + bflo(gg.y) * v0[2]; v0[3] = bfhi(y.y) + bfhi(gg.y) * v0[3];
              v1[0] = bflo(y.z) + bflo(gg.z) * v1[0]; v1[1] = bfhi(y.z) + bfhi(gg.z) * v1[1]; v1[2] = bflo(y.w) + bflo(gg.w) * v1[2]; v1[3] = bfhi(y.w) + bfhi(gg.w) * v1[3]; }
          *(u32x4*)(O + off) = (u32x4){pk2(v0[0], v0[1]), pk2(v0[2], v0[3]), pk2(v1[0], v1[1]), pk2(v1[2], v1[3])}; }
        __syncthreads();
    }
}

constexpr int NSTEP = 18;
__host__ __device__ constexpr bool step_sync(int l, int s) { return !(s == 3 || s == 4 || s == 5 || s == 8 || s == 9 || (s == 0 && l != 0)); }
__device__ __forceinline__ void run_gemm(Frame& F, int s) {
    unsigned char* ws = F.ws;
    const int grp = (s >= 8) ? 1 : 0;
    size_t oA = WS_R0, oB = WS_W, oO = WS_R1;
    int M = T, N = D, K = D, kind = pg8::EK_PLAIN, ldc = 1024, rot = 0; float scale = 1.f;
    if (s == 1) { oB = WS_W + W_IN * 2; N = DINP; kind = pg8::EK_WIN; oO = WS_BG; }
    else if (s == 3) { oB = WS_W + W_CONV * 2; kind = pg8::EK_GATE; oO = WS_R1; }
    else if (s == 4 || s == 8) { oA = WS_QLN + (size_t)grp * G0_ROWS * QL * 2; oB = WS_W + W_UQ * 2; M = grp ? G1_ROWS : G0_ROWS; N = 1536; K = QL; kind = pg8::EK_Q; oO = WS_QN; scale = QSCALE; rot = grp ? 0 : 128; }
    else if (s == 5 || s == 9) { oA = WS_CALL + (size_t)grp * G0_ROWS * KVL * 2; oB = WS_W + W_UK * 2; M = grp ? G1_KEYS : G0_ROWS; N = 1024; K = KVL; oO = WS_KN; rot = grp ? 112 : 0; }
    else if (s == 6 || s == 10) { oA = WS_W + W_UV * 2; oB = WS_CALL + (size_t)grp * G0_ROWS * KVL * 2; M = 1024; N = grp ? G1_KEYS : G0_ROWS; K = KVL; oO = WS_VT; ldc = VT_LD; rot = grp ? 104 : 0; }
    else if (s == 12) { oB = WS_W + W_ATTN * 2; kind = pg8::EK_COMBINE; oO = WS_R3; }
    else if (s == 13) { oA = WS_R3; oB = WS_W + W_MERGE * 2; oO = WS_R3 + U1; }
    else if (s == 15) { oA = WS_R2; oB = WS_W + W_GU * 2; N = 2 * DFF; kind = pg8::EK_SWIGLU; oO = WS_R3; ldc = DFF; }
    else { oA = WS_R3; oB = WS_W + W_DOWN * 2; K = DFF; oO = WS_R1; }
    const bool split_sample = (s == 3 || s == 12 || s == 13 || s == 15 || s == 16);
    if (split_sample) M = TP;
    const pg8::bf16_t* Ap = (s == 1) ? (const pg8::bf16_t*)(F.out + O_Y) : (const pg8::bf16_t*)(ws + oA);
    const pg8::Gemm g{Ap, (const pg8::bf16_t*)(ws + oB), M, N, K};
    const pg8::EpiX E{kind, ws, oO, ldc, scale, (s == 15) ? WS_RSB : WS_RSA, (s == 1 || s == 15) ? 1 : 0};
    pg8::StaticOrder S; S.init(g.M, g.N, F.G, (int)((blockIdx.x + rot) % F.G));
    pg8::gemm_phase<pg8::EpiX, pg8::StaticOrder, true, true>(F.lds, g, S, E);
    if (split_sample) small_gemm(F.lds, ws, oA, oB, kind == pg8::EK_SWIGLU ? N / 2 : N, K, kind, oO, ldc, F.G);
}

__global__ void __launch_bounds__(NWAVES * 64, 2) fwd_mega(Args args) {
    extern __shared__ __attribute__((aligned(16))) unsigned char lds_raw[];
    cg::grid_group grid = cg::this_grid();
    Frame F;
    F.lds = (LAS unsigned char*)lds_raw; F.tid = threadIdx.x; F.lane = F.tid & 63; F.wave = __builtin_amdgcn_readfirstlane(F.tid >> 6); F.G = gridDim.x;
    F.in = args.in;
    F.out = args.out; F.ws = args.ws;
    volatile LAS unsigned* bst = (volatile LAS unsigned*)(F.lds + 131072);
    if (F.tid < 64) bst[F.tid] = 0u;
    __syncthreads();
    XcdBarrier bar = xcd_barrier_post((unsigned*)(args.ws) + 1024, bst + 8);
    for (int vst = args.st_lo * 2; vst < args.st_hi * 2; ++vst) {
        const int st = vst >> 1, rep = vst & 1;
        const int l = st / NSTEP, s = st % NSTEP;
        { int t_ = threadIdx.x; asm volatile("" : "+v"(t_)); F.tid = t_; F.lane = t_ & 63; F.wave = __builtin_amdgcn_readfirstlane(t_ >> 6); }
#ifndef PROBE_GEMM
#define PROBE_GEMM 0
#endif
#ifndef PROBE_ATT
#define PROBE_ATT 0
#endif
        const bool is_g = (s == 1 || s == 4 || s == 5 || s == 6 || s == 8 || s == 9 || s == 10 || s == 12 || s == 13 || s == 15 || s == 16);
        const int reps = ((PROBE_GEMM && is_g) || (PROBE_ATT && (s == 7 || s == 11))) ? 2 : 1;
        if (rep >= reps) continue;
        if (l == 0 && (s == 0 || s == 17)) convert_weights(F, s == 0 ? 0 : 1);
        if (s == 0) { if (l == 0) { build_rope(F); phase_norm_in(F); } }
        else if (s == 2) phase_c(F, l);
        else if (s == 7 || s == 11) {
            att::Ptrs P; P.Qn = (const bf16_t*)(F.ws + WS_QN); P.Qr = (const bf16_t*)(F.ws + WS_QR); P.Kn = (const bf16_t*)(F.ws + WS_KN); P.Vt = (const bf16_t*)(F.ws + WS_VT);
            P.KR = (const bf16_t*)(F.ws + WS_KR); P.ATT = (bf16_t*)(F.ws + WS_R0); P.rope = (const float*)(F.ws + WS_ROPE);
            att::attn_phase(F.lds, P, s == 7 ? 0 : 1, F.G);
        }
        else if (s == 14) phase_h(F, l);
        else if (s == 17) phase_k(F, l);
        else run_gemm(F, s);
        if (rep + 1 == reps && step_sync(l, s) && st + 1 < args.st_hi) { if (args.st_lo < 0) grid.sync(); else xcd_barrier(bar); }
    }
}

#ifndef MK_MULTI
#define MK_MULTI 0
#endif
extern "C" void kernel_launch(void* const* d_in, const int* in_sizes, int n_in, void* d_out, int out_size, void* d_ws, size_t ws_size, hipStream_t stream) {
    static int grid_blocks = 0;
    if (grid_blocks == 0) {
        if (n_in != 20 || out_size != (int)O_END || ws_size < WS_END) { fprintf(stderr, "kernel_launch: unexpected shapes n_in %d out %d ws %zu (need %zu)\n", n_in, out_size, ws_size, (size_t)WS_END); grid_blocks = -1; return; }
        int dev = 0, cus = 0, per_cu = 0;
        (void)hipGetDevice(&dev); (void)hipDeviceGetAttribute(&cus, hipDeviceAttributeMultiprocessorCount, dev);
        (void)hipFuncSetAttribute((const void*)fwd_mega, hipFuncAttributeMaxDynamicSharedMemorySize, LDS_BYTES);
        (void)hipOccupancyMaxActiveBlocksPerMultiprocessor(&per_cu, (const void*)fwd_mega, NWAVES * 64, LDS_BYTES);
        if (per_cu < 1) per_cu = 1;
        if (cus <= 0) cus = 256;
        grid_blocks = cus * per_cu;
    }
    if (grid_blocks < 0) return;
    Args a{};
    for (int i = 0; i < 20; ++i) a.in[i] = (const float*)d_in[i];
    a.out = (float*)d_out; a.ws = (unsigned char*)d_ws;
    (void)hipMemsetAsync(d_ws, 0, 65536, stream);
#if MK_MULTI
    int lo = 0;
    for (int st = 0; st < 2 * NSTEP; ++st) {
        if (step_sync(st / NSTEP, st % NSTEP) || st + 1 == 2 * NSTEP) { a.st_lo = lo; a.st_hi = st + 1; hipLaunchKernelGGL(fwd_mega, dim3(grid_blocks), dim3(NWAVES * 64), LDS_BYTES, stream, a); lo = st + 1; }
    }
#else
    a.st_lo = 0; a.st_hi = 2 * NSTEP;
    void* params[] = {&a};
    hipError_t e = hipLaunchCooperativeKernel((const void*)fwd_mega, dim3(grid_blocks), dim3(NWAVES * 64), params, LDS_BYTES, stream);
    if (e != hipSuccess) fprintf(stderr, "cooperative launch failed: %s (grid %d)\n", hipGetErrorString(e), grid_blocks);
#endif
}
```
